# Optimizing an MI355X kernel written in HIP

```python
import math
import jax, jax.numpy as jnp
from jax import lax
import numpy as np

D_MODEL = 2048
BATCH = 4
SEQ = 4096
DEPTH = 4

D_FF = 5632
EPS = 1e-6
ROPE_THETA = 10000.0
BLOCK = 128

SSM_GROUP = 16
SSM_WIDTH = D_MODEL // 4
SSM_GROUPS = SSM_WIDTH // SSM_GROUP
SSM_STATE = 64
DT_MIN = 1e-3
DT_MAX = 1e-1

SWA_HEADS = 8
SWA_KV_HEADS = 2
SWA_Q_PER_KV = SWA_HEADS // SWA_KV_HEADS
SWA_HEAD_DIM = 64
SWA_WINDOW = 128
SWA_WIDTH = SWA_HEADS * SWA_HEAD_DIM

MLA_HEADS = 8
MLA_Q_RANK = 512
MLA_KV_RANK = 256
MLA_NOPE_DIM = 128
MLA_ROPE_DIM = 64
MLA_V_DIM = 128
MLA_WIDTH = MLA_HEADS * MLA_V_DIM

D_MIX = SSM_WIDTH + SWA_WIDTH + MLA_WIDTH
ROPE_DIM = SWA_HEAD_DIM

IN_SIZES = (SSM_WIDTH,
            SWA_WIDTH,
            SWA_KV_HEADS * SWA_HEAD_DIM,
            SWA_KV_HEADS * SWA_HEAD_DIM,
            MLA_Q_RANK,
            MLA_KV_RANK,
            MLA_ROPE_DIM)
N_IN = sum(IN_SIZES)
IN_OFFSETS = tuple(int(o) for o in np.cumsum(IN_SIZES)[:-1])

kernel_name = "hymba_s5_swa_mla_macaron"


def _rmsnorm(x, gain):
    xf = x.astype(jnp.float32)
    xf = xf * lax.rsqrt(jnp.mean(xf * xf, axis=-1, keepdims=True) + EPS)
    return xf.astype(x.dtype) * gain


def _rope_tables(positions, dim):
    inv_freq = ROPE_THETA ** (-jnp.arange(0, dim, 2, dtype=jnp.float32) / dim)
    ang = positions.astype(jnp.float32)[..., None] * inv_freq
    return jnp.cos(ang), jnp.sin(ang)


def _apply_rope(x, cos, sin):
    c = cos[:, :, None, :].astype(x.dtype)
    s = sin[:, :, None, :].astype(x.dtype)
    x1, x2 = jnp.split(x, 2, axis=-1)
    return jnp.concatenate([x1 * c - x2 * s, x2 * c + x1 * s], axis=-1)


def _swiglu(h, w_gate, w_up, w_down):
    return (jax.nn.silu(h @ w_gate) * (h @ w_up)) @ w_down


def _complex_affine_combine(left, right):
    a1r, a1i, b1r, b1i = left
    a2r, a2i, b2r, b2i = right
    ar = a2r * a1r - a2i * a1i
    ai = a2r * a1i + a2i * a1r
    br = a2r * b1r - a2i * b1i + b2r
    bi = a2r * b1i + a2i * b1r + b2i
    return (ar, ai, br, bi)


def _s5_mixer(u, log_dt, a_re, a_im, b_re, b_im, c_re, c_im, d_skip, w_glu, b_glu):
    B_, L, _ = u.shape
    f32 = jnp.float32
    uf = u.astype(f32).reshape(B_, L, SSM_GROUPS, SSM_GROUP)
    lr, li = a_re.astype(f32), a_im.astype(f32)
    dt = jnp.exp(log_dt.astype(f32))[:, None]
    mag = jnp.exp(lr * dt)
    abar_r = mag * jnp.cos(li * dt)
    abar_i = mag * jnp.sin(li * dt)
    den = lr * lr + li * li
    nr = abar_r - 1.0
    qr = (nr * lr + abar_i * li) / den
    qi = (abar_i * lr - nr * li) / den
    br, bi = b_re.astype(f32), b_im.astype(f32)
    bbar_r = qr[..., None] * br - qi[..., None] * bi
    bbar_i = qr[..., None] * bi + qi[..., None] * br
    bu_r = jnp.einsum('blgc,gpc->blgp', uf, bbar_r)
    bu_i = jnp.einsum('blgc,gpc->blgp', uf, bbar_i)
    shape = bu_r.shape
    elems = (jnp.broadcast_to(abar_r, shape), jnp.broadcast_to(abar_i, shape), bu_r, bu_i)
    _, _, xr, xi = lax.associative_scan(_complex_affine_combine, elems, axis=1)
    y = (jnp.einsum('blgp,gcp->blgc', xr, c_re.astype(f32))
         - jnp.einsum('blgp,gcp->blgc', xi, c_im.astype(f32)))
    y = y.reshape(B_, L, SSM_WIDTH) + d_skip.astype(f32) * u.astype(f32)
    y = jax.nn.gelu(y).astype(u.dtype)
    return y * jax.nn.sigmoid(y @ w_glu + b_glu)


def _swa_mixer(q, k, v, cos, sin, sinks):
    B_, L = q.shape[:2]
    nb = L // BLOCK
    f32 = jnp.float32
    q = _apply_rope(q.reshape(B_, L, SWA_HEADS, SWA_HEAD_DIM), cos, sin)
    k = _apply_rope(k.reshape(B_, L, SWA_KV_HEADS, SWA_HEAD_DIM), cos, sin)
    v = v.reshape(B_, L, SWA_KV_HEADS, SWA_HEAD_DIM)
    qb = q.reshape(B_, nb, BLOCK, SWA_KV_HEADS, SWA_Q_PER_KV, SWA_HEAD_DIM)

    def with_prev(t):
        tb = t.reshape(B_, nb, BLOCK, SWA_KV_HEADS, SWA_HEAD_DIM)
        prev = jnp.concatenate([jnp.zeros_like(tb[:, :1]), tb[:, :-1]], axis=1)
        return jnp.concatenate([prev, tb], axis=2)

    kb, vb = with_prev(k), with_prev(v)
    s = jnp.einsum('bnqhgd,bnkhd->bnhgqk', qb, kb).astype(f32) * (SWA_HEAD_DIM ** -0.5)
    qi = jnp.arange(BLOCK)[:, None] + BLOCK
    kj = jnp.arange(2 * BLOCK)[None, :]
    band = (qi - kj >= 0) & (qi - kj < SWA_WINDOW)
    has_prev = (jnp.arange(nb) > 0)[:, None, None] | (kj >= BLOCK)[None]
    mask = band[None] & has_prev
    s = jnp.where(mask[None, :, None, None], s, -jnp.inf)
    sink = sinks.astype(f32).reshape(1, 1, SWA_KV_HEADS, SWA_Q_PER_KV, 1, 1)
    m = jnp.maximum(jnp.max(s, axis=-1, keepdims=True), sink)
    e = jnp.exp(s - m)
    p = e / (jnp.sum(e, axis=-1, keepdims=True) + jnp.exp(sink - m))
    o = jnp.einsum('bnhgqk,bnkhd->bnqhgd', p.astype(v.dtype), vb)
    return o.reshape(B_, L, SWA_WIDTH)


def _mla_mixer(c_q, c_kv, k_rope, cos, sin, q_norm, w_uq, kv_norm, w_ukv):
    B_, L = c_q.shape[:2]
    nb = L // BLOCK
    f32 = jnp.float32
    q = (_rmsnorm(c_q, q_norm) @ w_uq).reshape(B_, L, MLA_HEADS, MLA_NOPE_DIM + MLA_ROPE_DIM)
    q_nope = q[..., :MLA_NOPE_DIM]
    q_rope = _apply_rope(q[..., MLA_NOPE_DIM:], cos, sin)
    kv = (_rmsnorm(c_kv, kv_norm) @ w_ukv).reshape(B_, L, MLA_HEADS, MLA_NOPE_DIM + MLA_V_DIM)
    k_nope, v = kv[..., :MLA_NOPE_DIM], kv[..., MLA_NOPE_DIM:]
    k_rope = _apply_rope(k_rope[:, :, None, :], cos, sin)[:, :, 0]
    scale = (MLA_NOPE_DIM + MLA_ROPE_DIM) ** -0.5
    key_pos = jnp.arange(L)

    def to_blocks(t):
        return jnp.moveaxis(t.reshape(B_, nb, BLOCK, *t.shape[2:]), 1, 0)

    def block(args):
        qn, qr, n = args
        s = (jnp.einsum('bqhd,bkhd->bhqk', qn, k_nope)
             + jnp.einsum('bqhd,bkd->bhqk', qr, k_rope)).astype(f32) * scale
        q_pos = n * BLOCK + jnp.arange(BLOCK)
        s = jnp.where(key_pos[None, :] <= q_pos[:, None], s, -jnp.inf)
        p = jax.nn.softmax(s, axis=-1).astype(v.dtype)
        return jnp.einsum('bhqk,bkhd->bqhd', p, v)

    o = lax.map(block, (to_blocks(q_nope), to_blocks(q_rope), jnp.arange(nb)))
    return jnp.moveaxis(o, 0, 1).reshape(B_, L, MLA_WIDTH)


def setup_inputs(seed: int = 0) -> dict:
    key = jax.random.key(seed)
    ks = jax.random.split(key, 40)
    f32 = jnp.float32

    def nrm(k, shape, scale):
        return jax.random.normal(k, shape, f32) * scale

    def gain(k, shape):
        return 1.0 + 0.02 * jax.random.normal(k, shape, f32)

    x = jax.random.normal(ks[0], (BATCH, SEQ, D_MODEL), f32)
    offset = jax.random.randint(ks[1], (BATCH, 1), 0, 1024, dtype=jnp.int32)
    positions = (offset + jnp.arange(SEQ, dtype=jnp.int32)[None, :]).astype(jnp.int32)
    n_idx = jnp.arange(SSM_STATE, dtype=f32)
    return {
        "x": x,
        "positions": positions,
        "ffn1_norm": gain(ks[2], (DEPTH, D_MODEL)),
        "ffn1_w_gate": nrm(ks[3], (DEPTH, D_MODEL, D_FF), D_MODEL ** -0.5),
        "ffn1_w_up": nrm(ks[4], (DEPTH, D_MODEL, D_FF), D_MODEL ** -0.5),
        "ffn1_w_down": nrm(ks[5], (DEPTH, D_FF, D_MODEL), D_FF ** -0.5),
        "mix_norm": gain(ks[6], (DEPTH, D_MODEL)),
        "w_in": nrm(ks[7], (DEPTH, D_MODEL, N_IN), D_MODEL ** -0.5),
        "ssm_log_dt": jax.random.uniform(ks[8], (DEPTH, SSM_GROUPS), f32, math.log(DT_MIN), math.log(DT_MAX)),
        "ssm_a_re": -0.5 * jnp.exp(0.05 * jax.random.normal(ks[9], (DEPTH, SSM_GROUPS, SSM_STATE), f32)),
        "ssm_a_im": math.pi * n_idx + 0.01 * jax.random.normal(ks[10], (DEPTH, SSM_GROUPS, SSM_STATE), f32),
        "ssm_b_re": nrm(ks[11], (DEPTH, SSM_GROUPS, SSM_STATE, SSM_GROUP), (2 * SSM_GROUP) ** -0.5),
        "ssm_b_im": nrm(ks[12], (DEPTH, SSM_GROUPS, SSM_STATE, SSM_GROUP), (2 * SSM_GROUP) ** -0.5),
        "ssm_c_re": nrm(ks[13], (DEPTH, SSM_GROUPS, SSM_GROUP, SSM_STATE), (2 * SSM_STATE) ** -0.5),
        "ssm_c_im": nrm(ks[14], (DEPTH, SSM_GROUPS, SSM_GROUP, SSM_STATE), (2 * SSM_STATE) ** -0.5),
        "ssm_d": nrm(ks[15], (DEPTH, SSM_WIDTH), 0.5),
        "ssm_w_glu": nrm(ks[16], (DEPTH, SSM_WIDTH, SSM_WIDTH), SSM_WIDTH ** -0.5),
        "ssm_b_glu": nrm(ks[17], (DEPTH, SSM_WIDTH), 0.01),
        "swa_sinks": nrm(ks[18], (DEPTH, SWA_HEADS), 0.5),
        "mla_q_norm": gain(ks[19], (DEPTH, MLA_Q_RANK)),
        "mla_w_uq": nrm(ks[20], (DEPTH, MLA_Q_RANK, MLA_HEADS * (MLA_NOPE_DIM + MLA_ROPE_DIM)), MLA_Q_RANK ** -0.5),
        "mla_kv_norm": gain(ks[21], (DEPTH, MLA_KV_RANK)),
        "mla_w_ukv": nrm(ks[22], (DEPTH, MLA_KV_RANK, MLA_HEADS * (MLA_NOPE_DIM + MLA_V_DIM)), MLA_KV_RANK ** -0.5),
        "out_norm": gain(ks[23], (DEPTH, D_MIX)),
        "w_out": nrm(ks[24], (DEPTH, D_MIX, D_MODEL), D_MIX ** -0.5),
        "ffn2_norm": gain(ks[25], (DEPTH, D_MODEL)),
        "ffn2_w_gate": nrm(ks[26], (DEPTH, D_MODEL, D_FF), D_MODEL ** -0.5),
        "ffn2_w_up": nrm(ks[27], (DEPTH, D_MODEL, D_FF), D_MODEL ** -0.5),
        "ffn2_w_down": nrm(ks[28], (DEPTH, D_FF, D_MODEL), D_FF ** -0.5),
        "final_norm": gain(ks[29], (D_MODEL,)),
    }


def reference(x, positions, ffn1_norm, ffn1_w_gate, ffn1_w_up, ffn1_w_down, mix_norm, w_in,
              ssm_log_dt, ssm_a_re, ssm_a_im, ssm_b_re, ssm_b_im, ssm_c_re, ssm_c_im, ssm_d,
              ssm_w_glu, ssm_b_glu, swa_sinks, mla_q_norm, mla_w_uq, mla_kv_norm, mla_w_ukv,
              out_norm, w_out, ffn2_norm, ffn2_w_gate, ffn2_w_up, ffn2_w_down, final_norm):
    cos, sin = _rope_tables(positions, ROPE_DIM)
    s1 = SSM_WIDTH
    s2 = SSM_WIDTH + SWA_WIDTH
    for l in range(DEPTH):
        h = _rmsnorm(x, ffn1_norm[l])
        x = x + 0.5 * _swiglu(h, ffn1_w_gate[l], ffn1_w_up[l], ffn1_w_down[l])
        h = _rmsnorm(x, mix_norm[l])
        z = h @ w_in[l]
        u, q_s, k_s, v_s, c_q, c_kv, k_r = jnp.split(z, IN_OFFSETS, axis=-1)
        y_ssm = _s5_mixer(u, ssm_log_dt[l], ssm_a_re[l], ssm_a_im[l], ssm_b_re[l], ssm_b_im[l],
                          ssm_c_re[l], ssm_c_im[l], ssm_d[l], ssm_w_glu[l], ssm_b_glu[l])
        y_swa = _swa_mixer(q_s, k_s, v_s, cos, sin, swa_sinks[l])
        y_mla = _mla_mixer(c_q, c_kv, k_r, cos, sin, mla_q_norm[l], mla_w_uq[l],
                           mla_kv_norm[l], mla_w_ukv[l])
        y = jnp.concatenate([_rmsnorm(y_ssm, out_norm[l, :s1]),
                             _rmsnorm(y_swa, out_norm[l, s1:s2]),
                             _rmsnorm(y_mla, out_norm[l, s2:])], axis=-1)
        x = x + y @ w_out[l]
        h = _rmsnorm(x, ffn2_norm[l])
        x = x + 0.5 * _swiglu(h, ffn2_w_gate[l], ffn2_w_up[l], ffn2_w_down[l])
    return _rmsnorm(x, final_norm)
```

```cpp
#include <hip/hip_runtime.h>
#include <cstdio>
#include <cstdint>
#include <cmath>

constexpr int D_MODEL = 2048, BATCH = 4, SEQ = 4096, DEPTH = 4, D_FF = 5632;
constexpr int MTOK = BATCH * SEQ;
constexpr float EPS = 1e-6f;
constexpr int SSM_GROUP = 16, SSM_WIDTH = 512, SSM_GROUPS = 32, SSM_STATE = 64;
constexpr int SWA_HEADS = 8, SWA_KV = 2, SWA_HD = 64, SWA_WINDOW = 128, SWA_WIDTH = 512;
constexpr int MLA_HEADS = 8, MLA_QR = 512, MLA_KVR = 256, MLA_NOPE = 128, MLA_ROPE = 64, MLA_V = 128, MLA_WIDTH = 1024;
constexpr int D_MIX = 2048, N_IN = 2112, N_IN_PAD = 2304;
constexpr int MLA_QK = MLA_NOPE + MLA_ROPE;
constexpr float LOG2E = 1.4426950408889634f;
namespace pg8 {
#define PG8_LAS __attribute__((address_space(3)))
typedef unsigned short bf16_t;
typedef short bf16x8 __attribute__((ext_vector_type(8)));
typedef float f32x4 __attribute__((ext_vector_type(4)));
typedef unsigned u32x4 __attribute__((ext_vector_type(4)));
constexpr int BM = 256, BK = 64, HALF = 128, HTB = HALF * BK * 2  , STAGE_BYTES = 8 * HTB, NXCD = 8, WGM = 8;

__host__ __device__ __forceinline__ int lds_byte(int r, int c) { const int st = (r >> 4) * 2 + (c >> 5), rr = r & 15, cc = c & 31, ob = rr * 64 + cc * 2; return st * 1024 + (ob ^ (((ob >> 9) & 1) << 5)); }
__host__ __device__ __forceinline__ void stage_rc(int b, int& R, int& C) { const int st = b / 1024, sb = b % 1024, swz = sb ^ (((sb >> 9) & 1) << 5); R = (st >> 1) * 16 + swz / 64; C = (st & 1) * 32 + (swz % 64) / 2; }
__host__ __device__ __forceinline__ int perm32(int rho) { const int n = rho >> 4, i = rho & 15; return 8 * (i >> 2) + 4 * n + (i & 3); }

struct Unit { int pm, pn; };
struct Gemm { const bf16_t* A; const bf16_t* Bt; int M, N, K; };

struct StaticOrder {
    int nM, nN, nwg, G, c;
    __host__ __device__ void init(int M, int N, int G_, int c_) { nM = M / BM; nN = N / BM; nwg = nM * nN; G = G_; c = c_; }
    __host__ __device__ bool next(int i, Unit& u) const {
        const long L = (long)i * G + c; if (L >= nwg) return false;
        int wgid = (int)L; { const int q = nwg / NXCD, r = nwg % NXCD, xcd = wgid % NXCD, off = wgid / NXCD; wgid = (xcd < r ? xcd * (q + 1) : r * (q + 1) + (xcd - r) * q) + off; }
        const int nig = WGM * nN, gid = wgid / nig, fm = gid * WGM, gsz = (nM - fm) < WGM ? (nM - fm) : WGM;
        u.pm = fm + ((wgid % nig) % gsz); u.pn = (wgid % nig) / gsz; return true;
    }
    __device__ __forceinline__ void a_ready(const Unit&) const {}
    __device__ __forceinline__ void done(const Unit&) const {}
};

__device__ __forceinline__ unsigned cvt_pk_bf16(float lo, float hi) { unsigned r; asm volatile("v_cvt_pk_bf16_f32 %0, %1, %2" : "=v"(r) : "v"(lo), "v"(hi)); return r; }
typedef float f32x2 __attribute__((ext_vector_type(2)));
__device__ __forceinline__ f32x2 gelu_pk(f32x2 v) {
    const f32x2 av = __builtin_elementwise_abs(v), d = av * 0.2316418882f + 1.0f;
    f32x2 t; t.x = __builtin_amdgcn_rcpf(d.x); t.y = __builtin_amdgcn_rcpf(d.y);
    f32x2 q = t * 0.5307027145f + (-0.7265760135f); q = q * t + 0.7107068705f; q = q * t + (-0.142248368f); q = q * t + 0.127414796f; q = q * t;
    const f32x2 s = (v * v) * (-0.72134752044f);
    f32x2 e; e.x = __builtin_amdgcn_exp2f(s.x); e.y = __builtin_amdgcn_exp2f(s.y);
    const f32x2 m = v * (q * e), r = v - m;
    f32x2 o; o.x = v.x < 0.f ? m.x : r.x; o.y = v.y < 0.f ? m.y : r.y; return o;
}

template <int ACT  > struct EpiBf16 {
    static constexpr bool PERM = true, AFTER_DRAIN = false; static_assert(ACT == 0 || ACT == 1, "EpiBf16: ACT is 0 (none) or 1 (gelu_pk)");
    bf16_t* O; int ldc; const float* bias; int split_cols; size_t split_stride; float scale0;
    __device__ __forceinline__ void operator()(const f32x4 (&acc)[2][2][4][2], const Unit& u, int wr, int wc, int fr, int fq) const {
        const int row0 = u.pm * BM + wr * 64 + fr; int colt = u.pn * BM; bf16_t* base = O;
        float sc = 1.f; if (split_cols) { const int t = colt / split_cols; base += (size_t)t * split_stride; colt -= t * split_cols; if (t == 0) sc = scale0; }
        const int col0 = colt + wc * 32 + 8 * fq, bcol0 = u.pn * BM + wc * 32 + 8 * fq;
        f32x4 bv[2][2];
#pragma unroll
        for (int bj = 0; bj < 2; ++bj)
#pragma unroll
            for (int n = 0; n < 2; ++n) bv[bj][n] = bias ? *(const f32x4*)(bias + bcol0 + bj * HALF + 4 * n) : (f32x4){0.f, 0.f, 0.f, 0.f};
#pragma unroll
        for (int ai = 0; ai < 2; ++ai)
#pragma unroll
            for (int m = 0; m < 4; ++m) { bf16_t* rowp = base + (size_t)(row0 + ai * HALF + m * 16) * ldc + col0;
#pragma unroll
                for (int bj = 0; bj < 2; ++bj) { f32x4 v0 = acc[ai][bj][m][0] + bv[bj][0], v1 = acc[ai][bj][m][1] + bv[bj][1];
                    if (ACT == 1) { f32x2 a = gelu_pk((f32x2){v0[0], v0[1]}), b = gelu_pk((f32x2){v0[2], v0[3]}), c = gelu_pk((f32x2){v1[0], v1[1]}), d = gelu_pk((f32x2){v1[2], v1[3]});
                        v0 = (f32x4){a.x, a.y, b.x, b.y}; v1 = (f32x4){c.x, c.y, d.x, d.y}; }
                    v0 = v0 * sc; v1 = v1 * sc; u32x4 w; w.x = cvt_pk_bf16(v0[0], v0[1]); w.y = cvt_pk_bf16(v0[2], v0[3]); w.z = cvt_pk_bf16(v1[0], v1[1]); w.w = cvt_pk_bf16(v1[2], v1[3]);
                    *(u32x4*)(rowp + bj * HALF) = w; } }
    }
};


typedef unsigned u32x2 __attribute__((ext_vector_type(2)));
__device__ __forceinline__ int epi_vz() { int z; asm volatile("v_mov_b32 %0, 0" : "=v"(z)); return z; }
__device__ __forceinline__ void store8_bf16(bf16_t* p, f32x4 v0, f32x4 v1) {
    u32x4 w; w.x = cvt_pk_bf16(v0[0], v0[1]); w.y = cvt_pk_bf16(v0[2], v0[3]); w.z = cvt_pk_bf16(v1[0], v1[1]); w.w = cvt_pk_bf16(v1[2], v1[3]); *(u32x4*)p = w;
}
__device__ __forceinline__ float sumsq8(f32x4 a, f32x4 b) { return (a[0] * a[0] + a[1] * a[1]) + (a[2] * a[2] + a[3] * a[3]) + (b[0] * b[0] + b[1] * b[1]) + (b[2] * b[2] + b[3] * b[3]); }
__device__ __forceinline__ float silu_mul(float g, float u) { return g * __builtin_amdgcn_rcpf(1.0f + __builtin_amdgcn_exp2f(-g * LOG2E)) * u; }
__device__ __forceinline__ f32x4 silu_mul4(f32x4 g, f32x4 u) { f32x4 r; r[0] = silu_mul(g[0], u[0]); r[1] = silu_mul(g[1], u[1]); r[2] = silu_mul(g[2], u[2]); r[3] = silu_mul(g[3], u[3]); return r; }
typedef unsigned long long rss_t;
__device__ __forceinline__ rss_t rss_enc(float ss) { return (rss_t)(long long)((double)ss * 4294967296.0); }
__device__ __forceinline__ float rss_dec(rss_t v) { return (float)((double)(long long)v * (1.0 / 4294967296.0)); }
__device__ __forceinline__ void row_atomic(rss_t* dst, float ss, int fq) { ss += __shfl_xor(ss, 16); ss += __shfl_xor(ss, 32); if (fq == 0) atomicAdd(dst, rss_enc(ss)); }

struct EpiSwiGLU {
    static constexpr bool PERM = true, AFTER_DRAIN = false;
    bf16_t* O; int ldc; const rss_t* rss; float invn;
    __device__ __forceinline__ void operator()(const f32x4 (&acc)[2][2][4][2], const Unit& u, int wr, int wc, int fr_, int fq_) const { const int ez = epi_vz(), fr = fr_ + ez, fq = fq_ + ez;
        const int row0 = u.pm * BM + wr * 64 + fr, col0 = u.pn * HALF + wc * 32 + 8 * fq;
#pragma unroll
        for (int ai = 0; ai < 2; ++ai)
#pragma unroll
            for (int m = 0; m < 4; ++m) { const int row = row0 + ai * HALF + m * 16; const float rs = __builtin_amdgcn_rsqf(rss_dec(rss[row]) * invn + EPS);
                const f32x4 h0 = silu_mul4(acc[ai][0][m][0] * rs, acc[ai][1][m][0] * rs), h1 = silu_mul4(acc[ai][0][m][1] * rs, acc[ai][1][m][1] * rs);
                store8_bf16(O + (size_t)row * ldc + col0, h0, h1); }
    }
};
struct EpiResid {
    static constexpr bool PERM = true, AFTER_DRAIN = false;
    const float* xin; float* xout; bf16_t* xb; rss_t* rss_out; float scale;
    __device__ __forceinline__ void operator()(const f32x4 (&acc)[2][2][4][2], const Unit& u, int wr, int wc, int fr_, int fq_) const { const int ez = epi_vz(), fr = fr_ + ez, fq = fq_ + ez;
        const int row0 = u.pm * BM + wr * 64 + fr, col0 = u.pn * BM + wc * 32 + 8 * fq;
#pragma unroll
        for (int ai = 0; ai < 2; ++ai)
#pragma unroll
            for (int m = 0; m < 4; ++m) { const int row = row0 + ai * HALF + m * 16; const size_t off = (size_t)row * D_MODEL + col0; float ss = 0.f;
#pragma unroll
                for (int bj = 0; bj < 2; ++bj) { const f32x4 a0 = *(const f32x4*)(xin + off + bj * HALF), a1 = *(const f32x4*)(xin + off + bj * HALF + 4);
                    const f32x4 v0 = a0 + acc[ai][bj][m][0] * scale, v1 = a1 + acc[ai][bj][m][1] * scale;
                    *(f32x4*)(xout + off + bj * HALF) = v0; *(f32x4*)(xout + off + bj * HALF + 4) = v1; store8_bf16(xb + off + bj * HALF, v0, v1); ss += sumsq8(v0, v1); }
                row_atomic(rss_out + row, ss, fq); }
    }
};
struct EpiBf16Rs {
    static constexpr bool PERM = true, AFTER_DRAIN = false;
    bf16_t* O; int ldc; const rss_t* rss; float invn; float scale;
    __device__ __forceinline__ void operator()(const f32x4 (&acc)[2][2][4][2], const Unit& u, int wr, int wc, int fr_, int fq_) const { const int ez = epi_vz(), fr = fr_ + ez, fq = fq_ + ez;
        const int row0 = u.pm * BM + wr * 64 + fr, col0 = u.pn * BM + wc * 32 + 8 * fq;
#pragma unroll
        for (int ai = 0; ai < 2; ++ai)
#pragma unroll
            for (int m = 0; m < 4; ++m) { const int row = row0 + ai * HALF + m * 16; const float rs = __builtin_amdgcn_rsqf(rss_dec(rss[row]) * invn + EPS) * scale;
#pragma unroll
                for (int bj = 0; bj < 2; ++bj) store8_bf16(O + (size_t)row * ldc + col0 + bj * HALF, acc[ai][bj][m][0] * rs, acc[ai][bj][m][1] * rs); }
    }
};
__device__ __forceinline__ void rope8(const f32x4 x1a, const f32x4 x1b, const f32x4 x2a, const f32x4 x2b, const float* cs, const float* sn, int i0, float sc, bf16_t* o1, bf16_t* o2) {
    const f32x4 ca = *(const f32x4*)(cs + i0), cb = *(const f32x4*)(cs + i0 + 4), sa = *(const f32x4*)(sn + i0), sb = *(const f32x4*)(sn + i0 + 4);
    store8_bf16(o1, (x1a * ca - x2a * sa) * sc, (x1b * cb - x2b * sb) * sc);
    store8_bf16(o2, (x2a * ca + x1a * sa) * sc, (x2b * cb + x1b * sb) * sc);
}
struct EpiWin {
    static constexpr bool PERM = true, AFTER_DRAIN = false;
    const rss_t* rss; const float* cs; const float* sn;
    float* U; bf16_t* QS; bf16_t* KS; bf16_t* VS; bf16_t* CQ; bf16_t* CKV; bf16_t* KR; rss_t* rss_cq; rss_t* rss_ckv; float qscale;
    __device__ __forceinline__ void operator()(const f32x4 (&acc)[2][2][4][2], const Unit& u, int wr, int wc, int fr_, int fq_) const { const int ez = epi_vz(), fr = fr_ + ez, fq = fq_ + ez;
        const int row0 = u.pm * BM + wr * 64 + fr, pn = u.pn, i0 = 8 * fq;
        if (pn == 8 && wc != 0) return;
#pragma unroll
        for (int ai = 0; ai < 2; ++ai)
#pragma unroll
            for (int m = 0; m < 4; ++m) { const int row = row0 + ai * HALF + m * 16; const float rs = __builtin_amdgcn_rsqf(rss_dec(rss[row]) * (1.0f / D_MODEL) + EPS);
                const f32x4 a00 = acc[ai][0][m][0] * rs, a01 = acc[ai][0][m][1] * rs, a10 = acc[ai][1][m][0] * rs, a11 = acc[ai][1][m][1] * rs;
                if (pn < 2) { float* p = U + (size_t)row * SSM_WIDTH + pn * BM + wc * 32 + 8 * fq;
                    *(f32x4*)p = a00; *(f32x4*)(p + 4) = a01; *(f32x4*)(p + HALF) = a10; *(f32x4*)(p + HALF + 4) = a11; }
                else if (pn < 4) { bf16_t* p = QS + (size_t)row * SWA_WIDTH + ((pn - 2) * 4 + wc) * SWA_HD + i0;
                    rope8(a00, a01, a10, a11, cs + (size_t)row * 32, sn + (size_t)row * 32, i0, qscale, p, p + 32); }
                else if (pn == 4) {
                    if (wc < 2) { bf16_t* p = KS + (size_t)row * (SWA_KV * SWA_HD) + wc * SWA_HD + i0; rope8(a00, a01, a10, a11, cs + (size_t)row * 32, sn + (size_t)row * 32, i0, 1.0f, p, p + 32); }
                    else { bf16_t* p = VS + (size_t)row * (SWA_KV * SWA_HD) + (wc - 2) * 32 + i0; store8_bf16(p, a00, a01); store8_bf16(p + 64, a10, a11); } }
                else if (pn < 7) { bf16_t* p = CQ + (size_t)row * MLA_QR + (pn - 5) * BM + wc * 32 + 8 * fq; store8_bf16(p, a00, a01); store8_bf16(p + HALF, a10, a11);
                    row_atomic(rss_cq + row, sumsq8(a00, a01) + sumsq8(a10, a11), fq); }
                else if (pn == 7) { bf16_t* p = CKV + (size_t)row * MLA_KVR + wc * 32 + 8 * fq; store8_bf16(p, a00, a01); store8_bf16(p + HALF, a10, a11);
                    row_atomic(rss_ckv + row, sumsq8(a00, a01) + sumsq8(a10, a11), fq); }
                else { bf16_t* p = KR + (size_t)row * MLA_ROPE + i0; rope8(a00, a01, a10, a11, cs + (size_t)row * 32, sn + (size_t)row * 32, i0, 1.0f, p, p + 32); }
            }
    }
};
struct EpiUq {
    static constexpr bool PERM = true, AFTER_DRAIN = false;
    bf16_t* QM; const rss_t* rss; const float* cs; const float* sn; float qscale;
    __device__ __forceinline__ void operator()(const f32x4 (&acc)[2][2][4][2], const Unit& u, int wr, int wc, int fr_, int fq_) const { const int ez = epi_vz(), fr = fr_ + ez, fq = fq_ + ez;
        const int row0 = u.pm * BM + wr * 64 + fr, pn = u.pn, i0 = 8 * fq;
#pragma unroll
        for (int ai = 0; ai < 2; ++ai)
#pragma unroll
            for (int m = 0; m < 4; ++m) { const int row = row0 + ai * HALF + m * 16; const float rs = __builtin_amdgcn_rsqf(rss_dec(rss[row]) * (1.0f / MLA_QR) + EPS);
                bf16_t* qrow = QM + (size_t)row * (MLA_HEADS * MLA_QK);
                if (pn < 4) { const float s = rs * qscale;
                    store8_bf16(qrow + (2 * pn) * MLA_QK + wc * 32 + 8 * fq, acc[ai][0][m][0] * s, acc[ai][0][m][1] * s);
                    store8_bf16(qrow + (2 * pn + 1) * MLA_QK + wc * 32 + 8 * fq, acc[ai][1][m][0] * s, acc[ai][1][m][1] * s); }
                else { bf16_t* p = qrow + ((pn - 4) * 4 + wc) * MLA_QK + MLA_NOPE + i0;
                    rope8(acc[ai][0][m][0] * rs, acc[ai][0][m][1] * rs, acc[ai][1][m][0] * rs, acc[ai][1][m][1] * rs, cs + (size_t)row * 32, sn + (size_t)row * 32, i0, qscale, p, p + 32); }
            }
    }
};
template <class Epi, class Sched, bool ALIGN_EPI = false, bool SP2 = false>
__device__ __forceinline__ void gemm_phase(PG8_LAS unsigned char* lds, const Gemm g, const Sched& S, const Epi& E) {
    int tid_z; asm volatile("v_mov_b32 %0, 0" : "=v"(tid_z));
    const int tid = threadIdx.x + tid_z, wid = __builtin_amdgcn_readfirstlane(tid >> 6), lane = tid & 63, wr = wid >> 2, wc = wid & 3, fr = lane & 15, fq = lane >> 4;
    const int K = g.K, nt = K / BK;
    unsigned voffA[2], voffB[2];
#pragma unroll
    for (int i = 0; i < 2; ++i) { int R, C; stage_rc(tid * 16 + i * 8192, R, C); const int Rb = Epi::PERM ? ((R & ~31) + perm32(R & 31)) : R;
        voffA[i] = (unsigned)(R * K + C) * 2u; voffB[i] = (unsigned)(Rb * K + C) * 2u; }
    const size_t kstep = (size_t)(BK * 2);
    const size_t hstep = (size_t)HALF * K * 2;
    const size_t tstep = 2 * hstep;
    const unsigned ldsw = (unsigned)wid * 1024u;
    const int aoff = lds_byte(wr * 64 + fr, fq * 8), boff = lds_byte(wc * 32 + fr, fq * 8);
#define PG8_SA(b, h) (((b) * 2 + (h)) * HTB)
#define PG8_SB(b, h) ((4 + (b) * 2 + (h)) * HTB)
#define PG8_STAGE(bufoff, gbase, voff) do { _Pragma("unroll") for (int _i = 0; _i < 2; ++_i) \
        __builtin_amdgcn_global_load_lds((const unsigned*)((const char*)(gbase) + (voff)[_i]), (PG8_LAS unsigned*)(lds + (bufoff) + ldsw + _i * 8192), 16, 0, 0); } while (0)
#define PG8_LDA(dst, b, h) do { _Pragma("unroll") for (int m = 0; m < 4; ++m) _Pragma("unroll") for (int k = 0; k < 2; ++k) dst[m][k] = *(const PG8_LAS bf16x8*)(lds + PG8_SA(b, h) + aoff + m * 2048 + k * 1024); } while (0)
#define PG8_LDB(dst, b, h) do { _Pragma("unroll") for (int n = 0; n < 2; ++n) _Pragma("unroll") for (int k = 0; k < 2; ++k) dst[n][k] = *(const PG8_LAS bf16x8*)(lds + PG8_SB(b, h) + boff + n * 2048 + k * 1024); } while (0)
#define PG8_MMA(ai, bj, At, Bt) do { __builtin_amdgcn_s_setprio(1); _Pragma("unroll") for (int m = 0; m < 4; ++m) _Pragma("unroll") for (int n = 0; n < 2; ++n) _Pragma("unroll") for (int k = 0; k < 2; ++k) \
        acc[ai][bj][m][n] = __builtin_amdgcn_mfma_f32_16x16x32_bf16(Bt[n][k], At[m][k], acc[ai][bj][m][n], 0, 0, 0); __builtin_amdgcn_s_setprio(0); } while (0)
#define PG8_WAIT_V(n) asm volatile("s_waitcnt vmcnt(" #n ")" ::: "memory")
#define PG8_WAIT_L(n) asm volatile("s_waitcnt lgkmcnt(" #n ")" ::: "memory")
#define PG8_BAR __builtin_amdgcn_s_barrier()
#define PG8_SCHED __builtin_amdgcn_sched_barrier(0)
    Unit cur, nxt; int ui = 0;
    if (!S.next(0, cur)) return;
    f32x4 acc[2][2][4][2];
#pragma unroll
    for (int a = 0; a < 2; ++a)
#pragma unroll
        for (int b = 0; b < 2; ++b)
#pragma unroll
            for (int m = 0; m < 4; ++m)
#pragma unroll
                for (int n = 0; n < 2; ++n) acc[a][b][m][n] = (f32x4){0.f, 0.f, 0.f, 0.f};
    bf16x8 At[4][2], B0[2][2], B1[2][2];
    const char* cA = (const char*)g.A + (size_t)cur.pm * tstep; const char* cB = (const char*)g.Bt + (size_t)cur.pn * tstep;
    S.a_ready(cur);
    if constexpr (SP2) {
        PG8_STAGE(PG8_SB(0, 0), cB, voffB); PG8_STAGE(PG8_SB(0, 1), cB + hstep, voffB); PG8_STAGE(PG8_SA(0, 0), cA, voffA); PG8_STAGE(PG8_SA(0, 1), cA + hstep, voffA);
        if (wr == 1) PG8_BAR;
        PG8_WAIT_V(2); PG8_BAR;
        PG8_STAGE(PG8_SB(1, 0), cB + kstep, voffB); PG8_STAGE(PG8_SA(1, 0), cA + kstep, voffA); PG8_STAGE(PG8_SB(1, 1), cB + hstep + kstep, voffB);
        PG8_WAIT_V(6); PG8_BAR;
    } else {
        PG8_STAGE(PG8_SB(0, 0), cB, voffB); PG8_STAGE(PG8_SA(0, 0), cA, voffA); PG8_STAGE(PG8_SB(0, 1), cB + hstep, voffB); PG8_STAGE(PG8_SA(0, 1), cA + hstep, voffA);
        if (wr == 1) PG8_BAR;
        PG8_WAIT_V(4); PG8_BAR;
        PG8_STAGE(PG8_SB(1, 0), cB + kstep, voffB); PG8_STAGE(PG8_SA(1, 0), cA + kstep, voffA); PG8_STAGE(PG8_SB(1, 1), cB + hstep + kstep, voffB);
        PG8_WAIT_V(6); PG8_BAR;
    }
    for (;;) {
        const bool has_next = S.next(ui + 1, nxt);
        const char* nA = has_next ? (const char*)g.A + (size_t)nxt.pm * tstep : cA; const char* nB = has_next ? (const char*)g.Bt + (size_t)nxt.pn * tstep : cB;
        for (int t = 0; t < nt; t += 2) {
            const bool last = (t == nt - 2);
            const char* a1 = cA + (size_t)(t + 1) * kstep;
            const char* a2 = last ? nA : cA + (size_t)(t + 2) * kstep; const char* b2 = last ? nB : cB + (size_t)(t + 2) * kstep;
            const char* a3 = a2 + kstep; const char* b3 = b2 + kstep;
            if (last && has_next) S.a_ready(nxt);
            if constexpr (SP2) {
            PG8_LDB(B0, 0, 0); PG8_LDB(B1, 0, 1); PG8_SCHED; PG8_LDA(At, 0, 0); PG8_STAGE(PG8_SA(1, 1), a1 + hstep, voffA);
            PG8_WAIT_V(8); PG8_WAIT_L(0); PG8_BAR; PG8_MMA(0, 0, At, B0); PG8_MMA(0, 1, At, B1); PG8_BAR; PG8_SCHED;
            PG8_LDA(At, 0, 1); PG8_STAGE(PG8_SB(0, 0), b2, voffB); PG8_STAGE(PG8_SB(0, 1), b2 + hstep, voffB); PG8_STAGE(PG8_SA(0, 0), a2, voffA);
            PG8_WAIT_V(8); PG8_WAIT_L(0); PG8_BAR; PG8_MMA(1, 0, At, B0); PG8_MMA(1, 1, At, B1); PG8_BAR; PG8_SCHED;
            PG8_LDB(B0, 1, 0); PG8_LDB(B1, 1, 1); PG8_SCHED; PG8_LDA(At, 1, 0); PG8_STAGE(PG8_SA(0, 1), a2 + hstep, voffA);
            PG8_WAIT_V(8); PG8_WAIT_L(0); PG8_BAR; PG8_MMA(0, 0, At, B0); PG8_MMA(0, 1, At, B1); PG8_BAR; PG8_SCHED;
            PG8_LDA(At, 1, 1); PG8_STAGE(PG8_SB(1, 0), b3, voffB); PG8_STAGE(PG8_SB(1, 1), b3 + hstep, voffB); PG8_STAGE(PG8_SA(1, 0), a3, voffA);
            PG8_WAIT_V(8); PG8_WAIT_L(0); PG8_BAR; PG8_MMA(1, 0, At, B0); PG8_MMA(1, 1, At, B1); PG8_BAR; PG8_SCHED;
            } else {
            PG8_LDB(B0, 0, 0); PG8_SCHED; PG8_LDA(At, 0, 0); PG8_STAGE(PG8_SA(1, 1), a1 + hstep, voffA);
            PG8_WAIT_L(8); PG8_BAR; PG8_WAIT_L(0); PG8_MMA(0, 0, At, B0); PG8_BAR; PG8_SCHED;
            PG8_LDB(B1, 0, 1); PG8_STAGE(PG8_SB(0, 0), b2, voffB);
            PG8_BAR; PG8_WAIT_L(0); PG8_MMA(0, 1, At, B1); PG8_BAR;
            PG8_LDA(At, 0, 1); PG8_STAGE(PG8_SA(0, 0), a2, voffA);
            PG8_BAR; PG8_WAIT_L(0); PG8_MMA(1, 0, At, B0); PG8_BAR; PG8_SCHED;
            PG8_STAGE(PG8_SB(0, 1), b2 + hstep, voffB);
            PG8_WAIT_V(6); PG8_BAR; PG8_MMA(1, 1, At, B1); PG8_BAR;
            PG8_LDB(B0, 1, 0); PG8_SCHED; PG8_LDA(At, 1, 0); PG8_STAGE(PG8_SA(0, 1), a2 + hstep, voffA);
            PG8_WAIT_L(8); PG8_BAR; PG8_WAIT_L(0); PG8_MMA(0, 0, At, B0); PG8_BAR; PG8_SCHED;
            PG8_LDB(B1, 1, 1); PG8_STAGE(PG8_SB(1, 0), b3, voffB);
            PG8_BAR; PG8_WAIT_L(0); PG8_MMA(0, 1, At, B1); PG8_BAR;
            PG8_LDA(At, 1, 1); PG8_STAGE(PG8_SA(1, 0), a3, voffA);
            PG8_BAR; PG8_WAIT_L(0); PG8_MMA(1, 0, At, B0); PG8_BAR; PG8_SCHED;
            PG8_STAGE(PG8_SB(1, 1), b3 + hstep, voffB);
            PG8_WAIT_V(6); PG8_BAR; PG8_MMA(1, 1, At, B1); PG8_BAR;
            }
        }
        if constexpr (ALIGN_EPI) { if (wr == 0) PG8_BAR; }
        if constexpr (!Epi::AFTER_DRAIN) { E(acc, cur, wr, wc, fr, fq); S.done(cur); }
        if (!has_next) break;
#pragma unroll
        for (int a = 0; a < 2; ++a)
#pragma unroll
            for (int b = 0; b < 2; ++b)
#pragma unroll
                for (int m = 0; m < 4; ++m)
#pragma unroll
                    for (int n = 0; n < 2; ++n) acc[a][b][m][n] = (f32x4){0.f, 0.f, 0.f, 0.f};
        cur = nxt; cA = nA; cB = nB; ++ui;
        if constexpr (ALIGN_EPI) { if (wr == 1) PG8_BAR; }
    }
    PG8_WAIT_V(0);
    if constexpr (!ALIGN_EPI) { if (wr == 0) PG8_BAR; }
    PG8_BAR;
    if constexpr (Epi::AFTER_DRAIN) { E.fused(acc, cur, wr, wc, fr, fq, lds, wid, lane); S.done(cur); }
#undef PG8_SA
#undef PG8_SB
#undef PG8_STAGE
#undef PG8_LDA
#undef PG8_LDB
#undef PG8_MMA
#undef PG8_WAIT_V
#undef PG8_WAIT_L
#undef PG8_BAR
#undef PG8_SCHED
}
}
#define GAS __attribute__((address_space(1)))
#define LAS __attribute__((address_space(3)))
typedef unsigned short bf16;
typedef unsigned v4u __attribute__((ext_vector_type(4)));
typedef float f32x4 __attribute__((ext_vector_type(4)));
typedef short bf16x8 __attribute__((ext_vector_type(8)));
typedef GAS unsigned gu32;
typedef GAS unsigned long long gu64;
#define RLX_AGENT __ATOMIC_RELAXED, __HIP_MEMORY_SCOPE_AGENT
#define LDS_WAIT() asm volatile("s_waitcnt lgkmcnt(0)" ::: "memory")
#define VM_WAIT() asm volatile("s_waitcnt vmcnt(0)" ::: "memory")
__device__ __forceinline__ unsigned long long rt() { return __builtin_amdgcn_s_memrealtime(); }
__device__ __forceinline__ unsigned f2bf(float f) { unsigned u = __builtin_bit_cast(unsigned, f); return (u + 0x7fffu + ((u >> 16) & 1u)) >> 16; }
__device__ __forceinline__ unsigned pk2(float lo, float hi) { return f2bf(lo) | (f2bf(hi) << 16); }

#define XB_TMO      128
#define XB_XCNT(j)  (256  + 64 * (j))
#define XB_XSUB(j)  (1280 + 64 * (j))
#define XB_XGEN(j)  (2304 + 64 * (j))
#define XB_TOP      3328
#define XB_TOPGEN   3392
#define XCD_BAR_WORDS 3456
#define XB_SPIN_CAP (1u << 18)

__device__ __forceinline__ unsigned xb_ld(unsigned* p)              { return __hip_atomic_load(p, __ATOMIC_RELAXED, __HIP_MEMORY_SCOPE_AGENT); }
__device__ __forceinline__ unsigned xb_add(unsigned* p, unsigned v) { return __hip_atomic_fetch_add(p, v, __ATOMIC_RELAXED, __HIP_MEMORY_SCOPE_AGENT); }
__device__ __forceinline__ unsigned xb_xcc_id() { return (unsigned)__builtin_amdgcn_s_getreg((3 << 11) | 20) & 0xFu; }
#define XB_SPIN(cond, bar) do { unsigned _sp = 0; while (cond) { __builtin_amdgcn_s_sleep(1); \
    if ((++_sp & 255u) == 0u) { if (xb_ld(&(bar)[XB_TMO])) break; if (_sp > XB_SPIN_CAP) { atomicAdd(&(bar)[XB_TMO], 1u); break; } } } } while (0)

struct XcdBarrier {
    unsigned* bar; unsigned x;
    volatile LAS unsigned* st;
};

__device__ __forceinline__ XcdBarrier xcd_barrier_post(unsigned* bar, volatile LAS unsigned* st) {
    XcdBarrier b; b.bar = bar; b.x = xb_xcc_id(); b.st = st;
    if (threadIdx.x == 0) (void)xb_add(&bar[XB_XCNT(b.x)], 1u);
    return b;
}
__device__ __forceinline__ void xcd_barrier_complete(unsigned* bar, unsigned x, unsigned& nloc, unsigned& nx) {
    const unsigned G = gridDim.x * gridDim.y * gridDim.z;
    unsigned sum, cnt, mine, sp = 0u;
    for (;;) {
        sum = 0u; cnt = 0u; mine = 0u;
#pragma unroll
        for (unsigned j = 0; j < 16; ++j) { const unsigned c = xb_ld(&bar[XB_XCNT(j)]); sum += c; cnt += (c > 0u) ? 1u : 0u; mine = (j == x) ? c : mine; }
        if (sum == G) break;
        __builtin_amdgcn_s_sleep(1);
        if ((++sp & 255u) == 0u) { if (xb_ld(&bar[XB_TMO])) break; if (sp > XB_SPIN_CAP) { atomicAdd(&bar[XB_TMO], 1u); break; } }
    }
    nloc = mine > 0u ? mine : 1u; nx = cnt > 0u ? cnt : 1u;
}

__device__ __forceinline__ void xcd_barrier(const XcdBarrier& b) {
    asm volatile("s_waitcnt vmcnt(0)" ::: "memory");
    __syncthreads();
    if (threadIdx.x == 0) {
        unsigned* bar = b.bar;
        __builtin_amdgcn_s_waitcnt(0);
        unsigned nloc = b.st[0], nx = b.st[1];
        if (nloc == 0u) { xcd_barrier_complete(bar, b.x, nloc, nx); b.st[0] = nloc; b.st[1] = nx; }
        const unsigned old = xb_add(&bar[XB_XSUB(b.x)], 1u);
        const unsigned gen = old / nloc;
        if (old + 1u == (gen + 1u) * nloc) {
            __builtin_amdgcn_fence(__ATOMIC_RELEASE, "agent");
            asm volatile("s_waitcnt vmcnt(0)" ::: "memory");
            const unsigned og = xb_add(&bar[XB_TOP], 1u);
            const unsigned tg = og / nx;
            if (og + 1u == (tg + 1u) * nx) xb_add(&bar[XB_TOPGEN], 1u);
            else XB_SPIN(xb_ld(&bar[XB_TOPGEN]) == tg, bar);
            __builtin_amdgcn_fence(__ATOMIC_ACQUIRE, "agent");
            xb_add(&bar[XB_XGEN(b.x)], 1u);
            asm volatile("s_waitcnt vmcnt(0)" ::: "memory");
        } else {
            XB_SPIN(xb_ld(&bar[XB_XGEN(b.x)]) == gen, bar);
            __builtin_amdgcn_fence(__ATOMIC_ACQUIRE, "agent");
            asm volatile("s_waitcnt vmcnt(0)" ::: "memory");
        }
    }
    __syncthreads();
}

constexpr int NWAVES = 8;
constexpr size_t MiB = 1u << 20;
constexpr size_t WS_CTL = 0, CTL_ZERO_BYTES = 8 * MiB;
constexpr int CW_BAR = 4096;
constexpr size_t RSS_OFF = 1 * MiB;
constexpr int RSS_PER_LAYER = 8, NRSS = DEPTH * RSS_PER_LAYER + 1;
static_assert(RSS_OFF + (size_t)NRSS * MTOK * 8 <= CTL_ZERO_BYTES && (CW_BAR + 3456) * 4 <= (int)RSS_OFF, "control region");
constexpr size_t E_WGU = (size_t)2 * D_FF * D_MODEL, E_WD = (size_t)D_MODEL * D_FF, E_WIN = (size_t)N_IN_PAD * D_MODEL, E_WUQ = (size_t)MLA_HEADS * MLA_QK * MLA_QR,
                 E_WUKV = (size_t)MLA_HEADS * 256 * MLA_KVR, E_WGLU = (size_t)SSM_WIDTH * SSM_WIDTH, E_WOUT = (size_t)D_MODEL * D_MIX;
constexpr size_t O_WGU1 = 0, O_WD1 = O_WGU1 + E_WGU, O_WIN = O_WD1 + E_WD, O_WUQ = O_WIN + E_WIN, O_WUKV = O_WUQ + E_WUQ, O_WGLU = O_WUKV + E_WUKV, O_WOUT = O_WGLU + E_WGLU,
                 O_WGU2 = O_WOUT + E_WOUT, O_WD2 = O_WGU2 + E_WGU, E_LAYER = O_WD2 + E_WD;
constexpr size_t WS_W = CTL_ZERO_BYTES;
constexpr size_t WS_XB = WS_W + (size_t)DEPTH * E_LAYER * 2;
constexpr size_t WS_ROPE = WS_XB + (size_t)MTOK * D_MODEL * 2;
constexpr size_t WS_SSMC = WS_ROPE + (size_t)MTOK * 32 * 4 * 2;
constexpr size_t SSMC_A = 0, SSMC_AT = 32 * 64 * 2, SSMC_BB = 2 * 32 * 64 * 2, SSMC_LAYER = SSMC_BB + 32 * 64 * 32;
constexpr size_t WS_SST = WS_SSMC + (size_t)DEPTH * SSMC_LAYER * 4;
constexpr size_t WS_ACT = WS_SST + (size_t)BATCH * 64 * 32 * 64 * 2 * 4;
constexpr size_t WS_U = WS_ACT;
constexpr size_t WS_QS = WS_U + (size_t)MTOK * 512 * 4, WS_KS = WS_QS + (size_t)MTOK * 512 * 2, WS_VS = WS_KS + (size_t)MTOK * 128 * 2, WS_CQ = WS_VS + (size_t)MTOK * 128 * 2,
                 WS_CKV = WS_CQ + (size_t)MTOK * 512 * 2, WS_KR = WS_CKV + (size_t)MTOK * 256 * 2, WS_QM = WS_KR + (size_t)MTOK * 64 * 2, WS_KVM = WS_QM + (size_t)MTOK * 1536 * 2,
                 WS_YCAT = WS_KVM + (size_t)MTOK * 2048 * 2, WS_MIXEND = WS_YCAT + (size_t)MTOK * 2048 * 2;
constexpr size_t WS_ACTEND = WS_ACT + (size_t)MTOK * D_FF * 2;
constexpr size_t WS_END = (WS_MIXEND > WS_ACTEND ? WS_MIXEND : WS_ACTEND);
static_assert(WS_W % 256 == 0 && WS_XB % 256 == 0 && WS_ROPE % 256 == 0 && WS_SSMC % 256 == 0 && WS_SST % 256 == 0 && WS_ACT % 256 == 0, "alignment");

constexpr int RING_BYTES = 139264;
constexpr int MISC_OFF = RING_BYTES;
constexpr int LDS_BYTES = 147456;
static_assert(MISC_OFF + 128 <= LDS_BYTES, "LDS map");

typedef unsigned short bf16_t;
typedef float f32x16 __attribute__((ext_vector_type(16)));
typedef short s16x4 __attribute__((ext_vector_type(4)));
typedef unsigned u32x4 __attribute__((ext_vector_type(4)));
typedef unsigned u32x2 __attribute__((ext_vector_type(2)));
using pg8::cvt_pk_bf16; using pg8::rss_t; using pg8::rss_enc; using pg8::rss_dec;
__device__ __forceinline__ float bf2f(unsigned short b) { return __uint_as_float((unsigned)b << 16); }
__device__ __forceinline__ float wave_sum(float v) {
#pragma unroll
    for (int o = 1; o < 64; o <<= 1) v += __shfl_xor(v, o);
    return v;
}
__device__ __forceinline__ int vzero() { int z; asm volatile("v_mov_b32 %0, 0" : "=v"(z)); return z; }

struct Frame {
    LAS unsigned char* lds;
    int tid, lane, wave;
    int vcu, G;
};

__device__ __forceinline__ void conv_item(const float* W, int ldw, int K, int src_col0, const float* gain, bf16_t* WT, int dst_row0, int k0, LAS float* scr, int lane) {
#pragma unroll 8
    for (int i = 0; i < 32; ++i) { const int kk = 2 * i + (lane >> 5); float v = W[(size_t)(k0 + kk) * ldw + src_col0 + (lane & 31)]; if (gain) v *= gain[k0 + kk]; scr[kk * 33 + (lane & 31)] = v; }
    LDS_WAIT(); asm volatile("" ::: "memory");
    const int c = lane & 7;
#pragma unroll
    for (int j = 0; j < 4; ++j) { const int n = (lane >> 3) + 8 * j; const LAS float* s = scr + (8 * c) * 33 + n;
        u32x4 o; o.x = cvt_pk_bf16(s[0 * 33], s[1 * 33]); o.y = cvt_pk_bf16(s[2 * 33], s[3 * 33]); o.z = cvt_pk_bf16(s[4 * 33], s[5 * 33]); o.w = cvt_pk_bf16(s[6 * 33], s[7 * 33]);
        *(u32x4*)(WT + (size_t)(dst_row0 + n) * K + k0 + 8 * c) = o; }
    LDS_WAIT(); asm volatile("" ::: "memory");
}
__device__ __forceinline__ void zero_item(bf16_t* WT, int K, int dst_row0, int k0, int lane) {
    const int c = lane & 7;
#pragma unroll
    for (int j = 0; j < 4; ++j) { const int n = (lane >> 3) + 8 * j; *(u32x4*)(WT + (size_t)(dst_row0 + n) * K + k0 + 8 * c) = (u32x4){0u, 0u, 0u, 0u}; }
}
__device__ __forceinline__ int win_src_col(int db) {
    const int t = db >> 3, j = db & 7;
    if (t < 2) return db * 32;
    if (t < 4) return 512 + ((t - 2) * 4 + (j & 3)) * 64 + (j >> 2) * 32;
    if (t == 4) { if ((j & 3) < 2) return 1024 + (j & 3) * 64 + (j >> 2) * 32;
                  return 1152 + (j >> 2) * 64 + ((j & 3) - 2) * 32; }
    if (t < 8) return 1280 + (db - 40) * 32;
    if (j == 0) return 2048; if (j == 4) return 2080;
    return -1;
}
__device__ __forceinline__ int wuq_src_col(int db) {
    const int t = db >> 3, j = db & 7;
    if (t < 4) return (2 * t + (j >> 2)) * MLA_QK + (j & 3) * 32;
    return ((t - 4) * 4 + (j & 3)) * MLA_QK + MLA_NOPE + (j >> 2) * 32;
}

enum ArgIdx { A_X = 0, A_POS, A_FFN1_NORM, A_FFN1_WG, A_FFN1_WU, A_FFN1_WD, A_MIX_NORM, A_W_IN, A_SSM_LOG_DT, A_SSM_A_RE, A_SSM_A_IM, A_SSM_B_RE, A_SSM_B_IM, A_SSM_C_RE, A_SSM_C_IM, A_SSM_D,
              A_SSM_W_GLU, A_SSM_B_GLU, A_SWA_SINKS, A_MLA_Q_NORM, A_MLA_W_UQ, A_MLA_KV_NORM, A_MLA_W_UKV, A_OUT_NORM, A_W_OUT, A_FFN2_NORM, A_FFN2_WG, A_FFN2_WU, A_FFN2_WD, A_FINAL_NORM, A_OUT, A_WS };
__device__ __forceinline__ const void* karg(int i) {
    unsigned long long v; asm volatile("s_load_dwordx2 %0, %1, %2\n\ts_waitcnt lgkmcnt(0)" : "=s"(v) : "s"(__builtin_amdgcn_kernarg_segment_ptr()), "i"(i * 8) : "memory");
    return (const void*)(const GAS unsigned char*)v; }
#define KF(i) ((const float*)karg(i))
struct Ptrs { int dummy; };
__device__ __forceinline__ unsigned char* wsbase() { return (unsigned char*)karg(A_WS); }
__device__ __forceinline__ bf16_t* wptr(const Ptrs&, int l, size_t off) { return (bf16_t*)(wsbase() + WS_W) + (size_t)l * E_LAYER + off; }
__device__ __forceinline__ rss_t* rssptr(const Ptrs&, int idx) { return (rss_t*)(wsbase() + RSS_OFF) + (size_t)idx * MTOK; }

#define CONV_LOOP(nitems, ...) do { const int _n = (nitems); int _s = (gw - (int)(base % (unsigned)NGW)); if (_s < 0) _s += NGW; for (int it = _s; it < _n; it += NGW) { __VA_ARGS__; } base += (unsigned)_n; } while (0)

__device__ __forceinline__ void p0_prologue(const Frame& F, const Ptrs& P) {
    LAS float* scr = (LAS float*)(F.lds + F.wave * 16384);
    const int gw = F.vcu * NWAVES + F.wave, NGW = F.G * NWAVES, lane = F.lane + vzero();
    unsigned base = 0;
    for (int l = 0; l < DEPTH; ++l) {
        for (int f = 0; f < 2; ++f) {
            const float* wg = (f ? KF(A_FFN2_WG) : KF(A_FFN1_WG)) + (size_t)l * D_MODEL * D_FF; const float* wu = (f ? KF(A_FFN2_WU) : KF(A_FFN1_WU)) + (size_t)l * D_MODEL * D_FF;
            const float* gn = (f ? KF(A_FFN2_NORM) : KF(A_FFN1_NORM)) + (size_t)l * D_MODEL; bf16_t* dst = wptr(P, l, f ? O_WGU2 : O_WGU1);
            CONV_LOOP((2 * D_FF / 32) * (D_MODEL / 64), { const int db = it / (D_MODEL / 64), kb = it % (D_MODEL / 64); const int t = db >> 3, j = db & 7;
                conv_item((j < 4) ? wg : wu, D_FF, D_MODEL, t * 128 + (j & 3) * 32, gn, dst, db * 32, kb * 64, scr, lane); });
            const float* wd = (f ? KF(A_FFN2_WD) : KF(A_FFN1_WD)) + (size_t)l * D_FF * D_MODEL; bf16_t* dd = wptr(P, l, f ? O_WD2 : O_WD1);
            CONV_LOOP((D_MODEL / 32) * (D_FF / 64), { const int db = it / (D_FF / 64), kb = it % (D_FF / 64); conv_item(wd, D_MODEL, D_FF, db * 32, nullptr, dd, db * 32, kb * 64, scr, lane); });
        }
        { const float* w = KF(A_W_IN) + (size_t)l * D_MODEL * N_IN; const float* gn = KF(A_MIX_NORM) + (size_t)l * D_MODEL; bf16_t* dst = wptr(P, l, O_WIN);
          CONV_LOOP((N_IN_PAD / 32) * (D_MODEL / 64), { const int db = it / (D_MODEL / 64), kb = it % (D_MODEL / 64); const int sc = win_src_col(db);
              if (sc >= 0) conv_item(w, N_IN, D_MODEL, sc, gn, dst, db * 32, kb * 64, scr, lane); else zero_item(dst, D_MODEL, db * 32, kb * 64, lane); }); }
        { const float* w = KF(A_MLA_W_UQ) + (size_t)l * MLA_QR * (MLA_HEADS * MLA_QK); const float* gn = KF(A_MLA_Q_NORM) + (size_t)l * MLA_QR; bf16_t* dst = wptr(P, l, O_WUQ);
          CONV_LOOP((MLA_HEADS * MLA_QK / 32) * (MLA_QR / 64), { const int db = it / (MLA_QR / 64), kb = it % (MLA_QR / 64);
              conv_item(w, MLA_HEADS * MLA_QK, MLA_QR, wuq_src_col(db), gn, dst, db * 32, kb * 64, scr, lane); }); }
        { const float* w = KF(A_MLA_W_UKV) + (size_t)l * MLA_KVR * 2048; const float* gn = KF(A_MLA_KV_NORM) + (size_t)l * MLA_KVR; bf16_t* dst = wptr(P, l, O_WUKV);
          CONV_LOOP((2048 / 32) * (MLA_KVR / 64), { const int db = it / (MLA_KVR / 64), kb = it % (MLA_KVR / 64); conv_item(w, 2048, MLA_KVR, db * 32, gn, dst, db * 32, kb * 64, scr, lane); }); }
        { const float* w = KF(A_SSM_W_GLU) + (size_t)l * SSM_WIDTH * SSM_WIDTH; bf16_t* dst = wptr(P, l, O_WGLU);
          CONV_LOOP((SSM_WIDTH / 32) * (SSM_WIDTH / 64), { const int db = it / (SSM_WIDTH / 64), kb = it % (SSM_WIDTH / 64); conv_item(w, SSM_WIDTH, SSM_WIDTH, db * 32, nullptr, dst, db * 32, kb * 64, scr, lane); }); }
        { const float* w = KF(A_W_OUT) + (size_t)l * D_MIX * D_MODEL; const float* gn = KF(A_OUT_NORM) + (size_t)l * D_MIX; bf16_t* dst = wptr(P, l, O_WOUT);
          CONV_LOOP((D_MODEL / 32) * (D_MIX / 64), { const int db = it / (D_MIX / 64), kb = it % (D_MIX / 64); conv_item(w, D_MODEL, D_MIX, db * 32, gn, dst, db * 32, kb * 64, scr, lane); }); }
    }
    { rss_t* rss0 = rssptr(P, 0); bf16_t* XB = (bf16_t*)(wsbase() + WS_XB);
      for (int m = gw; m < MTOK; m += NGW) { const f32x4* xr = (const f32x4*)(KF(A_X) + (size_t)m * D_MODEL) + lane; float s = 0.f; u32x2* o8 = (u32x2*)(XB + (size_t)m * D_MODEL) + lane;
#pragma unroll
          for (int j = 0; j < 8; ++j) { const f32x4 v = xr[64 * j]; s += (v[0] * v[0] + v[1] * v[1]) + (v[2] * v[2] + v[3] * v[3]); u32x2 w; w.x = cvt_pk_bf16(v[0], v[1]); w.y = cvt_pk_bf16(v[2], v[3]); o8[64 * j] = w; }
          s = wave_sum(s); if (lane == 0) rss0[m] = rss_enc(s); } }
    { float* cs = (float*)(wsbase() + WS_ROPE); float* sn = cs + (size_t)MTOK * 32; const int gt = gw * 64 + lane, NT = NGW * 64;
      for (int e = gt; e < MTOK * 32; e += NT) { const int row = e >> 5, i = e & 31; const float inv_freq = exp2f(-(float)i * (13.287712379549449f / 32.0f)); const float ang = (float)((const int*)karg(A_POS))[row] * inv_freq;
          float s, c; sincosf(ang, &s, &c); cs[e] = c; sn[e] = s; } }
    { const int gt = gw * 64 + lane, NT = NGW * 64;
      for (int e = gt; e < DEPTH * 32 * 64; e += NT) { const int l = e >> 11, gp = e & 2047, g = gp >> 6;
          float* C = (float*)(wsbase() + WS_SSMC) + (size_t)l * SSMC_LAYER;
          const double lr = (double)KF(A_SSM_A_RE)[e], li = (double)KF(A_SSM_A_IM)[e], dt = exp((double)KF(A_SSM_LOG_DT)[l * 32 + g]);
          const double mag = exp(lr * dt), ar = mag * cos(li * dt), ai = mag * sin(li * dt);
          const double magT = exp(lr * dt * 64.0), aTr = magT * cos(li * dt * 64.0), aTi = magT * sin(li * dt * 64.0);
          const double den = lr * lr + li * li, nr = ar - 1.0, qr = (nr * lr + ai * li) / den, qi = (ai * lr - nr * li) / den;
          C[SSMC_A + gp * 2] = (float)ar; C[SSMC_A + gp * 2 + 1] = (float)ai; C[SSMC_AT + gp * 2] = (float)aTr; C[SSMC_AT + gp * 2 + 1] = (float)aTi;
          const float* br = KF(A_SSM_B_RE) + (size_t)e * 16; const float* bi = KF(A_SSM_B_IM) + (size_t)e * 16; float* bb = C + SSMC_BB + (size_t)gp * 32;
          for (int c = 0; c < 16; ++c) { const double r = (double)br[c], im = (double)bi[c]; bb[c] = (float)(qr * r - qi * im); bb[16 + c] = (float)(qr * im + qi * r); } } }
}

__device__ __forceinline__ int crow(int r, int hi) { return (r & 3) + 8 * (r >> 2) + 4 * hi; }
__device__ __forceinline__ s16x4 vtr(const LAS unsigned char* p) { typedef short v4i16_t __attribute__((ext_vector_type(4))); return __builtin_bit_cast(s16x4, __builtin_amdgcn_ds_read_tr16_b64_v4i16((LAS v4i16_t*)p)); }

template <int DK, int DK1, int DV, bool WIN>
__device__ __forceinline__ void attn_unit(const Frame& F, const bf16_t* __restrict__ Q, int qld, const bf16_t* __restrict__ K1, int k1ld, const bf16_t* __restrict__ K2, int k2ld,
                                          const bf16_t* __restrict__ V, int vld, bf16_t* __restrict__ O, int old_, rss_t* __restrict__ rss, int rowbase, int q0, float m_init, float l_init) {
    constexpr int KROW = (DK + 8) * 2, VROW = (DV + 8) * 2, KBYTES = 64 * KROW, VBYTES = 64 * VROW, BUFB = KBYTES + VBYTES;
    constexpr int NKC = DK / 64, NVC = DV / 64, KCH = DK / 8, VCH = DV / 8;
    static_assert(2 * BUFB <= RING_BYTES, "attention tiles fit the phase scratch");
    const int zz = vzero();
    const int tid = F.tid + zz, lane = F.lane + zz, wid = F.wave, r = lane & 31, h = lane >> 5;
    LAS unsigned char* lds = F.lds;
    const int t_lo = WIN ? ((q0 >= SWA_WINDOW ? q0 - SWA_WINDOW : 0) >> 6) : 0, t_hi = (q0 + 256) >> 6;
    const bf16_t* ksrc[NKC]; int kdst[NKC]; int kld_[NKC]; const bf16_t* vsrc[NVC]; int vdst[NVC];
#pragma unroll
    for (int i = 0; i < NKC; ++i) { const int id = tid + i * 512, row = id / KCH, cc = id % KCH;
        ksrc[i] = (cc < DK1 / 8) ? K1 + (size_t)(rowbase + row) * k1ld + cc * 8 : K2 + (size_t)(rowbase + row) * k2ld + (cc - DK1 / 8) * 8; kdst[i] = row * KROW + cc * 16; kld_[i] = (cc < DK1 / 8) ? k1ld : k2ld; }
#pragma unroll
    for (int i = 0; i < NVC; ++i) { const int id = tid + i * 512, row = id / VCH, cc = id % VCH; vsrc[i] = V + (size_t)(rowbase + row) * vld + cc * 8; vdst[i] = KBYTES + row * VROW + cc * 16; }
    u32x4 kst[NKC], vst[NVC];
#define ATT_LOAD(t) do { _Pragma("unroll") for (int i = 0; i < NKC; ++i) kst[i] = *(const u32x4*)(ksrc[i] + (size_t)(t) * 64 * kld_[i]); \
                         _Pragma("unroll") for (int i = 0; i < NVC; ++i) vst[i] = *(const u32x4*)(vsrc[i] + (size_t)(t) * 64 * vld); } while (0)
#define ATT_STORE(buf) do { _Pragma("unroll") for (int i = 0; i < NKC; ++i) *(LAS u32x4*)(lds + (buf) * BUFB + kdst[i]) = kst[i]; \
                            _Pragma("unroll") for (int i = 0; i < NVC; ++i) *(LAS u32x4*)(lds + (buf) * BUFB + vdst[i]) = vst[i]; } while (0)
    ATT_LOAD(t_lo);
    bf16x8 qf[DK / 16];
    { const bf16_t* qrow = Q + (size_t)(rowbase + q0 + wid * 32 + r) * qld + 8 * h;
#pragma unroll
      for (int s = 0; s < DK / 16; ++s) qf[s] = *(const bf16x8*)(qrow + 16 * s); }
    f32x16 o[DV / 32];
#pragma unroll
    for (int i = 0; i < DV / 32; ++i)
#pragma unroll
        for (int e = 0; e < 16; ++e) o[i][e] = 0.f;
    float m_run = m_init, l_run = (h == 0) ? l_init : 0.f;
    const int qpos = q0 + wid * 32 + r, wq0 = q0 + wid * 32;
    ATT_STORE(0);
    __syncthreads();
    for (int t = t_lo; t < t_hi; ++t) {
        const int cur = (t - t_lo) & 1;
        if (t + 1 < t_hi) ATT_LOAD(t + 1);
        const int kb0 = 64 * t;
        const bool active = (kb0 <= wq0 + 31) && (!WIN || kb0 + 63 + SWA_WINDOW > wq0);
        if (active) {
            const LAS unsigned char* kb = lds + cur * BUFB + r * KROW + 16 * h;
            f32x16 p0, p1;
#pragma unroll
            for (int e = 0; e < 16; ++e) { p0[e] = 0.f; p1[e] = 0.f; }
#pragma unroll
            for (int s = 0; s < DK / 16; ++s) { const bf16x8 k0 = *(const LAS bf16x8*)(kb + 32 * s), k1 = *(const LAS bf16x8*)(kb + 32 * KROW + 32 * s);
                p0 = __builtin_amdgcn_mfma_f32_32x32x16_bf16(k0, qf[s], p0, 0, 0, 0); p1 = __builtin_amdgcn_mfma_f32_32x32x16_bf16(k1, qf[s], p1, 0, 0, 0); }
            const bool need_mask = (kb0 + 63 > wq0) || (WIN && kb0 + SWA_WINDOW <= wq0 + 31);
            if (need_mask) {
                const float NEG = -__builtin_inff();
#pragma unroll
                for (int e = 0; e < 16; ++e) { const int d0 = qpos - (kb0 + crow(e, h)), d1 = d0 - 32;
                    if (d0 < 0 || (WIN && d0 >= SWA_WINDOW)) p0[e] = NEG;
                    if (d1 < 0 || (WIN && d1 >= SWA_WINDOW)) p1[e] = NEG; }
            }
            float mx = p0[0];
#pragma unroll
            for (int e = 1; e < 16; ++e) mx = fmaxf(mx, p0[e]);
#pragma unroll
            for (int e = 0; e < 16; ++e) mx = fmaxf(mx, p1[e]);
            mx = fmaxf(mx, __shfl_xor(mx, 32));
            const float mn = fmaxf(m_run, mx), alpha = __builtin_amdgcn_exp2f(m_run - mn);
            m_run = mn;
            float ps = 0.f;
#pragma unroll
            for (int e = 0; e < 16; ++e) { p0[e] = __builtin_amdgcn_exp2f(p0[e] - mn); p1[e] = __builtin_amdgcn_exp2f(p1[e] - mn); ps += p0[e] + p1[e]; }
            l_run = l_run * alpha + ps;
#pragma unroll
            for (int i = 0; i < DV / 32; ++i)
#pragma unroll
                for (int e = 0; e < 16; ++e) o[i][e] *= alpha;
            bf16x8 pb[4];
#pragma unroll
            for (int ks = 0; ks < 4; ++ks) { const int b = (ks & 1) * 8; u32x4 w;
                if (ks < 2) { w.x = cvt_pk_bf16(p0[b], p0[b + 1]); w.y = cvt_pk_bf16(p0[b + 2], p0[b + 3]); w.z = cvt_pk_bf16(p0[b + 4], p0[b + 5]); w.w = cvt_pk_bf16(p0[b + 6], p0[b + 7]); }
                else        { w.x = cvt_pk_bf16(p1[b], p1[b + 1]); w.y = cvt_pk_bf16(p1[b + 2], p1[b + 3]); w.z = cvt_pk_bf16(p1[b + 4], p1[b + 5]); w.w = cvt_pk_bf16(p1[b + 6], p1[b + 7]); }
                pb[ks] = __builtin_bit_cast(bf16x8, w); }
            const LAS unsigned char* vb = lds + cur * BUFB + KBYTES + (4 * h + ((lane & 15) >> 2)) * VROW + (16 * ((lane >> 4) & 1) + 4 * (lane & 3)) * 2;
#pragma unroll
            for (int i = 0; i < DV / 32; ++i)
#pragma unroll
                for (int ks = 0; ks < 4; ++ks) { const s16x4 lo = vtr(vb + (16 * ks) * VROW + 64 * i), hi = vtr(vb + (16 * ks + 8) * VROW + 64 * i);
                    const bf16x8 vf = (bf16x8){lo[0], lo[1], lo[2], lo[3], hi[0], hi[1], hi[2], hi[3]};
                    o[i] = __builtin_amdgcn_mfma_f32_32x32x16_bf16(vf, pb[ks], o[i], 0, 0, 0); }
        }
        if (t + 1 < t_hi) ATT_STORE(cur ^ 1);
        __syncthreads();
    }
    const float lt = l_run + __shfl_xor(l_run, 32), inv = 1.0f / lt;
    float ss = 0.f;
    bf16_t* orow = O + (size_t)(rowbase + qpos) * old_;
#pragma unroll
    for (int i = 0; i < DV / 32; ++i)
#pragma unroll
        for (int g = 0; g < 4; ++g) { const float a = o[i][4 * g] * inv, b = o[i][4 * g + 1] * inv, c = o[i][4 * g + 2] * inv, d = o[i][4 * g + 3] * inv;
            ss += (a * a + b * b) + (c * c + d * d); u32x2 w; w.x = cvt_pk_bf16(a, b); w.y = cvt_pk_bf16(c, d); *(u32x2*)(orow + 32 * i + 8 * g + 4 * h) = w; }
    ss += __shfl_xor(ss, 32);
    if (h == 0) atomicAdd(rss + rowbase + qpos, rss_enc(ss));
#undef ATT_LOAD
#undef ATT_STORE
}

constexpr int SSM_T = 64, SSM_NCH = SEQ / SSM_T;
__device__ __forceinline__ float gelu_tanh(float y) { const float z = 1.5957691216057308f * (y + 0.044715f * y * y * y); return y * __builtin_amdgcn_rcpf(1.0f + __builtin_amdgcn_exp2f(-z * LOG2E)); }

__device__ __forceinline__ void ssm_pass1(const Frame& F, const Ptrs& P, int l) {
    const int vz = vzero(); const int gw = F.vcu * NWAVES + F.wave, NGW = F.G * NWAVES, lane = F.lane + vz;
    const float* C = (const float*)(wsbase() + WS_SSMC) + (size_t)l * SSMC_LAYER; const float* U = (const float*)(wsbase() + WS_U); float* SST = (float*)(wsbase() + WS_SST);
    for (int task = gw; task < BATCH * SSM_NCH * SSM_GROUPS; task += NGW) {
        const int g = task & 31, c = (task >> 5) & (SSM_NCH - 1), b = task >> 11;
        const float ar = C[SSMC_A + (g * 64 + lane) * 2], ai = C[SSMC_A + (g * 64 + lane) * 2 + 1];
        f32x4 bb[8];
#pragma unroll
        for (int i = 0; i < 8; ++i) bb[i] = *(const f32x4*)(C + SSMC_BB + (size_t)(g * 64 + lane) * 32 + 4 * i);
        float xr = 0.f, xi = 0.f;
        const float* up = U + (size_t)(b * SEQ + c * SSM_T) * SSM_WIDTH + g * 16 + vz;
#pragma unroll 4
        for (int t = 0; t < SSM_T; ++t) {
            const f32x4 u0 = *(const f32x4*)(up + (size_t)t * SSM_WIDTH), u1 = *(const f32x4*)(up + (size_t)t * SSM_WIDTH + 4), u2 = *(const f32x4*)(up + (size_t)t * SSM_WIDTH + 8), u3 = *(const f32x4*)(up + (size_t)t * SSM_WIDTH + 12);
            float br = ar * xr - ai * xi, bi = ar * xi + ai * xr;
#pragma unroll
            for (int k = 0; k < 4; ++k) { br += bb[0][k] * u0[k] + bb[1][k] * u1[k] + bb[2][k] * u2[k] + bb[3][k] * u3[k]; bi += bb[4][k] * u0[k] + bb[5][k] * u1[k] + bb[6][k] * u2[k] + bb[7][k] * u3[k]; }
            xr = br; xi = bi;
        }
        float* s = SST + ((size_t)((b * SSM_NCH + c) * SSM_GROUPS + g) * 64 + lane) * 2; s[0] = xr; s[1] = xi;
    }
}

constexpr int SSM_YROW = 520;
constexpr int SSM_XROW = 130;
constexpr int SSM_LDS_Y = 0, SSM_LDS_X = SSM_T * SSM_YROW * 2, SSM_LDS_END = SSM_LDS_X + NWAVES * 16 * SSM_XROW * 4;
static_assert(SSM_LDS_END <= RING_BYTES && NWAVES * 16 * SSM_XROW * 4 >= SSM_T * SSM_YROW * 2, "SSM LDS map (the out tile reuses the state scratch)");
__device__ __forceinline__ void ssm_pass2_unit(const Frame& F, const Ptrs& P, int l, int b, int c) {
    const int vz = vzero(); const int lane = F.lane + vz, wid = F.wave;
    const float* C = (const float*)(wsbase() + WS_SSMC) + (size_t)l * SSMC_LAYER; const float* U = (const float*)(wsbase() + WS_U); const float* SST = (const float*)(wsbase() + WS_SST);
    LAS unsigned short* ybuf = (LAS unsigned short*)(F.lds + SSM_LDS_Y); LAS float* xs = (LAS float*)(F.lds + SSM_LDS_X) + wid * 16 * SSM_XROW;
    const int row0 = b * SEQ + c * SSM_T;
#pragma unroll 1
    for (int gi = 0; gi < 4; ++gi) {
        const int g = wid * 4 + gi;
        const float ar = C[SSMC_A + (g * 64 + lane) * 2], ai = C[SSMC_A + (g * 64 + lane) * 2 + 1], aTr = C[SSMC_AT + (g * 64 + lane) * 2], aTi = C[SSMC_AT + (g * 64 + lane) * 2 + 1];
        f32x4 bb[8];
#pragma unroll
        for (int i = 0; i < 8; ++i) bb[i] = *(const f32x4*)(C + SSMC_BB + (size_t)(g * 64 + lane) * 32 + 4 * i);
        float xr = 0.f, xi = 0.f;
        { const float* sp = SST + ((size_t)(b * SSM_NCH * SSM_GROUPS + g) * 64 + lane) * 2;
          for (int j = 0; j < c; ++j) { const float sr = sp[(size_t)j * SSM_GROUPS * 128], si = sp[(size_t)j * SSM_GROUPS * 128 + 1]; const float nr = aTr * xr - aTi * xi + sr, ni = aTr * xi + aTi * xr + si; xr = nr; xi = ni; } }
        float cm[32];
        { const float* cre = KF(A_SSM_C_RE) + ((size_t)(l * SSM_GROUPS + g) * 16 + (lane & 15)) * 64 + (lane >> 4); const float* cim = KF(A_SSM_C_IM) + ((size_t)(l * SSM_GROUPS + g) * 16 + (lane & 15)) * 64 + (lane >> 4);
#pragma unroll
          for (int s = 0; s < 16; ++s) { cm[s] = cre[4 * s]; cm[16 + s] = -cim[4 * s]; } }
        const float dsk = KF(A_SSM_D)[l * SSM_WIDTH + g * 16 + (lane & 15)];
        const float* up = U + (size_t)row0 * SSM_WIDTH + g * 16 + vz;
#pragma unroll 1
        for (int tb = 0; tb < 4; ++tb) {
#pragma unroll 4
            for (int tt = 0; tt < 16; ++tt) { const int t = tb * 16 + tt;
                const f32x4 u0 = *(const f32x4*)(up + (size_t)t * SSM_WIDTH), u1 = *(const f32x4*)(up + (size_t)t * SSM_WIDTH + 4), u2 = *(const f32x4*)(up + (size_t)t * SSM_WIDTH + 8), u3 = *(const f32x4*)(up + (size_t)t * SSM_WIDTH + 12);
                float br = ar * xr - ai * xi, bi = ar * xi + ai * xr;
#pragma unroll
                for (int k = 0; k < 4; ++k) { br += bb[0][k] * u0[k] + bb[1][k] * u1[k] + bb[2][k] * u2[k] + bb[3][k] * u3[k]; bi += bb[4][k] * u0[k] + bb[5][k] * u1[k] + bb[6][k] * u2[k] + bb[7][k] * u3[k]; }
                xr = br; xi = bi; xs[tt * SSM_XROW + lane] = xr; xs[tt * SSM_XROW + 64 + lane] = xi; }
            LDS_WAIT(); asm volatile("" ::: "memory");
            f32x4 ya = {0.f, 0.f, 0.f, 0.f}, yb = {0.f, 0.f, 0.f, 0.f};
            const LAS float* xa = xs + (lane & 15) * SSM_XROW + (lane >> 4);
#pragma unroll
            for (int s = 0; s < 32; s += 2) { ya = __builtin_amdgcn_mfma_f32_16x16x4f32(xa[4 * s], cm[s], ya, 0, 0, 0); yb = __builtin_amdgcn_mfma_f32_16x16x4f32(xa[4 * s + 4], cm[s + 1], yb, 0, 0, 0); }
#pragma unroll
            for (int i = 0; i < 4; ++i) { const int t = tb * 16 + 4 * (lane >> 4) + i; const float uv = U[(size_t)(row0 + t) * SSM_WIDTH + g * 16 + (lane & 15)];
                const float y = gelu_tanh(ya[i] + yb[i] + dsk * uv); ybuf[t * SSM_YROW + g * 16 + (lane & 15)] = (unsigned short)(cvt_pk_bf16(y, 0.f) & 0xffffu); }
            LDS_WAIT(); asm volatile("" ::: "memory");
        }
    }
    __syncthreads();
    const int lane2 = F.lane + vzero(); const int r = lane2 & 31, h = lane2 >> 5;
    f32x16 acc[2][2];
#pragma unroll
    for (int a = 0; a < 2; ++a)
#pragma unroll
        for (int q = 0; q < 2; ++q)
#pragma unroll
            for (int e = 0; e < 16; ++e) acc[a][q][e] = 0.f;
    const bf16_t* wg = wptr(P, l, O_WGLU) + (size_t)(wid * 64 + r) * SSM_WIDTH + 8 * h;
    const LAS unsigned short* ya_ = ybuf + r * SSM_YROW + 8 * h;
#pragma unroll 4
    for (int s = 0; s < 32; ++s) {
        const bf16x8 a0 = *(const LAS bf16x8*)(ya_ + 16 * s), a1 = *(const LAS bf16x8*)(ya_ + 32 * SSM_YROW + 16 * s);
        const bf16x8 b0 = *(const bf16x8*)(wg + 16 * s), b1 = *(const bf16x8*)(wg + (size_t)32 * SSM_WIDTH + 16 * s);
        acc[0][0] = __builtin_amdgcn_mfma_f32_32x32x16_bf16(a0, b0, acc[0][0], 0, 0, 0); acc[0][1] = __builtin_amdgcn_mfma_f32_32x32x16_bf16(a0, b1, acc[0][1], 0, 0, 0);
        acc[1][0] = __builtin_amdgcn_mfma_f32_32x32x16_bf16(a1, b0, acc[1][0], 0, 0, 0); acc[1][1] = __builtin_amdgcn_mfma_f32_32x32x16_bf16(a1, b1, acc[1][1], 0, 0, 0);
    }
    LAS unsigned short* obuf = (LAS unsigned short*)(F.lds + SSM_LDS_X);
    { const int lane3 = F.lane + vzero(); const int r = lane3 & 31, h = lane3 >> 5;
#pragma unroll
    for (int q = 0; q < 2; ++q) { const int col = wid * 64 + q * 32 + r; const float bg = KF(A_SSM_B_GLU)[l * SSM_WIDTH + col];
#pragma unroll
        for (int a = 0; a < 2; ++a)
#pragma unroll
            for (int e = 0; e < 16; ++e) { const int row = 32 * a + crow(e, h); const float y = bf2f(ybuf[row * SSM_YROW + col]); const float z = acc[a][q][e] + bg;
                const float ov = y * __builtin_amdgcn_rcpf(1.0f + __builtin_amdgcn_exp2f(-z * LOG2E)); obuf[row * SSM_YROW + col] = (unsigned short)(cvt_pk_bf16(ov, 0.f) & 0xffffu); } } }
    __syncthreads();
    bf16_t* Y = (bf16_t*)(wsbase() + WS_YCAT); rss_t* rss = rssptr(P, l * RSS_PER_LAYER + 5);
#pragma unroll
    for (int i = 0; i < 8; ++i) { const int row = wid * 8 + i; const u32x4 v = *(const LAS u32x4*)(obuf + row * SSM_YROW + 8 * lane);
        float ss = 0.f;
#pragma unroll
        for (int k = 0; k < 4; ++k) { const float lo = __uint_as_float(v[k] << 16), hi = __uint_as_float(v[k] & 0xffff0000u); ss += lo * lo + hi * hi; }
        ss = wave_sum(ss); *(u32x4*)(Y + (size_t)(row0 + row) * D_MIX + 8 * lane) = v; if (lane == 0) rss[row0 + row] = rss_enc(ss); }
    __syncthreads();
}

__device__ __forceinline__ void ycat_normalize(const Frame& F, const Ptrs& P, int l) {
    const int gw = F.vcu * NWAVES + F.wave, NGW = F.G * NWAVES, lane = F.lane + vzero();
    bf16_t* Y = (bf16_t*)(wsbase() + WS_YCAT); const rss_t* r0 = rssptr(P, l * RSS_PER_LAYER + 5) + vzero(); const rss_t* r1 = rssptr(P, l * RSS_PER_LAYER + 6) + vzero(); const rss_t* r2 = rssptr(P, l * RSS_PER_LAYER + 7) + vzero();
    for (int m = gw; m < MTOK; m += NGW) {
        const float s0 = __builtin_amdgcn_rsqf(rss_dec(r0[m]) * (1.0f / SSM_WIDTH) + EPS), s1 = __builtin_amdgcn_rsqf(rss_dec(r1[m]) * (1.0f / SWA_WIDTH) + EPS), s2 = __builtin_amdgcn_rsqf(rss_dec(r2[m]) * (1.0f / MLA_WIDTH) + EPS);
        u32x4* yr = (u32x4*)(Y + (size_t)m * D_MIX) + lane;
#pragma unroll
        for (int j = 0; j < 4; ++j) { const float sc = j == 0 ? s0 : (j == 1 ? s1 : s2); u32x4 v = yr[64 * j];
#pragma unroll
            for (int k = 0; k < 4; ++k) { const float lo = __uint_as_float(v[k] << 16) * sc, hi = __uint_as_float(v[k] & 0xffff0000u) * sc; v[k] = cvt_pk_bf16(lo, hi); }
            yr[64 * j] = v; }
    }
}
__device__ __forceinline__ void final_norm_phase(const Frame& F, const Ptrs& P) {
    const int gw = F.vcu * NWAVES + F.wave, NGW = F.G * NWAVES, lane = F.lane + vzero(); const rss_t* rs = rssptr(P, DEPTH * RSS_PER_LAYER) + vzero();
    for (int m = gw; m < MTOK; m += NGW) { const float sc = __builtin_amdgcn_rsqf(rss_dec(rs[m]) * (1.0f / D_MODEL) + EPS); f32x4* xr = (f32x4*)(((float*)karg(A_OUT)) + (size_t)m * D_MODEL) + lane; const f32x4* gn = (const f32x4*)KF(A_FINAL_NORM) + lane;
#pragma unroll
        for (int j = 0; j < 8; ++j) { const f32x4 v = xr[64 * j], g = gn[64 * j]; xr[64 * j] = v * sc * g; } }
}

#ifndef MK_PER_PHASE
#define MK_PER_PHASE 1
#endif
constexpr int PH_PER_LAYER = 9, N_PHASES = 1 + DEPTH * PH_PER_LAYER + 1;
struct Args { const void* in[30]; float* out; unsigned char* ws; int ph_lo, ph_hi, pad0, pad1; };
__global__ void __launch_bounds__(NWAVES * 64, 2) mk_fwd(Args args) {
    extern __shared__ __attribute__((aligned(16))) unsigned char lds_raw[];
    Frame F;
    F.lds = (LAS unsigned char*)lds_raw;
    F.tid = threadIdx.x; F.lane = F.tid & 63; F.wave = __builtin_amdgcn_readfirstlane(F.tid >> 6);
    F.G = gridDim.x; { const int bx = blockIdx.x; F.vcu = (F.G % 8 == 0) ? (bx % 8) * (F.G / 8) + bx / 8 : bx; }
    Ptrs P; P.dummy = 0;
    volatile LAS unsigned* MISC = (volatile LAS unsigned*)(F.lds + MISC_OFF);
    for (int u = F.tid; u < (LDS_BYTES - MISC_OFF) / 4; u += NWAVES * 64) ((LAS unsigned*)(F.lds + MISC_OFF))[u] = 0u;
    __syncthreads();
    const int lo = args.ph_lo, hi = args.ph_hi;
    XcdBarrier bar; bar.bar = (unsigned*)(wsbase() + WS_CTL) + CW_BAR; bar.x = 0; bar.st = nullptr;
    if (hi - lo > 1) bar = xcd_barrier_post((unsigned*)(wsbase() + WS_CTL) + CW_BAR, MISC + 8);
    int ph = 0;
#ifndef ONLY_K
#define ONLY_K -1
#endif
    int kk = 0;
#define PHASE_BEGIN if ((ONLY_K < 0 || ONLY_K == kk) && ph >= lo && ph < hi) {
#define PHASE_END   if (ph + 1 < hi) xcd_barrier(bar); } ++ph; ++kk;

#define XB ((bf16_t*)(wsbase() + WS_XB))
#define ACT ((bf16_t*)(wsbase() + WS_ACT))
#define YCAT ((bf16_t*)(wsbase() + WS_YCAT))
#define RCS ((const float*)(wsbase() + WS_ROPE))
#define RSN (RCS + (size_t)MTOK * 32)
#define UU ((float*)(wsbase() + WS_U))
#define QS ((bf16_t*)(wsbase() + WS_QS))
#define KS ((bf16_t*)(wsbase() + WS_KS))
#define VS ((bf16_t*)(wsbase() + WS_VS))
#define CQ ((bf16_t*)(wsbase() + WS_CQ))
#define CKV ((bf16_t*)(wsbase() + WS_CKV))
#define KR ((bf16_t*)(wsbase() + WS_KR))
#define QM ((bf16_t*)(wsbase() + WS_QM))
#define KVM ((bf16_t*)(wsbase() + WS_KVM))
#define KL(k) ({ int _k = (k); asm volatile("" : "+s"(_k)); _k; })

    #ifndef NO_P0
    PHASE_BEGIN p0_prologue(F, P); PHASE_END
#endif

    for (int l = 0; l < DEPTH; ++l) { kk = 1;
#define rss_l rssptr(P, l * RSS_PER_LAYER)
        PHASE_BEGIN { pg8::Gemm g{XB, wptr(P, l, O_WGU1), MTOK, 2 * D_FF, KL(D_MODEL)}; pg8::StaticOrder S; S.init(MTOK, 2 * D_FF, F.G, (int)blockIdx.x);
            pg8::EpiSwiGLU E{ACT, D_FF, rss_l + 0 * MTOK, 1.0f / D_MODEL}; pg8::gemm_phase<pg8::EpiSwiGLU, pg8::StaticOrder, true, true>(F.lds, g, S, E); } PHASE_END
        PHASE_BEGIN { pg8::Gemm g{ACT, wptr(P, l, O_WD1), MTOK, D_MODEL, KL(D_FF)}; pg8::StaticOrder S; S.init(MTOK, D_MODEL, F.G, (int)blockIdx.x);
            pg8::EpiResid E{l == 0 ? KF(A_X) : ((float*)karg(A_OUT)), ((float*)karg(A_OUT)), XB, rss_l + 1 * MTOK, 0.5f}; pg8::gemm_phase<pg8::EpiResid, pg8::StaticOrder, true, true>(F.lds, g, S, E); } PHASE_END
        PHASE_BEGIN { pg8::Gemm g{XB, wptr(P, l, O_WIN), MTOK, N_IN_PAD, KL(D_MODEL)}; pg8::StaticOrder S; S.init(MTOK, N_IN_PAD, F.G, (int)blockIdx.x);
            pg8::EpiWin E{rss_l + 1 * MTOK, RCS, RSN, UU, QS, KS, VS, CQ, CKV, KR, rss_l + 3 * MTOK, rss_l + 4 * MTOK, 0.125f * LOG2E};
            pg8::gemm_phase<pg8::EpiWin, pg8::StaticOrder, true, true>(F.lds, g, S, E); } PHASE_END
        PHASE_BEGIN {
#ifndef NO_UQ
            { pg8::Gemm g{CQ, wptr(P, l, O_WUQ), MTOK, MLA_HEADS * MLA_QK, KL(MLA_QR)}; pg8::StaticOrder S; S.init(MTOK, MLA_HEADS * MLA_QK, F.G, (int)blockIdx.x);
              pg8::EpiUq E{QM, rss_l + 3 * MTOK, RCS, RSN, 0.07216878364870322f * LOG2E}; pg8::gemm_phase<pg8::EpiUq, pg8::StaticOrder, true, true>(F.lds, g, S, E); }
#endif
#ifndef NO_UKV
            { pg8::Gemm g{CKV, wptr(P, l, O_WUKV), MTOK, 2048, KL(MLA_KVR)}; pg8::StaticOrder S; S.init(MTOK, 2048, F.G, (int)blockIdx.x);
              pg8::EpiBf16Rs E{KVM, 2048, rss_l + 4 * MTOK, 1.0f / MLA_KVR, 1.0f}; pg8::gemm_phase<pg8::EpiBf16Rs, pg8::StaticOrder, true, true>(F.lds, g, S, E); }
#endif
#ifndef NO_SSM1
            ssm_pass1(F, P, l);
#endif
        } PHASE_END
        PHASE_BEGIN {
#ifndef NO_MLA
            for (int u = F.vcu; u < 512; u += F.G) { const int half = u >> 8, v = u & 255, bh = v >> 3, s = v & 7, qb = half ? 15 - s : s, b = bh >> 3, hh = bh & 7;
                attn_unit<MLA_QK, MLA_NOPE, MLA_V, false>(F, QM + hh * MLA_QK, MLA_HEADS * MLA_QK, KVM + hh * 256, 2048, KR, MLA_ROPE, KVM + hh * 256 + 128, 2048,
                                                         YCAT + 1024 + hh * MLA_V, D_MIX, rss_l + 7 * MTOK, b * SEQ, qb * 256, -1e30f, 0.f); }
#endif
#ifndef NO_SWA
            for (int u = F.vcu; u < 512; u += F.G) { const int hq = u & 7, qb = (u >> 3) & 15, b = u >> 7, kvh = hq >> 2;
                attn_unit<SWA_HD, SWA_HD, SWA_HD, true>(F, QS + hq * SWA_HD, SWA_WIDTH, KS + kvh * SWA_HD, SWA_KV * SWA_HD, nullptr, 0, VS + kvh * SWA_HD, SWA_KV * SWA_HD,
                                                       YCAT + 512 + hq * SWA_HD, D_MIX, rss_l + 6 * MTOK, b * SEQ, qb * 256, KF(A_SWA_SINKS)[l * SWA_HEADS + hq] * LOG2E, 1.0f); }
#endif
#ifndef NO_SSM2
            for (int u = F.vcu; u < BATCH * SSM_NCH; u += F.G) ssm_pass2_unit(F, P, l, u >> 6, u & 63);
#endif
        } PHASE_END
        PHASE_BEGIN ycat_normalize(F, P, l); PHASE_END
        PHASE_BEGIN { pg8::Gemm g{YCAT, wptr(P, l, O_WOUT), MTOK, D_MODEL, KL(D_MIX)}; pg8::StaticOrder S; S.init(MTOK, D_MODEL, F.G, (int)blockIdx.x);
            pg8::EpiResid E{((float*)karg(A_OUT)), ((float*)karg(A_OUT)), XB, rss_l + 2 * MTOK, 1.0f}; pg8::gemm_phase<pg8::EpiResid, pg8::StaticOrder, true, true>(F.lds, g, S, E); } PHASE_END
        PHASE_BEGIN { pg8::Gemm g{XB, wptr(P, l, O_WGU2), MTOK, 2 * D_FF, KL(D_MODEL)}; pg8::StaticOrder S; S.init(MTOK, 2 * D_FF, F.G, (int)blockIdx.x);
            pg8::EpiSwiGLU E{ACT, D_FF, rss_l + 2 * MTOK, 1.0f / D_MODEL}; pg8::gemm_phase<pg8::EpiSwiGLU, pg8::StaticOrder, true, true>(F.lds, g, S, E); } PHASE_END
        PHASE_BEGIN { pg8::Gemm g{ACT, wptr(P, l, O_WD2), MTOK, D_MODEL, KL(D_FF)}; pg8::StaticOrder S; S.init(MTOK, D_MODEL, F.G, (int)blockIdx.x);
            pg8::EpiResid E{((float*)karg(A_OUT)), ((float*)karg(A_OUT)), XB, rss_l + RSS_PER_LAYER * MTOK, 0.5f}; pg8::gemm_phase<pg8::EpiResid, pg8::StaticOrder, true, true>(F.lds, g, S, E); } PHASE_END
    }
    kk = 10;
    PHASE_BEGIN final_norm_phase(F, P); PHASE_END
#undef PHASE_BEGIN
#undef PHASE_END
}

extern "C" void kernel_launch(void* const* d_in, const int* in_sizes, int n_in, void* d_out, int out_size, void* d_ws, size_t ws_size, hipStream_t stream) {
    static int grid = 0;
    if (grid == 0) {
        if (n_in != 30 || in_sizes[0] != MTOK * D_MODEL || out_size != MTOK * D_MODEL || ws_size < WS_END) {
            fprintf(stderr, "kernel_launch: built for 30 inputs, x/out of %d floats, >= %zu bytes of workspace; got n_in %d, in0 %d, out %d, ws %zu; nothing launched\n", MTOK * D_MODEL, (size_t)WS_END, n_in, n_in > 0 ? in_sizes[0] : -1, out_size, ws_size);
            grid = -1; return; }
        int dev = 0, cus = 0, per_cu = 0;
        if (hipGetDevice(&dev) != hipSuccess || hipDeviceGetAttribute(&cus, hipDeviceAttributeMultiprocessorCount, dev) != hipSuccess) { fprintf(stderr, "kernel_launch: device query failed\n"); grid = -1; return; }
        if (hipFuncSetAttribute((const void*)mk_fwd, hipFuncAttributeMaxDynamicSharedMemorySize, LDS_BYTES) != hipSuccess) { fprintf(stderr, "kernel_launch: hipFuncSetAttribute failed\n"); grid = -1; return; }
        if (hipOccupancyMaxActiveBlocksPerMultiprocessor(&per_cu, (const void*)mk_fwd, NWAVES * 64, LDS_BYTES) != hipSuccess || per_cu < 1)
            fprintf(stderr, "kernel_launch: note: occupancy query reports %d workgroups per CU\n", per_cu);
        (void)hipGetLastError();
        grid = cus;
    }
    if (grid < 0) return;
    if (hipMemsetAsync((char*)d_ws + WS_CTL, 0, CTL_ZERO_BYTES, stream) != hipSuccess) { fprintf(stderr, "kernel_launch: hipMemsetAsync failed\n"); return; }
    Args a{};
    for (int i = 0; i < 30; ++i) a.in[i] = d_in[i];
    a.out = (float*)d_out; a.ws = (unsigned char*)d_ws;
#if MK_PER_PHASE
    for (int p = 0; p < N_PHASES; ++p) { a.ph_lo = p; a.ph_hi = p + 1; hipLaunchKernelGGL(mk_fwd, dim3(grid), dim3(NWAVES * 64), LDS_BYTES, stream, a); }
#else
    a.ph_lo = 0; a.ph_hi = N_PHASES; hipLaunchKernelGGL(mk_fwd, dim3(grid), dim3(NWAVES * 64), LDS_BYTES, stream, a);
#endif
    const hipError_t le = hipPeekAtLastError();
    if (le != hipSuccess) fprintf(stderr, "kernel_launch: launch failed: %s\n", hipGetErrorName(le));
}
```

```cpp
#include <hip/hip_runtime.h>
#include <cstdio>
#include <cstdint>
#include <cmath>

constexpr int D_MODEL = 2048, BATCH = 4, SEQ = 4096, DEPTH = 4, D_FF = 5632;
constexpr int MTOK = BATCH * SEQ;
constexpr float EPS = 1e-6f;
constexpr int SSM_GROUP = 16, SSM_WIDTH = 512, SSM_GROUPS = 32, SSM_STATE = 64;
constexpr int SWA_HEADS = 8, SWA_KV = 2, SWA_HD = 64, SWA_WINDOW = 128, SWA_WIDTH = 512;
constexpr int MLA_HEADS = 8, MLA_QR = 512, MLA_KVR = 256, MLA_NOPE = 128, MLA_ROPE = 64, MLA_V = 128, MLA_WIDTH = 1024;
constexpr int D_MIX = 2048, N_IN = 2112, N_IN_PAD = 2304;
#ifndef WIN_MAIN_N
#define WIN_MAIN_N 2048
#endif
constexpr int MLA_QK = MLA_NOPE + MLA_ROPE;
constexpr float LOG2E = 1.4426950408889634f;
namespace pg8 {
#define PG8_LAS __attribute__((address_space(3)))
typedef unsigned short bf16_t;
typedef short bf16x8 __attribute__((ext_vector_type(8)));
typedef float f32x4 __attribute__((ext_vector_type(4)));
typedef unsigned u32x4 __attribute__((ext_vector_type(4)));
constexpr int BM = 256, BK = 64, HALF = 128, HTB = HALF * BK * 2  , STAGE_BYTES = 8 * HTB, NXCD = 8, WGM = 8;

__host__ __device__ __forceinline__ int lds_byte(int r, int c) { const int st = (r >> 4) * 2 + (c >> 5), rr = r & 15, cc = c & 31, ob = rr * 64 + cc * 2; return st * 1024 + (ob ^ (((ob >> 9) & 1) << 5)); }
__host__ __device__ __forceinline__ void stage_rc(int b, int& R, int& C) { const int st = b / 1024, sb = b % 1024, swz = sb ^ (((sb >> 9) & 1) << 5); R = (st >> 1) * 16 + swz / 64; C = (st & 1) * 32 + (swz % 64) / 2; }
__host__ __device__ __forceinline__ int perm32(int rho) { const int n = rho >> 4, i = rho & 15; return 8 * (i >> 2) + 4 * n + (i & 3); }

struct Unit { int pm, pn; };
struct Gemm { const bf16_t* A; const bf16_t* Bt; int M, N, K; };

struct StaticOrder {
    int nM, nN, nwg, G, c;
    __host__ __device__ void init(int M, int N, int G_, int c_) { nM = M / BM; nN = N / BM; nwg = nM * nN; G = G_; c = c_; }
    __host__ __device__ bool next(int i, Unit& u) const {
        const long L = (long)i * G + c; if (L >= nwg) return false;
        int wgid = (int)L; { const int q = nwg / NXCD, r = nwg % NXCD, xcd = wgid % NXCD, off = wgid / NXCD; wgid = (xcd < r ? xcd * (q + 1) : r * (q + 1) + (xcd - r) * q) + off; }
        const int nig = WGM * nN, gid = wgid / nig, fm = gid * WGM, gsz = (nM - fm) < WGM ? (nM - fm) : WGM;
        u.pm = fm + ((wgid % nig) % gsz); u.pn = (wgid % nig) / gsz; return true;
    }
    __device__ __forceinline__ void a_ready(const Unit&) const {}
    __device__ __forceinline__ void done(const Unit&) const {}
};

struct DealOrder {
    int first, stride, cnt, nN, pm0, pn0;
    __host__ __device__ bool next(int i, Unit& u) const { if (i >= cnt) return false; const int lu = first + i * stride; u.pm = pm0 + lu / nN; u.pn = pn0 + lu % nN; return true; }
    __device__ __forceinline__ void a_ready(const Unit&) const {}
    __device__ __forceinline__ void done(const Unit&) const {}
};

__device__ __forceinline__ unsigned cvt_pk_bf16(float lo, float hi) { unsigned r; asm("v_cvt_pk_bf16_f32 %0, %1, %2" : "=v"(r) : "v"(lo), "v"(hi)); return r; }
typedef float f32x2 __attribute__((ext_vector_type(2)));
__device__ __forceinline__ f32x2 gelu_pk(f32x2 v) {
    const f32x2 av = __builtin_elementwise_abs(v), d = av * 0.2316418882f + 1.0f;
    f32x2 t; t.x = __builtin_amdgcn_rcpf(d.x); t.y = __builtin_amdgcn_rcpf(d.y);
    f32x2 q = t * 0.5307027145f + (-0.7265760135f); q = q * t + 0.7107068705f; q = q * t + (-0.142248368f); q = q * t + 0.127414796f; q = q * t;
    const f32x2 s = (v * v) * (-0.72134752044f);
    f32x2 e; e.x = __builtin_amdgcn_exp2f(s.x); e.y = __builtin_amdgcn_exp2f(s.y);
    const f32x2 m = v * (q * e), r = v - m;
    f32x2 o; o.x = v.x < 0.f ? m.x : r.x; o.y = v.y < 0.f ? m.y : r.y; return o;
}

template <int ACT  > struct EpiBf16 {
    static constexpr bool PERM = true, AFTER_DRAIN = false; static_assert(ACT == 0 || ACT == 1, "EpiBf16: ACT is 0 (none) or 1 (gelu_pk)");
    bf16_t* O; int ldc; const float* bias; int split_cols; size_t split_stride; float scale0;
    __device__ __forceinline__ void operator()(const f32x4 (&acc)[2][2][4][2], const Unit& u, int wr, int wc, int fr, int fq) const {
        const int row0 = u.pm * BM + wr * 64 + fr; int colt = u.pn * BM; bf16_t* base = O;
        float sc = 1.f; if (split_cols) { const int t = colt / split_cols; base += (size_t)t * split_stride; colt -= t * split_cols; if (t == 0) sc = scale0; }
        const int col0 = colt + wc * 32 + 8 * fq, bcol0 = u.pn * BM + wc * 32 + 8 * fq;
        f32x4 bv[2][2];
#pragma unroll
        for (int bj = 0; bj < 2; ++bj)
#pragma unroll
            for (int n = 0; n < 2; ++n) bv[bj][n] = bias ? *(const f32x4*)(bias + bcol0 + bj * HALF + 4 * n) : (f32x4){0.f, 0.f, 0.f, 0.f};
#pragma unroll
        for (int ai = 0; ai < 2; ++ai)
#pragma unroll
            for (int m = 0; m < 4; ++m) { bf16_t* rowp = base + (size_t)(row0 + ai * HALF + m * 16) * ldc + col0;
#pragma unroll
                for (int bj = 0; bj < 2; ++bj) { f32x4 v0 = acc[ai][bj][m][0] + bv[bj][0], v1 = acc[ai][bj][m][1] + bv[bj][1];
                    if (ACT == 1) { f32x2 a = gelu_pk((f32x2){v0[0], v0[1]}), b = gelu_pk((f32x2){v0[2], v0[3]}), c = gelu_pk((f32x2){v1[0], v1[1]}), d = gelu_pk((f32x2){v1[2], v1[3]});
                        v0 = (f32x4){a.x, a.y, b.x, b.y}; v1 = (f32x4){c.x, c.y, d.x, d.y}; }
                    v0 = v0 * sc; v1 = v1 * sc; u32x4 w; w.x = cvt_pk_bf16(v0[0], v0[1]); w.y = cvt_pk_bf16(v0[2], v0[3]); w.z = cvt_pk_bf16(v1[0], v1[1]); w.w = cvt_pk_bf16(v1[2], v1[3]);
                    *(u32x4*)(rowp + bj * HALF) = w; } }
    }
};


typedef unsigned u32x2 __attribute__((ext_vector_type(2)));
__device__ __forceinline__ int epi_vz() { int z; asm volatile("v_mov_b32 %0, 0" : "=v"(z)); return z; }
__device__ __forceinline__ void store8_bf16(bf16_t* p, f32x4 v0, f32x4 v1) {
    u32x4 w; w.x = cvt_pk_bf16(v0[0], v0[1]); w.y = cvt_pk_bf16(v0[2], v0[3]); w.z = cvt_pk_bf16(v1[0], v1[1]); w.w = cvt_pk_bf16(v1[2], v1[3]); *(u32x4*)p = w;
}
#ifndef ACT_NT
#define ACT_NT 0
#endif
__device__ __forceinline__ void store8_bf16_nt(bf16_t* p, f32x4 v0, f32x4 v1) {
    u32x4 w; w.x = cvt_pk_bf16(v0[0], v0[1]); w.y = cvt_pk_bf16(v0[2], v0[3]); w.z = cvt_pk_bf16(v1[0], v1[1]); w.w = cvt_pk_bf16(v1[2], v1[3]);
    if (ACT_NT) __builtin_nontemporal_store(w, (u32x4*)p); else *(u32x4*)p = w;
}
__device__ __forceinline__ float sumsq8(f32x4 a, f32x4 b) { return (a[0] * a[0] + a[1] * a[1]) + (a[2] * a[2] + a[3] * a[3]) + (b[0] * b[0] + b[1] * b[1]) + (b[2] * b[2] + b[3] * b[3]); }
__device__ __forceinline__ float silu_mul(float g, float u) { return g * __builtin_amdgcn_rcpf(1.0f + __builtin_amdgcn_exp2f(-g * LOG2E)) * u; }
__device__ __forceinline__ f32x4 silu_mul4(f32x4 g, f32x4 u) {
    const f32x4 a = g * (-LOG2E); f32x4 e, r;
#pragma unroll
    for (int k = 0; k < 4; ++k) e[k] = __builtin_amdgcn_exp2f(a[k]);
    const f32x4 d = e + 1.0f;
#pragma unroll
    for (int k = 0; k < 4; ++k) r[k] = __builtin_amdgcn_rcpf(d[k]);
    return (g * r) * u;
}
typedef unsigned long long rss_t;
__device__ __forceinline__ rss_t rss_enc(float ss) { return (rss_t)(long long)((double)ss * 4294967296.0); }
__device__ __forceinline__ float rss_dec(rss_t v) { return (float)((double)(long long)v * (1.0 / 4294967296.0)); }
__device__ __forceinline__ void row_atomic(rss_t* dst, float ss, int fq) { ss += __shfl_xor(ss, 16); ss += __shfl_xor(ss, 32); if (fq == 0) atomicAdd(dst, rss_enc(ss)); }
__device__ __forceinline__ void row_scales8(const rss_t* rss, int row0, float invn, float mul, float (&rs)[8]) {
    rss_t v[8];
#pragma unroll
    for (int i = 0; i < 8; ++i) v[i] = rss[row0 + (i >> 2) * HALF + (i & 3) * 16];
#pragma unroll
    for (int i = 0; i < 8; ++i) rs[i] = __builtin_amdgcn_rsqf(rss_dec(v[i]) * invn + EPS) * mul;
}

struct EpiSwiGLU {
    static constexpr bool PERM = true, AFTER_DRAIN = false, INIT_ACC = false, KSEG = false;
    bf16_t* O; int ldc; const rss_t* rss; float invn;
    __device__ __forceinline__ void operator()(const f32x4 (&acc)[2][2][4][2], const Unit& u, int wr, int wc, int fr_, int fq_) const { const int ez = epi_vz(), fr = fr_ + ez, fq = fq_ + ez;
        const int row0 = u.pm * BM + wr * 64 + fr, col0 = u.pn * HALF + wc * 32 + 8 * fq;
        float rs8[8]; row_scales8(rss, row0, invn, 1.0f, rs8);
#pragma unroll
        for (int ai = 0; ai < 2; ++ai)
#pragma unroll
            for (int m = 0; m < 4; ++m) { const int row = row0 + ai * HALF + m * 16; const float rs = rs8[4 * ai + m];
                const f32x4 h0 = silu_mul4(acc[ai][0][m][0] * rs, acc[ai][1][m][0] * rs), h1 = silu_mul4(acc[ai][0][m][1] * rs, acc[ai][1][m][1] * rs);
                store8_bf16_nt(O + (size_t)row * ldc + col0, h0, h1); }
    }
};
#ifndef RESID_LO
#define RESID_LO 0
#endif
#ifndef RESID_BATCH16
#define RESID_BATCH16 0
#endif
__device__ __forceinline__ f32x4 bf_lo4(u32x2 w) { return (f32x4){__uint_as_float(w.x << 16), __uint_as_float(w.x & 0xffff0000u), __uint_as_float(w.y << 16), __uint_as_float(w.y & 0xffff0000u)}; }
__device__ __forceinline__ float resid8(bf16_t* xb, bf16_t* xl, size_t off, f32x4 d0, f32x4 d1) {
    const u32x4 hv = *(const u32x4*)(xb + off);
    f32x4 a0 = bf_lo4((u32x2){hv.x, hv.y}), a1 = bf_lo4((u32x2){hv.z, hv.w});
    if (RESID_LO) { const u32x4 lv = *(const u32x4*)(xl + off); a0 = a0 + bf_lo4((u32x2){lv.x, lv.y}); a1 = a1 + bf_lo4((u32x2){lv.z, lv.w}); }
    const f32x4 v0 = a0 + d0, v1 = a1 + d1;
    u32x4 w; w.x = cvt_pk_bf16(v0[0], v0[1]); w.y = cvt_pk_bf16(v0[2], v0[3]); w.z = cvt_pk_bf16(v1[0], v1[1]); w.w = cvt_pk_bf16(v1[2], v1[3]);
    *(u32x4*)(xb + off) = w;
    if (RESID_LO) { const f32x4 r0 = v0 - bf_lo4((u32x2){w.x, w.y}), r1 = v1 - bf_lo4((u32x2){w.z, w.w}); store8_bf16(xl + off, r0, r1); }
    return sumsq8(v0, v1);
}
__device__ __forceinline__ float resid8v(bf16_t* xb, size_t off, u32x4 hv, f32x4 d0, f32x4 d1) {
    static_assert(!RESID_LO, "batched residual epilogue: bf16-only residual stream");
    const f32x4 v0 = bf_lo4((u32x2){hv.x, hv.y}) + d0, v1 = bf_lo4((u32x2){hv.z, hv.w}) + d1;
    u32x4 w; w.x = cvt_pk_bf16(v0[0], v0[1]); w.y = cvt_pk_bf16(v0[2], v0[3]); w.z = cvt_pk_bf16(v1[0], v1[1]); w.w = cvt_pk_bf16(v1[2], v1[3]);
    *(u32x4*)(xb + off) = w;
    return sumsq8(v0, v1);
}
struct EpiResid {
    static constexpr bool PERM = true, AFTER_DRAIN = false, INIT_ACC = false, KSEG = false;
    bf16_t* xb; bf16_t* xl; rss_t* rss_out; float scale;
    __device__ __forceinline__ void init(f32x4 (&acc)[2][2][4][2], const Unit& u, int wr, int wc, int fr_, int fq_) const {}
    __device__ __forceinline__ void operator()(const f32x4 (&acc)[2][2][4][2], const Unit& u, int wr, int wc, int fr_, int fq_) const { const int ez = epi_vz(), fr = fr_ + ez, fq = fq_ + ez;
        const int row0 = u.pm * BM + wr * 64 + fr, col0 = u.pn * BM + wc * 32 + 8 * fq;
        u32x4 hv[2][4][2];
#if RESID_BATCH16
#pragma unroll
        for (int ai = 0; ai < 2; ++ai)
#pragma unroll
            for (int m = 0; m < 4; ++m)
#pragma unroll
                for (int bj = 0; bj < 2; ++bj) hv[ai][m][bj] = *(const u32x4*)(xb + (size_t)(row0 + ai * HALF + m * 16) * D_MODEL + col0 + bj * HALF);
#endif
#pragma unroll
        for (int ai = 0; ai < 2; ++ai) {
#if !RESID_BATCH16
#pragma unroll
            for (int m = 0; m < 4; ++m)
#pragma unroll
                for (int bj = 0; bj < 2; ++bj) hv[ai][m][bj] = *(const u32x4*)(xb + (size_t)(row0 + ai * HALF + m * 16) * D_MODEL + col0 + bj * HALF);
#endif
#pragma unroll
            for (int m = 0; m < 4; ++m) { const int row = row0 + ai * HALF + m * 16; const size_t off = (size_t)row * D_MODEL + col0; float ss = 0.f;
#pragma unroll
                for (int bj = 0; bj < 2; ++bj) ss += resid8v(xb, off + bj * HALF, hv[ai][m][bj], acc[ai][bj][m][0] * scale, acc[ai][bj][m][1] * scale);
                if (rss_out) row_atomic(rss_out + row, ss, fq); } }
    }
};
struct EpiResidSeg {
    static constexpr bool PERM = true, AFTER_DRAIN = false, INIT_ACC = false, KSEG = true;
    bf16_t* xb; bf16_t* xl; rss_t* rss_out; const rss_t* r0; const rss_t* r1; const rss_t* r2;
    __device__ __forceinline__ void init(f32x4 (&acc)[2][2][4][2], const Unit& u, int wr, int wc, int fr_, int fq_) const {}
    __device__ __forceinline__ bool seg_boundary(int t) const { return t == SSM_WIDTH / BK || t == (SSM_WIDTH + SWA_WIDTH) / BK; }
    __device__ __forceinline__ float rsc(const rss_t* r, int row, float invn) const { return __builtin_amdgcn_rsqf(rss_dec(r[row]) * invn + EPS); }
    __device__ __forceinline__ void rescale(f32x4 (&acc)[2][2][4][2], const Unit& u, int t, int wr, int wc, int fr_, int fq_) const { const int ez = epi_vz(), fr = fr_ + ez;
        const int row0 = u.pm * BM + wr * 64 + fr; const bool first = (t == SSM_WIDTH / BK);
        float fa[8], fb[8];
        row_scales8(first ? r0 : r1, row0, 1.0f / SSM_WIDTH, 1.0f, fa); row_scales8(first ? r1 : r2, row0, first ? 1.0f / SWA_WIDTH : 1.0f / MLA_WIDTH, 1.0f, fb);
        static_assert(SSM_WIDTH == SWA_WIDTH, "the first two segments share 1/n");
#pragma unroll
        for (int ai = 0; ai < 2; ++ai)
#pragma unroll
            for (int m = 0; m < 4; ++m) { const float f = fa[4 * ai + m] * __builtin_amdgcn_rcpf(fb[4 * ai + m]);
#pragma unroll
                for (int bj = 0; bj < 2; ++bj) { acc[ai][bj][m][0] = acc[ai][bj][m][0] * f; acc[ai][bj][m][1] = acc[ai][bj][m][1] * f; } }
    }
    __device__ __forceinline__ void operator()(const f32x4 (&acc)[2][2][4][2], const Unit& u, int wr, int wc, int fr_, int fq_) const { const int ez = epi_vz(), fr = fr_ + ez, fq = fq_ + ez;
        const int row0 = u.pm * BM + wr * 64 + fr, col0 = u.pn * BM + wc * 32 + 8 * fq;
        float rs8[8]; row_scales8(r2, row0, 1.0f / MLA_WIDTH, 1.0f, rs8);
        u32x4 hv[2][4][2];
#if RESID_BATCH16
#pragma unroll
        for (int ai = 0; ai < 2; ++ai)
#pragma unroll
            for (int m = 0; m < 4; ++m)
#pragma unroll
                for (int bj = 0; bj < 2; ++bj) hv[ai][m][bj] = *(const u32x4*)(xb + (size_t)(row0 + ai * HALF + m * 16) * D_MODEL + col0 + bj * HALF);
#endif
#pragma unroll
        for (int ai = 0; ai < 2; ++ai) {
#if !RESID_BATCH16
#pragma unroll
            for (int m = 0; m < 4; ++m)
#pragma unroll
                for (int bj = 0; bj < 2; ++bj) hv[ai][m][bj] = *(const u32x4*)(xb + (size_t)(row0 + ai * HALF + m * 16) * D_MODEL + col0 + bj * HALF);
#endif
#pragma unroll
            for (int m = 0; m < 4; ++m) { const int row = row0 + ai * HALF + m * 16; const size_t off = (size_t)row * D_MODEL + col0; float ss = 0.f; const float sc = rs8[4 * ai + m];
#pragma unroll
                for (int bj = 0; bj < 2; ++bj) ss += resid8v(xb, off + bj * HALF, hv[ai][m][bj], acc[ai][bj][m][0] * sc, acc[ai][bj][m][1] * sc);
                row_atomic(rss_out + row, ss, fq); } }
    }
};
struct EpiNull {
    static constexpr bool PERM = true, AFTER_DRAIN = false, INIT_ACC = false, KSEG = false;
    float* sink;
    __device__ __forceinline__ void init(f32x4 (&acc)[2][2][4][2], const Unit& u, int wr, int wc, int fr_, int fq_) const {}
    __device__ __forceinline__ void operator()(const f32x4 (&acc)[2][2][4][2], const Unit& u, int wr, int wc, int fr, int fq) const {
        float s = 0.f;
#pragma unroll
        for (int ai = 0; ai < 2; ++ai)
#pragma unroll
            for (int bj = 0; bj < 2; ++bj)
#pragma unroll
                for (int m = 0; m < 4; ++m) s += acc[ai][bj][m][0][0] + acc[ai][bj][m][1][3] + acc[ai][bj][m][0][2] + acc[ai][bj][m][1][1];
        if (s == 123.456f) sink[u.pm * 8 + u.pn] = s;
    }
};
struct EpiBf16Rs {
    static constexpr bool PERM = true, AFTER_DRAIN = false, INIT_ACC = false, KSEG = false;
    bf16_t* O; int ldc; const rss_t* rss; float invn; float scale;
    __device__ __forceinline__ void operator()(const f32x4 (&acc)[2][2][4][2], const Unit& u, int wr, int wc, int fr_, int fq_) const { const int ez = epi_vz(), fr = fr_ + ez, fq = fq_ + ez;
        const int row0 = u.pm * BM + wr * 64 + fr, col0 = u.pn * BM + wc * 32 + 8 * fq;
float rs8[8]; row_scales8(rss, row0, invn, scale, rs8);
#pragma unroll
        for (int ai = 0; ai < 2; ++ai)
#pragma unroll
            for (int m = 0; m < 4; ++m) { const int row = row0 + ai * HALF + m * 16; const float rs = rs8[4 * ai + m];
#pragma unroll
                for (int bj = 0; bj < 2; ++bj) store8_bf16(O + (size_t)row * ldc + col0 + bj * HALF, acc[ai][bj][m][0] * rs, acc[ai][bj][m][1] * rs); }
    }
};
__device__ __forceinline__ void rope8(const f32x4 x1a, const f32x4 x1b, const f32x4 x2a, const f32x4 x2b, const float* cs, const float* sn, int i0, float sc, bf16_t* o1, bf16_t* o2) {
    const f32x4 ca = *(const f32x4*)(cs + i0), cb = *(const f32x4*)(cs + i0 + 4), sa = *(const f32x4*)(sn + i0), sb = *(const f32x4*)(sn + i0 + 4);
    store8_bf16(o1, (x1a * ca - x2a * sa) * sc, (x1b * cb - x2b * sb) * sc);
    store8_bf16(o2, (x2a * ca + x1a * sa) * sc, (x2b * cb + x1b * sb) * sc);
}
struct RopeTb { f32x4 ca, cb, sa, sb; };
__device__ __forceinline__ RopeTb rope_load(const float* cs, const float* sn, int row, int i0) {
    RopeTb t; const float* c = cs + (size_t)row * 32 + i0; const float* s = sn + (size_t)row * 32 + i0; t.ca = *(const f32x4*)c; t.cb = *(const f32x4*)(c + 4); t.sa = *(const f32x4*)s; t.sb = *(const f32x4*)(s + 4); return t; }
__device__ __forceinline__ void rope8v(const f32x4 x1a, const f32x4 x1b, const f32x4 x2a, const f32x4 x2b, const RopeTb& t, float sc, bf16_t* o1, bf16_t* o2) {
    store8_bf16(o1, (x1a * t.ca - x2a * t.sa) * sc, (x1b * t.cb - x2b * t.sb) * sc);
    store8_bf16(o2, (x2a * t.ca + x1a * t.sa) * sc, (x2b * t.cb + x1b * t.sb) * sc);
}
struct EpiWin {
    static constexpr bool PERM = true, AFTER_DRAIN = false, INIT_ACC = false, KSEG = false;
    const rss_t* rss; const float* cs; const float* sn;
    float* U; bf16_t* QS; bf16_t* KS; bf16_t* VS; bf16_t* CQ; bf16_t* CKV; bf16_t* KR; rss_t* rss_cq; rss_t* rss_ckv; float qscale;
    __device__ __forceinline__ void operator()(const f32x4 (&acc)[2][2][4][2], const Unit& u, int wr, int wc, int fr_, int fq_) const { const int ez = epi_vz(), fr = fr_ + ez, fq = fq_ + ez;
        const int row0 = u.pm * BM + wr * 64 + fr, pn = u.pn, i0 = 8 * fq;
        if (pn == 8 && wc != 0) return;
        float rs8[8]; row_scales8(rss, row0, 1.0f / D_MODEL, 1.0f, rs8);
        const bool rope = (pn == 2) || (pn == 3) || (pn == 4 && wc < 2) || (pn == 8);
#pragma unroll
        for (int aim = 0; aim < 4; ++aim) { const int ai = aim >> 1; RopeTb tb[4];
            if (rope) {
#pragma unroll
                for (int m = 2 * (aim & 1); m < 2 * (aim & 1) + 2; ++m) tb[m] = rope_load(cs, sn, row0 + ai * HALF + m * 16, i0); }
#pragma unroll
            for (int m = 2 * (aim & 1); m < 2 * (aim & 1) + 2; ++m) { const int row = row0 + ai * HALF + m * 16; const float rs = rs8[4 * ai + m];
                const f32x4 a00 = acc[ai][0][m][0] * rs, a01 = acc[ai][0][m][1] * rs, a10 = acc[ai][1][m][0] * rs, a11 = acc[ai][1][m][1] * rs;
                if (pn < 2) { float* p = U + (size_t)row * SSM_WIDTH + pn * BM + wc * 32 + 8 * fq;
                    *(f32x4*)p = a00; *(f32x4*)(p + 4) = a01; *(f32x4*)(p + HALF) = a10; *(f32x4*)(p + HALF + 4) = a11; }
                else if (pn < 4) { bf16_t* p = QS + (size_t)row * SWA_WIDTH + ((pn - 2) * 4 + wc) * SWA_HD + i0;
                    rope8v(a00, a01, a10, a11, tb[m], qscale, p, p + 32); }
                else if (pn == 4) {
                    if (wc < 2) { bf16_t* p = KS + (size_t)row * (SWA_KV * SWA_HD) + wc * SWA_HD + i0; rope8v(a00, a01, a10, a11, tb[m], 1.0f, p, p + 32); }
                    else { bf16_t* p = VS + (size_t)row * (SWA_KV * SWA_HD) + (wc - 2) * 32 + i0; store8_bf16(p, a00, a01); store8_bf16(p + 64, a10, a11); } }
                else if (pn < 7) { bf16_t* p = CQ + (size_t)row * MLA_QR + (pn - 5) * BM + wc * 32 + 8 * fq; store8_bf16(p, a00, a01); store8_bf16(p + HALF, a10, a11);
                    row_atomic(rss_cq + row, sumsq8(a00, a01) + sumsq8(a10, a11), fq); }
                else if (pn == 7) { bf16_t* p = CKV + (size_t)row * MLA_KVR + wc * 32 + 8 * fq; store8_bf16(p, a00, a01); store8_bf16(p + HALF, a10, a11);
                    row_atomic(rss_ckv + row, sumsq8(a00, a01) + sumsq8(a10, a11), fq); }
                else { bf16_t* p = KR + (size_t)row * MLA_ROPE + i0; rope8v(a00, a01, a10, a11, tb[m], 1.0f, p, p + 32); }
            } }
    }
};
struct EpiUq {
    static constexpr bool PERM = true, AFTER_DRAIN = false, INIT_ACC = false, KSEG = false;
    bf16_t* QM; const rss_t* rss; const float* cs; const float* sn; float qscale;
    __device__ __forceinline__ void operator()(const f32x4 (&acc)[2][2][4][2], const Unit& u, int wr, int wc, int fr_, int fq_) const { const int ez = epi_vz(), fr = fr_ + ez, fq = fq_ + ez;
        const int row0 = u.pm * BM + wr * 64 + fr, pn = u.pn, i0 = 8 * fq;
        float rs8[8]; row_scales8(rss, row0, 1.0f / MLA_QR, 1.0f, rs8);
#pragma unroll
        for (int aim = 0; aim < 4; ++aim) { const int ai = aim >> 1; RopeTb tb[4];
            if (pn >= 4) {
#pragma unroll
                for (int m = 2 * (aim & 1); m < 2 * (aim & 1) + 2; ++m) tb[m] = rope_load(cs, sn, row0 + ai * HALF + m * 16, i0); }
#pragma unroll
            for (int m = 2 * (aim & 1); m < 2 * (aim & 1) + 2; ++m) { const int row = row0 + ai * HALF + m * 16; const float rs = rs8[4 * ai + m];
                bf16_t* qrow = QM + (size_t)row * (MLA_HEADS * MLA_QK);
                if (pn < 4) { const float s = rs * qscale;
                    store8_bf16(qrow + (2 * pn) * MLA_QK + wc * 32 + 8 * fq, acc[ai][0][m][0] * s, acc[ai][0][m][1] * s);
                    store8_bf16(qrow + (2 * pn + 1) * MLA_QK + wc * 32 + 8 * fq, acc[ai][1][m][0] * s, acc[ai][1][m][1] * s); }
                else { bf16_t* p = qrow + ((pn - 4) * 4 + wc) * MLA_QK + MLA_NOPE + i0;
                    rope8v(acc[ai][0][m][0] * rs, acc[ai][0][m][1] * rs, acc[ai][1][m][0] * rs, acc[ai][1][m][1] * rs, tb[m], qscale, p, p + 32); }
            } }
    }
};
template <class Epi, class Sched, bool ALIGN_EPI = false, bool SP2 = false>
__device__ __forceinline__ void gemm_phase(PG8_LAS unsigned char* lds, const Gemm g, const Sched& S, const Epi& E) {
    int tid_z; asm volatile("v_mov_b32 %0, 0" : "=v"(tid_z));
    const int tid = threadIdx.x + tid_z, wid = __builtin_amdgcn_readfirstlane(tid >> 6), lane = tid & 63, wr = wid >> 2, wc = wid & 3, fr = lane & 15, fq = lane >> 4;
    const int K = g.K, nt = K / BK;
    unsigned voffA[2], voffB[2];
#pragma unroll
    for (int i = 0; i < 2; ++i) { int R, C; stage_rc(tid * 16 + i * 8192, R, C); const int Rb = Epi::PERM ? ((R & ~31) + perm32(R & 31)) : R;
        voffA[i] = (unsigned)(R * K + C) * 2u; voffB[i] = (unsigned)(Rb * K + C) * 2u; }
    const size_t kstep = (size_t)(BK * 2);
    const size_t hstep = (size_t)HALF * K * 2;
    const size_t tstep = 2 * hstep;
    const unsigned ldsw = (unsigned)wid * 1024u;
    const int aoff = lds_byte(wr * 64 + fr, fq * 8), boff = lds_byte(wc * 32 + fr, fq * 8);
#define PG8_SA(b, h) (((b) * 2 + (h)) * HTB)
#define PG8_SB(b, h) ((4 + (b) * 2 + (h)) * HTB)
#define PG8_STAGE(bufoff, gbase, voff) do { _Pragma("unroll") for (int _i = 0; _i < 2; ++_i) \
        __builtin_amdgcn_global_load_lds((const unsigned*)((const char*)(gbase) + (voff)[_i]), (PG8_LAS unsigned*)(lds + (bufoff) + ldsw + _i * 8192), 16, 0, 0); } while (0)
#define PG8_LDA(dst, b, h) do { _Pragma("unroll") for (int m = 0; m < 4; ++m) _Pragma("unroll") for (int k = 0; k < 2; ++k) dst[m][k] = *(const PG8_LAS bf16x8*)(lds + PG8_SA(b, h) + aoff + m * 2048 + k * 1024); } while (0)
#define PG8_LDB(dst, b, h) do { _Pragma("unroll") for (int n = 0; n < 2; ++n) _Pragma("unroll") for (int k = 0; k < 2; ++k) dst[n][k] = *(const PG8_LAS bf16x8*)(lds + PG8_SB(b, h) + boff + n * 2048 + k * 1024); } while (0)
#define PG8_MMA(ai, bj, At, Bt) do { __builtin_amdgcn_s_setprio(1); _Pragma("unroll") for (int m = 0; m < 4; ++m) _Pragma("unroll") for (int n = 0; n < 2; ++n) _Pragma("unroll") for (int k = 0; k < 2; ++k) \
        acc[ai][bj][m][n] = __builtin_amdgcn_mfma_f32_16x16x32_bf16(Bt[n][k], At[m][k], acc[ai][bj][m][n], 0, 0, 0); __builtin_amdgcn_s_setprio(0); } while (0)
#define PG8_WAIT_V(n) asm volatile("s_waitcnt vmcnt(" #n ")" ::: "memory")
#define PG8_WAIT_L(n) asm volatile("s_waitcnt lgkmcnt(" #n ")" ::: "memory")
#define PG8_BAR __builtin_amdgcn_s_barrier()
#define PG8_SCHED __builtin_amdgcn_sched_barrier(0)
    Unit cur, nxt; int ui = 0;
    if (!S.next(0, cur)) return;
    f32x4 acc[2][2][4][2];
    if constexpr (Epi::INIT_ACC) E.init(acc, cur, wr, wc, fr, fq);
    else {
#pragma unroll
    for (int a = 0; a < 2; ++a)
#pragma unroll
        for (int b = 0; b < 2; ++b)
#pragma unroll
            for (int m = 0; m < 4; ++m)
#pragma unroll
                for (int n = 0; n < 2; ++n) acc[a][b][m][n] = (f32x4){0.f, 0.f, 0.f, 0.f};
    }
    bf16x8 At[4][2], B0[2][2], B1[2][2];
    const char* cA = (const char*)g.A + (size_t)cur.pm * tstep; const char* cB = (const char*)g.Bt + (size_t)cur.pn * tstep;
    S.a_ready(cur);
    if constexpr (SP2) {
        PG8_STAGE(PG8_SB(0, 0), cB, voffB); PG8_STAGE(PG8_SB(0, 1), cB + hstep, voffB); PG8_STAGE(PG8_SA(0, 0), cA, voffA); PG8_STAGE(PG8_SA(0, 1), cA + hstep, voffA);
        if (wr == 1) PG8_BAR;
        PG8_WAIT_V(2); PG8_BAR;
        PG8_STAGE(PG8_SB(1, 0), cB + kstep, voffB); PG8_STAGE(PG8_SA(1, 0), cA + kstep, voffA); PG8_STAGE(PG8_SB(1, 1), cB + hstep + kstep, voffB);
        PG8_WAIT_V(6); PG8_BAR;
    } else {
        PG8_STAGE(PG8_SB(0, 0), cB, voffB); PG8_STAGE(PG8_SA(0, 0), cA, voffA); PG8_STAGE(PG8_SB(0, 1), cB + hstep, voffB); PG8_STAGE(PG8_SA(0, 1), cA + hstep, voffA);
        if (wr == 1) PG8_BAR;
        PG8_WAIT_V(4); PG8_BAR;
        PG8_STAGE(PG8_SB(1, 0), cB + kstep, voffB); PG8_STAGE(PG8_SA(1, 0), cA + kstep, voffA); PG8_STAGE(PG8_SB(1, 1), cB + hstep + kstep, voffB);
        PG8_WAIT_V(6); PG8_BAR;
    }
    for (;;) {
        const bool has_next = S.next(ui + 1, nxt);
        const char* nA = has_next ? (const char*)g.A + (size_t)nxt.pm * tstep : cA; const char* nB = has_next ? (const char*)g.Bt + (size_t)nxt.pn * tstep : cB;
        for (int t = 0; t < nt; t += 2) {
            if constexpr (Epi::KSEG) { if (E.seg_boundary(t)) E.rescale(acc, cur, t, wr, wc, fr, fq); }
            const bool last = (t == nt - 2);
            const char* a1 = cA + (size_t)(t + 1) * kstep;
            const char* a2 = last ? nA : cA + (size_t)(t + 2) * kstep; const char* b2 = last ? nB : cB + (size_t)(t + 2) * kstep;
            const char* a3 = a2 + kstep; const char* b3 = b2 + kstep;
            if (last && has_next) S.a_ready(nxt);
            if constexpr (SP2) {
            PG8_LDB(B0, 0, 0); PG8_LDB(B1, 0, 1); PG8_SCHED; PG8_LDA(At, 0, 0); PG8_STAGE(PG8_SA(1, 1), a1 + hstep, voffA);
            PG8_WAIT_V(8); PG8_WAIT_L(0); PG8_BAR; PG8_MMA(0, 0, At, B0); PG8_MMA(0, 1, At, B1); PG8_BAR; PG8_SCHED;
            PG8_LDA(At, 0, 1); PG8_STAGE(PG8_SB(0, 0), b2, voffB); PG8_STAGE(PG8_SB(0, 1), b2 + hstep, voffB); PG8_STAGE(PG8_SA(0, 0), a2, voffA);
            PG8_WAIT_V(8); PG8_WAIT_L(0); PG8_BAR; PG8_MMA(1, 0, At, B0); PG8_MMA(1, 1, At, B1); PG8_BAR; PG8_SCHED;
            PG8_LDB(B0, 1, 0); PG8_LDB(B1, 1, 1); PG8_SCHED; PG8_LDA(At, 1, 0); PG8_STAGE(PG8_SA(0, 1), a2 + hstep, voffA);
            PG8_WAIT_V(8); PG8_WAIT_L(0); PG8_BAR; PG8_MMA(0, 0, At, B0); PG8_MMA(0, 1, At, B1); PG8_BAR; PG8_SCHED;
            PG8_LDA(At, 1, 1); PG8_STAGE(PG8_SB(1, 0), b3, voffB); PG8_STAGE(PG8_SB(1, 1), b3 + hstep, voffB); PG8_STAGE(PG8_SA(1, 0), a3, voffA);
            PG8_WAIT_V(8); PG8_WAIT_L(0); PG8_BAR; PG8_MMA(1, 0, At, B0); PG8_MMA(1, 1, At, B1); PG8_BAR; PG8_SCHED;
            } else {
            PG8_LDB(B0, 0, 0); PG8_SCHED; PG8_LDA(At, 0, 0); PG8_STAGE(PG8_SA(1, 1), a1 + hstep, voffA);
            PG8_WAIT_L(8); PG8_BAR; PG8_WAIT_L(0); PG8_MMA(0, 0, At, B0); PG8_BAR; PG8_SCHED;
            PG8_LDB(B1, 0, 1); PG8_STAGE(PG8_SB(0, 0), b2, voffB);
            PG8_BAR; PG8_WAIT_L(0); PG8_MMA(0, 1, At, B1); PG8_BAR;
            PG8_LDA(At, 0, 1); PG8_STAGE(PG8_SA(0, 0), a2, voffA);
            PG8_BAR; PG8_WAIT_L(0); PG8_MMA(1, 0, At, B0); PG8_BAR; PG8_SCHED;
            PG8_STAGE(PG8_SB(0, 1), b2 + hstep, voffB);
            PG8_WAIT_V(6); PG8_BAR; PG8_MMA(1, 1, At, B1); PG8_BAR;
            PG8_LDB(B0, 1, 0); PG8_SCHED; PG8_LDA(At, 1, 0); PG8_STAGE(PG8_SA(0, 1), a2 + hstep, voffA);
            PG8_WAIT_L(8); PG8_BAR; PG8_WAIT_L(0); PG8_MMA(0, 0, At, B0); PG8_BAR; PG8_SCHED;
            PG8_LDB(B1, 1, 1); PG8_STAGE(PG8_SB(1, 0), b3, voffB);
            PG8_BAR; PG8_WAIT_L(0); PG8_MMA(0, 1, At, B1); PG8_BAR;
            PG8_LDA(At, 1, 1); PG8_STAGE(PG8_SA(1, 0), a3, voffA);
            PG8_BAR; PG8_WAIT_L(0); PG8_MMA(1, 0, At, B0); PG8_BAR; PG8_SCHED;
            PG8_STAGE(PG8_SB(1, 1), b3 + hstep, voffB);
            PG8_WAIT_V(6); PG8_BAR; PG8_MMA(1, 1, At, B1); PG8_BAR;
            }
        }
        if constexpr (ALIGN_EPI) { if (wr == 0) PG8_BAR; }
        if constexpr (!Epi::AFTER_DRAIN) { E(acc, cur, wr, wc, fr, fq); S.done(cur); }
        if (!has_next) break;
        if constexpr (Epi::INIT_ACC) E.init(acc, nxt, wr, wc, fr, fq);
        else {
#pragma unroll
        for (int a = 0; a < 2; ++a)
#pragma unroll
            for (int b = 0; b < 2; ++b)
#pragma unroll
                for (int m = 0; m < 4; ++m)
#pragma unroll
                    for (int n = 0; n < 2; ++n) acc[a][b][m][n] = (f32x4){0.f, 0.f, 0.f, 0.f};
        }
        cur = nxt; cA = nA; cB = nB; ++ui;
        if constexpr (ALIGN_EPI) { if (wr == 1) PG8_BAR; }
    }
    PG8_WAIT_V(0);
    if constexpr (!ALIGN_EPI) { if (wr == 0) PG8_BAR; }
    PG8_BAR;
    if constexpr (Epi::AFTER_DRAIN) { E.fused(acc, cur, wr, wc, fr, fq, lds, wid, lane); S.done(cur); }
#undef PG8_SA
#undef PG8_SB
#undef PG8_STAGE
#undef PG8_LDA
#undef PG8_LDB
#undef PG8_MMA
#undef PG8_WAIT_V
#undef PG8_WAIT_L
#undef PG8_BAR
#undef PG8_SCHED
}
}
#define GAS __attribute__((address_space(1)))
#define LAS __attribute__((address_space(3)))
typedef unsigned short bf16;
typedef unsigned v4u __attribute__((ext_vector_type(4)));
typedef float f32x4 __attribute__((ext_vector_type(4)));
typedef short bf16x8 __attribute__((ext_vector_type(8)));
typedef GAS unsigned gu32;
typedef GAS unsigned long long gu64;
#define RLX_AGENT __ATOMIC_RELAXED, __HIP_MEMORY_SCOPE_AGENT
#define LDS_WAIT() asm volatile("s_waitcnt lgkmcnt(0)" ::: "memory")
#define VM_WAIT() asm volatile("s_waitcnt vmcnt(0)" ::: "memory")
__device__ __forceinline__ unsigned long long rt() { return __builtin_amdgcn_s_memrealtime(); }
__device__ __forceinline__ unsigned f2bf(float f) { unsigned u = __builtin_bit_cast(unsigned, f); return (u + 0x7fffu + ((u >> 16) & 1u)) >> 16; }
__device__ __forceinline__ unsigned pk2(float lo, float hi) { return f2bf(lo) | (f2bf(hi) << 16); }

#define XB_TMO      128
#define XB_XCNT(j)  (256  + 64 * (j))
#define XB_XSUB(j)  (1280 + 64 * (j))
#define XB_XGEN(j)  (2304 + 64 * (j))
#define XB_TOP      3328
#define XB_TOPGEN   3392
#define XCD_BAR_WORDS 3456
#define XB_SPIN_CAP (1u << 18)

__device__ __forceinline__ unsigned xb_ld(unsigned* p)              { return __hip_atomic_load(p, __ATOMIC_RELAXED, __HIP_MEMORY_SCOPE_AGENT); }
__device__ __forceinline__ unsigned xb_add(unsigned* p, unsigned v) { return __hip_atomic_fetch_add(p, v, __ATOMIC_RELAXED, __HIP_MEMORY_SCOPE_AGENT); }
__device__ __forceinline__ unsigned xb_xcc_id() { return (unsigned)__builtin_amdgcn_s_getreg((3 << 11) | 20) & 0xFu; }
#define XB_SPIN(cond, bar) do { unsigned _sp = 0; while (cond) { __builtin_amdgcn_s_sleep(1); \
    if ((++_sp & 255u) == 0u) { if (xb_ld(&(bar)[XB_TMO])) break; if (_sp > XB_SPIN_CAP) { atomicAdd(&(bar)[XB_TMO], 1u); break; } } } } while (0)

struct XcdBarrier {
    unsigned* bar; unsigned x;
    volatile LAS unsigned* st;
};

__device__ __forceinline__ XcdBarrier xcd_barrier_post(unsigned* bar, volatile LAS unsigned* st) {
    XcdBarrier b; b.bar = bar; b.x = xb_xcc_id(); b.st = st;
    if (threadIdx.x == 0) (void)xb_add(&bar[XB_XCNT(b.x)], 1u);
    return b;
}
__device__ __forceinline__ void xcd_barrier_complete(unsigned* bar, unsigned x, unsigned& nloc, unsigned& nx) {
    const unsigned G = gridDim.x * gridDim.y * gridDim.z;
    unsigned sum, cnt, mine, sp = 0u;
    for (;;) {
        sum = 0u; cnt = 0u; mine = 0u;
#pragma unroll
        for (unsigned j = 0; j < 16; ++j) { const unsigned c = xb_ld(&bar[XB_XCNT(j)]); sum += c; cnt += (c > 0u) ? 1u : 0u; mine = (j == x) ? c : mine; }
        if (sum == G) break;
        __builtin_amdgcn_s_sleep(1);
        if ((++sp & 255u) == 0u) { if (xb_ld(&bar[XB_TMO])) break; if (sp > XB_SPIN_CAP) { atomicAdd(&bar[XB_TMO], 1u); break; } }
    }
    nloc = mine > 0u ? mine : 1u; nx = cnt > 0u ? cnt : 1u;
}

__device__ __forceinline__ void xcd_barrier(const XcdBarrier& b) {
    asm volatile("s_waitcnt vmcnt(0)" ::: "memory");
    __syncthreads();
    if (threadIdx.x == 0) {
        unsigned* bar = b.bar;
        __builtin_amdgcn_s_waitcnt(0);
        unsigned nloc = b.st[0], nx = b.st[1];
        if (nloc == 0u) { xcd_barrier_complete(bar, b.x, nloc, nx); b.st[0] = nloc; b.st[1] = nx; }
        const unsigned old = xb_add(&bar[XB_XSUB(b.x)], 1u);
        const unsigned gen = old / nloc;
        if (old + 1u == (gen + 1u) * nloc) {
            __builtin_amdgcn_fence(__ATOMIC_RELEASE, "agent");
            asm volatile("s_waitcnt vmcnt(0)" ::: "memory");
            const unsigned og = xb_add(&bar[XB_TOP], 1u);
            const unsigned tg = og / nx;
            if (og + 1u == (tg + 1u) * nx) xb_add(&bar[XB_TOPGEN], 1u);
            else XB_SPIN(xb_ld(&bar[XB_TOPGEN]) == tg, bar);
            __builtin_amdgcn_fence(__ATOMIC_ACQUIRE, "agent");
            xb_add(&bar[XB_XGEN(b.x)], 1u);
            asm volatile("s_waitcnt vmcnt(0)" ::: "memory");
        } else {
            XB_SPIN(xb_ld(&bar[XB_XGEN(b.x)]) == gen, bar);
            __builtin_amdgcn_fence(__ATOMIC_ACQUIRE, "agent");
            asm volatile("s_waitcnt vmcnt(0)" ::: "memory");
        }
    }
    __syncthreads();
}

constexpr int NWAVES = 8;
constexpr size_t MiB = 1u << 20;
constexpr size_t WS_CTL = 0, CTL_ZERO_BYTES = 8 * MiB;
constexpr int CW_BAR = 4096;
constexpr size_t RSS_OFF = 1 * MiB;
constexpr int RSS_PER_LAYER = 8, NRSS = DEPTH * RSS_PER_LAYER + 1;
static_assert(RSS_OFF + (size_t)(NRSS + 2) * MTOK * 8 <= CTL_ZERO_BYTES && (CW_BAR + 3456) * 4 <= (int)RSS_OFF, "control region");
constexpr size_t E_WGU = (size_t)2 * D_FF * D_MODEL, E_WD = (size_t)D_MODEL * D_FF, E_WIN = (size_t)N_IN_PAD * D_MODEL, E_WUQ = (size_t)MLA_HEADS * MLA_QK * MLA_QR,
                 E_WUKV = (size_t)MLA_HEADS * 256 * MLA_KVR, E_WGLU = (size_t)SSM_WIDTH * SSM_WIDTH, E_WOUT = (size_t)D_MODEL * D_MIX;
constexpr size_t O_WGU1 = 0, O_WD1 = O_WGU1 + E_WGU, O_WIN = O_WD1 + E_WD, O_WUQ = O_WIN + E_WIN, O_WUKV = O_WUQ + E_WUQ, O_WGLU = O_WUKV + E_WUKV, O_WOUT = O_WGLU + E_WGLU,
                 O_WGU2 = O_WOUT + E_WOUT, O_WD2 = O_WGU2 + E_WGU, E_LAYER = O_WD2 + E_WD;
constexpr size_t WS_W = CTL_ZERO_BYTES;
constexpr size_t WS_XB = WS_W + (size_t)DEPTH * E_LAYER * 2;
constexpr size_t WS_XL = WS_XB + (size_t)MTOK * D_MODEL * 2;
constexpr size_t WS_ROPE = WS_XL + (size_t)MTOK * D_MODEL * 2;
constexpr size_t WS_SSMC = WS_ROPE + (size_t)MTOK * 32 * 4 * 2;
constexpr size_t SSMC_A = 0, SSMC_AT = 32 * 64 * 2, SSMC_BB = 2 * 32 * 64 * 2, SSMC_LAYER = SSMC_BB + 32 * 64 * 32;
constexpr size_t WS_SST = WS_SSMC + (size_t)DEPTH * SSMC_LAYER * 4;
constexpr size_t WS_ACT = WS_SST + (size_t)BATCH * 64 * 32 * 64 * 2 * 4;
constexpr size_t WS_U = WS_ACT;
constexpr size_t WS_QS = WS_U + (size_t)MTOK * 512 * 4, WS_KS = WS_QS + (size_t)MTOK * 512 * 2, WS_VS = WS_KS + (size_t)MTOK * 128 * 2, WS_CQ = WS_VS + (size_t)MTOK * 128 * 2,
                 WS_CKV = WS_CQ + (size_t)MTOK * 512 * 2, WS_KR = WS_CKV + (size_t)MTOK * 256 * 2, WS_QM = WS_KR + (size_t)MTOK * 64 * 2, WS_KVM = WS_QM + (size_t)MTOK * 1536 * 2,
                 WS_YCAT = WS_KVM + (size_t)MTOK * 2048 * 2, WS_MIXEND = WS_YCAT + (size_t)MTOK * 2048 * 2;
constexpr size_t WS_ACTEND = WS_ACT + (size_t)MTOK * D_FF * 2;
constexpr size_t WS_END = (WS_MIXEND > WS_ACTEND ? WS_MIXEND : WS_ACTEND);
static_assert(WS_W % 256 == 0 && WS_XB % 256 == 0 && WS_ROPE % 256 == 0 && WS_SSMC % 256 == 0 && WS_SST % 256 == 0 && WS_ACT % 256 == 0, "alignment");

constexpr int RING_BYTES = 146432;
constexpr int MISC_OFF = RING_BYTES;
constexpr int LDS_BYTES = 147456;
static_assert(MISC_OFF + 128 <= LDS_BYTES, "LDS map");

typedef unsigned short bf16_t;
typedef float f32x16 __attribute__((ext_vector_type(16)));
typedef short s16x4 __attribute__((ext_vector_type(4)));
typedef unsigned u32x4 __attribute__((ext_vector_type(4)));
typedef unsigned u32x2 __attribute__((ext_vector_type(2)));
using pg8::cvt_pk_bf16; using pg8::rss_t; using pg8::rss_enc; using pg8::rss_dec;
__device__ __forceinline__ float bf2f(unsigned short b) { return __uint_as_float((unsigned)b << 16); }
__device__ __forceinline__ float wave_sum(float v) {
#pragma unroll
    for (int o = 1; o < 64; o <<= 1) v += __shfl_xor(v, o);
    return v;
}
__device__ __forceinline__ int vzero() { int z; asm volatile("v_mov_b32 %0, 0" : "=v"(z)); return z; }

struct Frame {
    LAS unsigned char* lds;
    int tid, lane, wave;
    int vcu, G;
};

__device__ __forceinline__ void conv_item(const float* W, int ldw, int K, int src_col0, const float* gain, bf16_t* WT, int dst_row0, int k0, LAS float* scr, int lane) {
#pragma unroll 8
    for (int i = 0; i < 32; ++i) { const int kk = 2 * i + (lane >> 5); float v = W[(size_t)(k0 + kk) * ldw + src_col0 + (lane & 31)]; if (gain) v *= gain[k0 + kk]; scr[kk * 33 + (lane & 31)] = v; }
    LDS_WAIT(); asm volatile("" ::: "memory");
    const int c = lane & 7;
#pragma unroll
    for (int j = 0; j < 4; ++j) { const int n = (lane >> 3) + 8 * j; const LAS float* s = scr + (8 * c) * 33 + n;
        u32x4 o; o.x = cvt_pk_bf16(s[0 * 33], s[1 * 33]); o.y = cvt_pk_bf16(s[2 * 33], s[3 * 33]); o.z = cvt_pk_bf16(s[4 * 33], s[5 * 33]); o.w = cvt_pk_bf16(s[6 * 33], s[7 * 33]);
        *(u32x4*)(WT + (size_t)(dst_row0 + n) * K + k0 + 8 * c) = o; }
    LDS_WAIT(); asm volatile("" ::: "memory");
}
__device__ __forceinline__ void zero_item(bf16_t* WT, int K, int dst_row0, int k0, int lane) {
    const int c = lane & 7;
#pragma unroll
    for (int j = 0; j < 4; ++j) { const int n = (lane >> 3) + 8 * j; *(u32x4*)(WT + (size_t)(dst_row0 + n) * K + k0 + 8 * c) = (u32x4){0u, 0u, 0u, 0u}; }
}
__device__ __forceinline__ int win_src_col(int db) {
    const int t = db >> 3, j = db & 7;
    if (t < 2) return db * 32;
    if (t < 4) return 512 + ((t - 2) * 4 + (j & 3)) * 64 + (j >> 2) * 32;
    if (t == 4) { if ((j & 3) < 2) return 1024 + (j & 3) * 64 + (j >> 2) * 32;
                  return 1152 + (j >> 2) * 64 + ((j & 3) - 2) * 32; }
    if (t < 8) return 1280 + (db - 40) * 32;
    if (j == 0) return 2048; if (j == 4) return 2080;
    return -1;
}
__device__ __forceinline__ int wuq_src_col(int db) {
    const int t = db >> 3, j = db & 7;
    if (t < 4) return (2 * t + (j >> 2)) * MLA_QK + (j & 3) * 32;
    return ((t - 4) * 4 + (j & 3)) * MLA_QK + MLA_NOPE + (j >> 2) * 32;
}

enum ArgIdx { A_X = 0, A_POS, A_FFN1_NORM, A_FFN1_WG, A_FFN1_WU, A_FFN1_WD, A_MIX_NORM, A_W_IN, A_SSM_LOG_DT, A_SSM_A_RE, A_SSM_A_IM, A_SSM_B_RE, A_SSM_B_IM, A_SSM_C_RE, A_SSM_C_IM, A_SSM_D,
              A_SSM_W_GLU, A_SSM_B_GLU, A_SWA_SINKS, A_MLA_Q_NORM, A_MLA_W_UQ, A_MLA_KV_NORM, A_MLA_W_UKV, A_OUT_NORM, A_W_OUT, A_FFN2_NORM, A_FFN2_WG, A_FFN2_WU, A_FFN2_WD, A_FINAL_NORM, A_OUT, A_WS };
__device__ __forceinline__ const void* karg(int i) {
    unsigned long long v; asm volatile("s_load_dwordx2 %0, %1, %2\n\ts_waitcnt lgkmcnt(0)" : "=s"(v) : "s"(__builtin_amdgcn_kernarg_segment_ptr()), "i"(i * 8) : "memory");
    return (const void*)(const GAS unsigned char*)v; }
#define KF(i) ((const float*)karg(i))
struct Ptrs { int dummy; };
__device__ __forceinline__ unsigned char* wsbase() { return (unsigned char*)karg(A_WS); }
__device__ __forceinline__ bf16_t* wptr(const Ptrs&, int l, size_t off) { return (bf16_t*)(wsbase() + WS_W) + (size_t)l * E_LAYER + off; }
__device__ __forceinline__ rss_t* rssptr(const Ptrs&, int idx) { return (rss_t*)(wsbase() + RSS_OFF) + (size_t)idx * MTOK; }

constexpr int CI_GU = (2 * D_FF / 32) * (D_MODEL / 64), CI_D = (D_MODEL / 32) * (D_FF / 64), CI_IN = (N_IN_PAD / 32) * (D_MODEL / 64), CI_UQ = (MLA_HEADS * MLA_QK / 32) * (MLA_QR / 64),
              CI_UKV = (2048 / 32) * (MLA_KVR / 64), CI_GLU = (SSM_WIDTH / 32) * (SSM_WIDTH / 64), CI_OUT = (D_MODEL / 32) * (D_MIX / 64);
constexpr int CI_LAYER = 2 * (CI_GU + CI_D) + CI_IN + CI_UQ + CI_UKV + CI_GLU + CI_OUT, CI_TOTAL = DEPTH * CI_LAYER;
struct ConvJob { const float* src; const float* gain; bf16_t* dst; int ldw, K; };
__device__ __forceinline__ void conv_decode(int I, ConvJob& J) {
    const int l = I / CI_LAYER; int r = I - l * CI_LAYER;
    const float* W; const float* gn = nullptr; int ldw, K, db, kb, sc; size_t off;
    if (r < 2 * (CI_GU + CI_D)) { const int f = r >= (CI_GU + CI_D); if (f) r -= CI_GU + CI_D;
        if (r < CI_GU) { K = D_MODEL; ldw = D_FF; db = r / (D_MODEL / 64); kb = r % (D_MODEL / 64); const int t = db >> 3, j = db & 7;
            W = ((j < 4) ? (f ? KF(A_FFN2_WG) : KF(A_FFN1_WG)) : (f ? KF(A_FFN2_WU) : KF(A_FFN1_WU))) + (size_t)l * D_MODEL * D_FF; gn = (f ? KF(A_FFN2_NORM) : KF(A_FFN1_NORM)) + (size_t)l * D_MODEL;
            sc = t * 128 + (j & 3) * 32; off = f ? O_WGU2 : O_WGU1; }
        else { r -= CI_GU; K = D_FF; ldw = D_MODEL; db = r / (D_FF / 64); kb = r % (D_FF / 64); W = (f ? KF(A_FFN2_WD) : KF(A_FFN1_WD)) + (size_t)l * D_FF * D_MODEL; sc = db * 32; off = f ? O_WD2 : O_WD1; } }
    else { r -= 2 * (CI_GU + CI_D);
        if (r < CI_IN) { K = D_MODEL; ldw = N_IN; db = r / (D_MODEL / 64); kb = r % (D_MODEL / 64); W = KF(A_W_IN) + (size_t)l * D_MODEL * N_IN; gn = KF(A_MIX_NORM) + (size_t)l * D_MODEL; sc = win_src_col(db); off = O_WIN; }
        else if ((r -= CI_IN) < CI_UQ) { K = MLA_QR; ldw = MLA_HEADS * MLA_QK; db = r / (MLA_QR / 64); kb = r % (MLA_QR / 64); W = KF(A_MLA_W_UQ) + (size_t)l * MLA_QR * (MLA_HEADS * MLA_QK); gn = KF(A_MLA_Q_NORM) + (size_t)l * MLA_QR; sc = wuq_src_col(db); off = O_WUQ; }
        else if ((r -= CI_UQ) < CI_UKV) { K = MLA_KVR; ldw = 2048; db = r / (MLA_KVR / 64); kb = r % (MLA_KVR / 64); W = KF(A_MLA_W_UKV) + (size_t)l * MLA_KVR * 2048; gn = KF(A_MLA_KV_NORM) + (size_t)l * MLA_KVR; sc = db * 32; off = O_WUKV; }
        else if ((r -= CI_UKV) < CI_GLU) { K = SSM_WIDTH; ldw = SSM_WIDTH; db = r / (SSM_WIDTH / 64); kb = r % (SSM_WIDTH / 64); W = KF(A_SSM_W_GLU) + (size_t)l * SSM_WIDTH * SSM_WIDTH; sc = db * 32; off = O_WGLU; }
        else { r -= CI_GLU; K = D_MIX; ldw = D_MODEL; db = r / (D_MIX / 64); kb = r % (D_MIX / 64); W = KF(A_W_OUT) + (size_t)l * D_MIX * D_MODEL; gn = KF(A_OUT_NORM) + (size_t)l * D_MIX; sc = db * 32; off = O_WOUT; } }
    J.src = sc >= 0 ? W + (size_t)(kb * 64) * ldw + sc : nullptr; J.gain = gn ? gn + kb * 64 : nullptr; J.ldw = ldw; J.K = K;
    J.dst = (bf16_t*)(wsbase() + WS_W) + (size_t)l * E_LAYER + off + (size_t)(db * 32) * K + kb * 64;
}
#define CONV_LOAD(J, v) do { if ((J).src) { const float* _s = (J).src + (size_t)(lane >> 5) * (J).ldw + (lane & 31); const size_t _st = (size_t)2 * (J).ldw; \
        _Pragma("unroll") for (int _i = 0; _i < 32; ++_i) v[_i] = _s[_i * _st]; } else { _Pragma("unroll") for (int _i = 0; _i < 32; ++_i) v[_i] = 0.f; } } while (0)
#define CONV_STORE(J, v) do { _Pragma("unroll") for (int _i = 0; _i < 32; ++_i) scr[(2 * _i + (lane >> 5)) * 33 + (lane & 31)] = v[_i]; \
        LDS_WAIT(); asm volatile("" ::: "memory"); \
        const int _c = lane & 7; f32x4 _g0 = {1.f, 1.f, 1.f, 1.f}, _g1 = {1.f, 1.f, 1.f, 1.f}; if ((J).gain) { _g0 = *(const f32x4*)((J).gain + 8 * _c); _g1 = *(const f32x4*)((J).gain + 8 * _c + 4); } \
        _Pragma("unroll") for (int _j = 0; _j < 4; ++_j) { const int _n = (lane >> 3) + 8 * _j; const LAS float* _s = scr + (8 * _c) * 33 + _n; \
            u32x4 _o; _o.x = cvt_pk_bf16(_s[0 * 33] * _g0[0], _s[1 * 33] * _g0[1]); _o.y = cvt_pk_bf16(_s[2 * 33] * _g0[2], _s[3 * 33] * _g0[3]); \
                      _o.z = cvt_pk_bf16(_s[4 * 33] * _g1[0], _s[5 * 33] * _g1[1]); _o.w = cvt_pk_bf16(_s[6 * 33] * _g1[2], _s[7 * 33] * _g1[3]); \
            *(u32x4*)((J).dst + (size_t)_n * (J).K + 8 * _c) = _o; } \
        LDS_WAIT(); asm volatile("" ::: "memory"); } while (0)

__device__ __forceinline__ void p0_prologue(const Frame& F, const Ptrs& P) {
    LAS float* scr = (LAS float*)(F.lds + F.wave * 16384);
    const int gw = F.vcu * NWAVES + F.wave, NGW = F.G * NWAVES, lane = F.lane + vzero();
    { ConvJob JA, JB; float va[32], vb[32];
      int I = gw;
      if (I < CI_TOTAL) { conv_decode(I, JA); CONV_LOAD(JA, va); }
      while (I < CI_TOTAL) {
          const bool hasB = I + NGW < CI_TOTAL; if (hasB) { conv_decode(I + NGW, JB); CONV_LOAD(JB, vb); }
          CONV_STORE(JA, va);
          if (!hasB) break;
          const bool hasA = I + 2 * NGW < CI_TOTAL; if (hasA) { conv_decode(I + 2 * NGW, JA); CONV_LOAD(JA, va); }
          CONV_STORE(JB, vb);
          I += 2 * NGW; if (!hasA) break;
      } }
    { rss_t* rss0 = rssptr(P, 0); bf16_t* XBp = (bf16_t*)(wsbase() + WS_XB); bf16_t* XLp = (bf16_t*)(wsbase() + WS_XL);
      for (int m = gw; m < MTOK; m += NGW) { const f32x4* xr = (const f32x4*)(KF(A_X) + (size_t)m * D_MODEL) + lane; float s = 0.f; u32x2* o8 = (u32x2*)(XBp + (size_t)m * D_MODEL) + lane; u32x2* l8 = (u32x2*)(XLp + (size_t)m * D_MODEL) + lane;
          f32x4 xv[8];
#pragma unroll
          for (int j = 0; j < 8; ++j) xv[j] = xr[64 * j];
#pragma unroll
          for (int j = 0; j < 8; ++j) { const f32x4 v = xv[j]; s += (v[0] * v[0] + v[1] * v[1]) + (v[2] * v[2] + v[3] * v[3]); u32x2 w; w.x = cvt_pk_bf16(v[0], v[1]); w.y = cvt_pk_bf16(v[2], v[3]); o8[64 * j] = w;
              if (RESID_LO) { const f32x4 rm = v - pg8::bf_lo4(w); u32x2 wl; wl.x = cvt_pk_bf16(rm[0], rm[1]); wl.y = cvt_pk_bf16(rm[2], rm[3]); l8[64 * j] = wl; } }
          s = wave_sum(s); if (lane == 0) rss0[m] = rss_enc(s); } }
    { float* cs = (float*)(wsbase() + WS_ROPE); float* sn = cs + (size_t)MTOK * 32; const int gt = gw * 64 + lane, NT = NGW * 64;
      for (int e = gt; e < MTOK * 32; e += NT) { const int row = e >> 5, i = e & 31; const float inv_freq = exp2f(-(float)i * (13.287712379549449f / 32.0f)); const float ang = (float)((const int*)karg(A_POS))[row] * inv_freq;
          float s, c; sincosf(ang, &s, &c); cs[e] = c; sn[e] = s; } }
    { const int gt = gw * 64 + lane, NT = NGW * 64;
      for (int e = gt; e < DEPTH * 32 * 64; e += NT) { const int l = e >> 11, gp = e & 2047, g = gp >> 6;
          float* C = (float*)(wsbase() + WS_SSMC) + (size_t)l * SSMC_LAYER;
          const double lr = (double)KF(A_SSM_A_RE)[e], li = (double)KF(A_SSM_A_IM)[e], dt = exp((double)KF(A_SSM_LOG_DT)[l * 32 + g]);
          const double mag = exp(lr * dt), ar = mag * cos(li * dt), ai = mag * sin(li * dt);
          const double magT = exp(lr * dt * 64.0), aTr = magT * cos(li * dt * 64.0), aTi = magT * sin(li * dt * 64.0);
          const double den = lr * lr + li * li, nr = ar - 1.0, qr = (nr * lr + ai * li) / den, qi = (ai * lr - nr * li) / den;
          C[SSMC_A + gp * 2] = (float)ar; C[SSMC_A + gp * 2 + 1] = (float)ai; C[SSMC_AT + gp * 2] = (float)aTr; C[SSMC_AT + gp * 2 + 1] = (float)aTi;
          const float* br = KF(A_SSM_B_RE) + (size_t)e * 16; const float* bi = KF(A_SSM_B_IM) + (size_t)e * 16; float* bb = C + SSMC_BB + (size_t)gp * 32;
          f32x4 brv[4], biv[4];
#pragma unroll
          for (int i = 0; i < 4; ++i) { brv[i] = *(const f32x4*)(br + 4 * i); biv[i] = *(const f32x4*)(bi + 4 * i); }
#pragma unroll
          for (int i = 0; i < 4; ++i) { f32x4 o_re, o_im;
#pragma unroll
              for (int k = 0; k < 4; ++k) { const double r = (double)brv[i][k], im = (double)biv[i][k]; o_re[k] = (float)(qr * r - qi * im); o_im[k] = (float)(qr * im + qi * r); }
              *(f32x4*)(bb + 4 * i) = o_re; *(f32x4*)(bb + 16 + 4 * i) = o_im; } } }
}

__device__ __forceinline__ int crow(int r, int hi) { return (r & 3) + 8 * (r >> 2) + 4 * hi; }
__device__ __forceinline__ s16x4 vtr(const LAS unsigned char* p) { typedef short v4i16_t __attribute__((ext_vector_type(4))); return __builtin_bit_cast(s16x4, __builtin_amdgcn_ds_read_tr16_b64_v4i16((LAS v4i16_t*)p)); }

template <int DK, int DK1, int DV, bool WIN, bool ALLST = false>
__device__ __forceinline__ void attn_unit(const Frame& F, const bf16_t* __restrict__ Q, int qld, const bf16_t* __restrict__ K1, int k1ld, const bf16_t* __restrict__ K2, int k2ld,
                                          const bf16_t* __restrict__ V, int vld, bf16_t* __restrict__ O, int old_, rss_t* __restrict__ rss, int rowbase, int q0, float m_init, float l_init) {
    constexpr int KROW = (DK + 8) * 2, VROW = (DV + 8) * 2, KBYTES = 64 * KROW, VBYTES = 64 * VROW, BUFB = KBYTES + VBYTES;
    constexpr int NKC = DK / 64, NVC = DV / 64, KCH = DK / 8, VCH = DV / 8;
    static_assert(2 * BUFB <= RING_BYTES, "attention tiles fit the phase scratch");
    const int zz = vzero();
    const int tid = F.tid + zz, lane = F.lane + zz, r = lane & 31, h = lane >> 5;
    const int wid = (F.wave < 4) ? F.wave : (F.wave ^ 2);
    LAS unsigned char* lds = F.lds;
    const int t_lo = WIN ? ((q0 >= SWA_WINDOW ? q0 - SWA_WINDOW : 0) >> 6) : 0, t_hi = (q0 + 256) >> 6;
    const bf16_t* ksrc[NKC]; int kdst[NKC]; int kld_[NKC]; const bf16_t* vsrc[NVC]; int vdst[NVC];
#pragma unroll
    for (int i = 0; i < NKC; ++i) { const int id = tid + i * 512, row = id / KCH, cc = id % KCH;
        ksrc[i] = (cc < DK1 / 8) ? K1 + (size_t)(rowbase + row) * k1ld + cc * 8 : K2 + (size_t)(rowbase + row) * k2ld + (cc - DK1 / 8) * 8; kdst[i] = row * KROW + cc * 16; kld_[i] = (cc < DK1 / 8) ? k1ld : k2ld; }
#pragma unroll
    for (int i = 0; i < NVC; ++i) { const int id = tid + i * 512, row = id / VCH, cc = id % VCH; vsrc[i] = V + (size_t)(rowbase + row) * vld + cc * 8; vdst[i] = KBYTES + row * VROW + cc * 16; }
    u32x4 kst[NKC], vst[NVC];
#define ATT_LOAD(t) do { _Pragma("unroll") for (int i = 0; i < NKC; ++i) kst[i] = *(const u32x4*)(ksrc[i] + (size_t)(t) * 64 * kld_[i]); \
                         _Pragma("unroll") for (int i = 0; i < NVC; ++i) vst[i] = *(const u32x4*)(vsrc[i] + (size_t)(t) * 64 * vld); } while (0)
#define ATT_STORE(buf) do { _Pragma("unroll") for (int i = 0; i < NKC; ++i) *(LAS u32x4*)(lds + (buf) * BUFB + kdst[i]) = kst[i]; \
                            _Pragma("unroll") for (int i = 0; i < NVC; ++i) *(LAS u32x4*)(lds + (buf) * BUFB + vdst[i]) = vst[i]; } while (0)
    constexpr float ATT_THR = 8.0f;
#define ATT_TILE(KT, VT) do { \
        if (active) { \
            const LAS unsigned char* kb = lds + (KT) + r * KROW + 16 * h; \
            f32x16 p0, p1; \
            _Pragma("unroll") \
            for (int e = 0; e < 16; ++e) { p0[e] = 0.f; p1[e] = 0.f; } \
              \
            bf16x8 kfa0 = *(const LAS bf16x8*)(kb), kfa1 = *(const LAS bf16x8*)(kb + 32 * KROW), kfb0 = *(const LAS bf16x8*)(kb + 32), kfb1 = *(const LAS bf16x8*)(kb + 32 * KROW + 32); \
            __builtin_amdgcn_s_setprio(1); \
            _Pragma("unroll") \
            for (int s = 0; s < DK / 16; s += 2) { \
                p0 = __builtin_amdgcn_mfma_f32_32x32x16_bf16(kfa0, qf[s], p0, 0, 0, 0); p1 = __builtin_amdgcn_mfma_f32_32x32x16_bf16(kfa1, qf[s], p1, 0, 0, 0); \
                if (s + 2 < DK / 16) { kfa0 = *(const LAS bf16x8*)(kb + 32 * (s + 2)); kfa1 = *(const LAS bf16x8*)(kb + 32 * KROW + 32 * (s + 2)); } \
                __builtin_amdgcn_sched_barrier(0); \
                p0 = __builtin_amdgcn_mfma_f32_32x32x16_bf16(kfb0, qf[s + 1], p0, 0, 0, 0); p1 = __builtin_amdgcn_mfma_f32_32x32x16_bf16(kfb1, qf[s + 1], p1, 0, 0, 0); \
                if (s + 3 < DK / 16) { kfb0 = *(const LAS bf16x8*)(kb + 32 * (s + 3)); kfb1 = *(const LAS bf16x8*)(kb + 32 * KROW + 32 * (s + 3)); } \
                __builtin_amdgcn_sched_barrier(0); } \
            __builtin_amdgcn_s_setprio(0); \
            const bool need_mask = (kb0 + 63 > wq0) || (WIN && kb0 + SWA_WINDOW <= wq0 + 31); \
            if (need_mask) { \
                const float NEG = -__builtin_inff(); \
            _Pragma("unroll") \
                for (int e = 0; e < 16; ++e) { const int d0 = qpos - (kb0 + crow(e, h)), d1 = d0 - 32; \
                    if (d0 < 0 || (WIN && d0 >= SWA_WINDOW)) p0[e] = NEG; \
                    if (d1 < 0 || (WIN && d1 >= SWA_WINDOW)) p1[e] = NEG; } \
            } \
            float mxa = __builtin_fmaxf(__builtin_fmaxf(p0[0], p0[1]), p1[0]), mxb = __builtin_fmaxf(__builtin_fmaxf(p0[2], p0[3]), p1[1]); mxa = __builtin_fmaxf(__builtin_fmaxf(mxa, p1[2]), p1[3]); \
            _Pragma("unroll") \
            for (int e = 4; e < 16; e += 4) { mxa = __builtin_fmaxf(__builtin_fmaxf(mxa, p0[e]), p0[e + 1]); mxb = __builtin_fmaxf(__builtin_fmaxf(mxb, p0[e + 2]), p0[e + 3]); mxa = __builtin_fmaxf(__builtin_fmaxf(mxa, p1[e]), p1[e + 1]); mxb = __builtin_fmaxf(__builtin_fmaxf(mxb, p1[e + 2]), p1[e + 3]); } \
            float mx = __builtin_fmaxf(mxa, mxb); mx = __builtin_fmaxf(mx, __shfl_xor(mx, 32)); \
            if (!__all(mx - m_run <= ATT_THR)) { const float mnew = fmaxf(m_run, mx), alpha = __builtin_amdgcn_exp2f(m_run - mnew); m_run = mnew; l_run *= alpha; \
            _Pragma("unroll") \
                for (int i = 0; i < DV / 32; ++i) \
            _Pragma("unroll") \
                    for (int e = 0; e < 16; ++e) o[i][e] *= alpha; } \
            const float mn = m_run; float ps = 0.f; \
            _Pragma("unroll") \
            for (int e = 0; e < 16; ++e) { p0[e] = __builtin_amdgcn_exp2f(p0[e] - mn); p1[e] = __builtin_amdgcn_exp2f(p1[e] - mn); ps += p0[e] + p1[e]; } \
            l_run += ps; \
            bf16x8 pb[4]; \
            _Pragma("unroll") \
            for (int ks = 0; ks < 4; ++ks) { const int b = (ks & 1) * 8; u32x4 w; \
                if (ks < 2) { w.x = cvt_pk_bf16(p0[b], p0[b + 1]); w.y = cvt_pk_bf16(p0[b + 2], p0[b + 3]); w.z = cvt_pk_bf16(p0[b + 4], p0[b + 5]); w.w = cvt_pk_bf16(p0[b + 6], p0[b + 7]); } \
                else        { w.x = cvt_pk_bf16(p1[b], p1[b + 1]); w.y = cvt_pk_bf16(p1[b + 2], p1[b + 3]); w.z = cvt_pk_bf16(p1[b + 4], p1[b + 5]); w.w = cvt_pk_bf16(p1[b + 6], p1[b + 7]); } \
                pb[ks] = __builtin_bit_cast(bf16x8, w); } \
            const LAS unsigned char* vb = lds + (VT) + (4 * h + ((lane & 15) >> 2)) * VROW + (16 * ((lane >> 4) & 1) + 4 * (lane & 3)) * 2; \
              \
            bf16x8 vfr[4]; \
              \
            _Pragma("unroll") \
            for (int j = 0; j < 4; ++j) { const int i_ = j % (DV / 32), ks_ = j / (DV / 32); const s16x4 lo = vtr(vb + (16 * ks_) * VROW + 64 * i_), hi = vtr(vb + (16 * ks_ + 8) * VROW + 64 * i_); vfr[j] = (bf16x8){lo[0], lo[1], lo[2], lo[3], hi[0], hi[1], hi[2], hi[3]}; } \
            __builtin_amdgcn_s_setprio(1); \
            _Pragma("unroll") \
            for (int j = 0; j < 4 * (DV / 32); ++j) { \
                o[j % (DV / 32)] = __builtin_amdgcn_mfma_f32_32x32x16_bf16(vfr[j & 3], pb[j / (DV / 32)], o[j % (DV / 32)], 0, 0, 0); \
                if (j + 4 < 4 * (DV / 32)) { const int jn = j + 4, i_ = jn % (DV / 32), ks_ = jn / (DV / 32); const s16x4 lo = vtr(vb + (16 * ks_) * VROW + 64 * i_), hi = vtr(vb + (16 * ks_ + 8) * VROW + 64 * i_); vfr[j & 3] = (bf16x8){lo[0], lo[1], lo[2], lo[3], hi[0], hi[1], hi[2], hi[3]}; } \
                __builtin_amdgcn_sched_barrier(0); } \
            __builtin_amdgcn_s_setprio(0); \
        } \
    } while (0)
    constexpr int NTMAX = ALLST ? 6 : 1;
    static_assert(!ALLST || NTMAX * (KBYTES + VBYTES) <= RING_BYTES, "whole-window staging fits the phase scratch");
    u32x4 ka[NTMAX][NKC], va[NTMAX][NVC];
    if constexpr (ALLST) {
#pragma unroll
        for (int jt = 0; jt < NTMAX; ++jt) if (t_lo + jt < t_hi) {
#pragma unroll
            for (int i = 0; i < NKC; ++i) ka[jt][i] = *(const u32x4*)(ksrc[i] + (size_t)(t_lo + jt) * 64 * kld_[i]);
#pragma unroll
            for (int i = 0; i < NVC; ++i) va[jt][i] = *(const u32x4*)(vsrc[i] + (size_t)(t_lo + jt) * 64 * vld); }
    } else { ATT_LOAD(t_lo); }
    bf16x8 qf[DK / 16];
    { const bf16_t* qrow = Q + (size_t)(rowbase + q0 + wid * 32 + r) * qld + 8 * h;
#pragma unroll
      for (int s = 0; s < DK / 16; ++s) qf[s] = *(const bf16x8*)(qrow + 16 * s);
#pragma unroll
      for (int s = 0; s < DK / 16; ++s) asm volatile("" : "+v"(qf[s])); }
    f32x16 o[DV / 32];
#pragma unroll
    for (int i = 0; i < DV / 32; ++i)
#pragma unroll
        for (int e = 0; e < 16; ++e) o[i][e] = 0.f;
    float m_run = m_init, l_run = (h == 0) ? l_init : 0.f;
    const int qpos = q0 + wid * 32 + r, wq0 = q0 + wid * 32;
    if constexpr (ALLST) {
#pragma unroll
        for (int jt = 0; jt < NTMAX; ++jt) if (t_lo + jt < t_hi) {
#pragma unroll
            for (int i = 0; i < NKC; ++i) *(LAS u32x4*)(lds + jt * KBYTES + kdst[i]) = ka[jt][i];
#pragma unroll
            for (int i = 0; i < NVC; ++i) *(LAS u32x4*)(lds + NTMAX * KBYTES + jt * VBYTES + (vdst[i] - KBYTES)) = va[jt][i]; }
        __syncthreads();
#pragma unroll 1
        for (int t = t_lo; t < t_hi; ++t) { const int jt = t - t_lo; const int kb0 = 64 * t;
            const bool active = (kb0 <= wq0 + 31) && (!WIN || kb0 + 63 + SWA_WINDOW > wq0);
            ATT_TILE(jt * KBYTES, NTMAX * KBYTES + jt * VBYTES); }
        __syncthreads();
    } else {
    ATT_STORE(0);
    __syncthreads();
    for (int t = t_lo; t < t_hi; ++t) {
        const int cur = (t - t_lo) & 1;
        if (t + 1 < t_hi) ATT_LOAD(t + 1);
        const int kb0 = 64 * t;
        const bool active = (kb0 <= wq0 + 31) && (!WIN || kb0 + 63 + SWA_WINDOW > wq0);
        ATT_TILE(cur * BUFB, cur * BUFB + KBYTES);
        if (t + 1 < t_hi) ATT_STORE(cur ^ 1);
        __syncthreads();
    }
    }
    const float lt = l_run + __shfl_xor(l_run, 32), inv = 1.0f / lt;
    float ss = 0.f;
    bf16_t* orow = O + (size_t)(rowbase + qpos) * old_;
#pragma unroll
    for (int i = 0; i < DV / 32; ++i)
#pragma unroll
        for (int pgi = 0; pgi < 2; ++pgi) { u32x2 w[2];
#pragma unroll
            for (int k = 0; k < 2; ++k) { const int g = 2 * pgi + k; const float a = o[i][4 * g] * inv, b = o[i][4 * g + 1] * inv, c = o[i][4 * g + 2] * inv, d = o[i][4 * g + 3] * inv;
                ss += (a * a + b * b) + (c * c + d * d); w[k].x = cvt_pk_bf16(a, b); w[k].y = cvt_pk_bf16(c, d); }
            const u32x2 snd = h ? w[0] : w[1]; u32x2 rcv; rcv.x = (unsigned)__shfl_xor((int)snd.x, 32); rcv.y = (unsigned)__shfl_xor((int)snd.y, 32);
            const u32x4 st = h ? (u32x4){rcv.x, rcv.y, w[1].x, w[1].y} : (u32x4){w[0].x, w[0].y, rcv.x, rcv.y};
            *(u32x4*)(orow + 32 * i + 16 * pgi + 8 * h) = st; }
    ss += __shfl_xor(ss, 32);
    if (h == 0) atomicAdd(rss + rowbase + qpos, rss_enc(ss));
#undef ATT_LOAD
#undef ATT_TILE
#undef ATT_STORE
}


constexpr int SSM_T = 64, SSM_NCH = SEQ / SSM_T;
__device__ __forceinline__ float gelu_tanh(float y) { const float z = 1.5957691216057308f * (y + 0.044715f * y * y * y); return y * __builtin_amdgcn_rcpf(1.0f + __builtin_amdgcn_exp2f(-z * LOG2E)); }

constexpr int SSM_YROW = 520;
constexpr int SSM_XBROW = 136;
constexpr int SSM_XROW = 132;
constexpr int SSM_LDS_Y = 0, SSM_LDS_X = SSM_T * SSM_YROW * 2, SSM_LDS_U = SSM_LDS_X + NWAVES * 16 * SSM_XROW * 4, SSM_LDS_END = SSM_LDS_U + NWAVES * 1024;
static_assert(SSM_LDS_END <= RING_BYTES && SSM_LDS_U - SSM_LDS_X >= SSM_T * SSM_YROW * 2, "SSM LDS map (the out tile reuses the state scratch)");
__device__ __forceinline__ void ssm_load_bb_raw(const float* C, int g, int lane, f32x4 (&raw)[16]) {
    const int q = lane >> 4, n = lane & 15;
#pragma unroll
    for (int blk = 0; blk < 8; ++blk) { const float* src = C + SSMC_BB + (size_t)(g * 64 + 16 * (blk & 3) + n) * 32 + (blk >> 2) * 16 + 8 * (q & 1); raw[2 * blk] = *(const f32x4*)src; raw[2 * blk + 1] = *(const f32x4*)(src + 4); }
}
__device__ __forceinline__ void ssm_cvt_bbh(const f32x4 (&raw)[16], int lane, bf16x8 (&bbh)[8]) {
    const int q = lane >> 4;
#pragma unroll
    for (int blk = 0; blk < 8; ++blk) { const f32x4 v0 = raw[2 * blk], v1 = raw[2 * blk + 1]; u32x4 w; w.x = cvt_pk_bf16(v0[0], v0[1]); w.y = cvt_pk_bf16(v0[2], v0[3]); w.z = cvt_pk_bf16(v1[0], v1[1]); w.w = cvt_pk_bf16(v1[2], v1[3]);
        if (q >= 2) w = (u32x4){0u, 0u, 0u, 0u}; bbh[blk] = __builtin_bit_cast(bf16x8, w); }
}
__device__ __forceinline__ void ssm_load_bbh(const float* C, int g, int lane, bf16x8 (&bbh)[8]) {
    f32x4 raw[16]; ssm_load_bb_raw(C, g, lane, raw);
#pragma unroll
    for (int i = 0; i < 16; ++i) asm volatile("" : "+v"(raw[i]));
    ssm_cvt_bbh(raw, lane, bbh);
}
__device__ __forceinline__ void ssm_bproj16(const LAS float* ubf, const bf16x8 (&bbh)[8], LAS float* bu, int lane) {
    const int q = lane >> 4, n = lane & 15;
    const f32x4 v0 = *(const LAS f32x4*)(ubf + n * 16 + 8 * (q & 1)), v1 = *(const LAS f32x4*)(ubf + n * 16 + 8 * (q & 1) + 4);
    u32x4 w; w.x = cvt_pk_bf16(v0[0], v0[1]); w.y = cvt_pk_bf16(v0[2], v0[3]); w.z = cvt_pk_bf16(v1[0], v1[1]); w.w = cvt_pk_bf16(v1[2], v1[3]);
    if (q >= 2) w = (u32x4){0u, 0u, 0u, 0u};
    const bf16x8 a = __builtin_bit_cast(bf16x8, w);
#pragma unroll
    for (int blk = 0; blk < 8; ++blk) { f32x4 d = {0.f, 0.f, 0.f, 0.f}; d = __builtin_amdgcn_mfma_f32_16x16x32_bf16(a, bbh[blk], d, 0, 0, 0);
#pragma unroll
        for (int i = 0; i < 4; ++i) bu[(4 * q + i) * SSM_XROW + 16 * blk + n] = d[i]; }
}

constexpr int SSM_BTROW = 20;
__device__ __forceinline__ bf16x8 ssm_bproj_a(const LAS float* ubf, int lane) {
    const int q = lane >> 4, n = lane & 15;
    const f32x4 v0 = *(const LAS f32x4*)(ubf + n * 16 + 8 * (q & 1)), v1 = *(const LAS f32x4*)(ubf + n * 16 + 8 * (q & 1) + 4);
    u32x4 w; w.x = cvt_pk_bf16(v0[0], v0[1]); w.y = cvt_pk_bf16(v0[2], v0[3]); w.z = cvt_pk_bf16(v1[0], v1[1]); w.w = cvt_pk_bf16(v1[2], v1[3]);
    if (q >= 2) w = (u32x4){0u, 0u, 0u, 0u};
    return __builtin_bit_cast(bf16x8, w);
}
__device__ __forceinline__ void ssm_bproj_half(const bf16x8 a, const bf16x8 (&bbh)[8], int half, LAS float* bt, int lane, float (&out)[16]) {
    const int q = lane >> 4, n = lane & 15;
#pragma unroll
    for (int b4 = 0; b4 < 4; ++b4) { f32x4 d = {0.f, 0.f, 0.f, 0.f}; d = __builtin_amdgcn_mfma_f32_16x16x32_bf16(a, bbh[half * 4 + b4], d, 0, 0, 0);
        *(LAS f32x4*)(bt + (16 * b4 + n) * SSM_BTROW + 4 * q) = d; }
#pragma unroll
    for (int i = 0; i < 4; ++i) { const f32x4 v = *(const LAS f32x4*)(bt + lane * SSM_BTROW + 4 * i); out[4 * i] = v[0]; out[4 * i + 1] = v[1]; out[4 * i + 2] = v[2]; out[4 * i + 3] = v[3]; }
}

typedef float sf2 __attribute__((ext_vector_type(2)));
#ifndef P1_LIGHT_T
#define P1_LIGHT_T 1
#endif
__device__ __forceinline__ void ssm_pass1(const Frame& F, const Ptrs& P, int l) {
    const int vz = vzero(); const int gw = F.vcu * NWAVES + F.wave, NGW = F.G * NWAVES, lane = F.lane + vz;
    const float* C = (const float*)(wsbase() + WS_SSMC) + (size_t)l * SSMC_LAYER; const float* U = (const float*)(wsbase() + WS_U); float* SST = (float*)(wsbase() + WS_SST);
    int t0 = gw, tstride = NGW, tend = BATCH * SSM_NCH * SSM_GROUPS;
#if WIN_MAIN_N < 2304
    if (F.G == 256) {
        const int bx = (int)blockIdx.x;
        if (bx < 64) { t0 = bx * NWAVES + F.wave; tstride = 64 * NWAVES; tend = P1_LIGHT_T * 64 * NWAVES; }
        else { t0 = P1_LIGHT_T * 64 * NWAVES + (bx - 64) * NWAVES + F.wave; tstride = 192 * NWAVES; }
    }
#endif
    for (int task = t0; task < tend; task += tstride) {
        const int g = task & 31, c = (task >> 5) & (SSM_NCH - 1), b = task >> 11;
        const float ar = C[SSMC_A + (g * 64 + lane) * 2], ai = C[SSMC_A + (g * 64 + lane) * 2 + 1];
        f32x4 bb[8];
#pragma unroll
        for (int i = 0; i < 8; ++i) bb[i] = *(const f32x4*)(C + SSMC_BB + (size_t)(g * 64 + lane) * 32 + 4 * i);
        sf2 bp[16];
#pragma unroll
        for (int i = 0; i < 16; ++i) bp[i] = (sf2){bb[i >> 2][i & 3], bb[4 + (i >> 2)][i & 3]};
        const sf2 arr = {ar, ar}, aim = {-ai, ai};
        sf2 x = {0.f, 0.f};
        f32x4 uf[4];
        { const float* up = U + (size_t)(b * SEQ + c * SSM_T + lane) * SSM_WIDTH + g * 16;
#pragma unroll
          for (int i = 0; i < 4; ++i) uf[i] = *(const f32x4*)(up + 4 * i); }
        LAS f32x4* ub = (LAS f32x4*)(F.lds + F.wave * 4096);
#pragma unroll
        for (int i = 0; i < 4; ++i) ub[lane * 4 + i] = uf[i];
        LDS_WAIT(); asm volatile("" ::: "memory");
#define P1_READ4(a0_, a1_, a2_, a3_, addr) asm volatile("ds_read_b128 %0, %4\n\tds_read_b128 %1, %4 offset:16\n\tds_read_b128 %2, %4 offset:32\n\tds_read_b128 %3, %4 offset:48" : "=&v"(a0_), "=&v"(a1_), "=&v"(a2_), "=&v"(a3_) : "v"(addr))
#define P1_WAIT4(a0_, a1_, a2_, a3_) asm volatile("s_waitcnt lgkmcnt(0)" : "+v"(a0_), "+v"(a1_), "+v"(a2_), "+v"(a3_))
        const unsigned ubase = (unsigned)(size_t)ub + (unsigned)vz;
        f32x4 un0, un1, un2, un3; P1_READ4(un0, un1, un2, un3, ubase); P1_WAIT4(un0, un1, un2, un3);
#pragma unroll 4
        for (int t = 0; t < SSM_T; ++t) {
            const f32x4 u0 = un0, u1 = un1, u2 = un2, u3 = un3;
            { const unsigned an = ubase + (unsigned)(((t + 1) & (SSM_T - 1)) * 64); P1_READ4(un0, un1, un2, un3, an); }
            sf2 a0 = arr * x + aim * x.yx, a1 = {0.f, 0.f};
#pragma unroll
            for (int k = 0; k < 4; ++k) { a0 += bp[k] * (sf2){u0[k], u0[k]}; a1 += bp[4 + k] * (sf2){u1[k], u1[k]}; a0 += bp[8 + k] * (sf2){u2[k], u2[k]}; a1 += bp[12 + k] * (sf2){u3[k], u3[k]}; }
            x = a0 + a1;
            asm volatile("s_waitcnt lgkmcnt(0)" : "+v"(un0), "+v"(un1), "+v"(un2), "+v"(un3), "+v"(x));
        }
        const float xr = x.x, xi = x.y;
        LDS_WAIT(); asm volatile("" ::: "memory");
        float* s = SST + ((size_t)((b * SSM_NCH + c) * SSM_GROUPS + g) * 64 + lane) * 2; s[0] = xr; s[1] = xi;
    }
}

__device__ __forceinline__ void ssm_pass2_unit(const Frame& F, const Ptrs& P, int l, int b, int c) {
    const int vz = vzero(); const int lane = F.lane + vz, wid = F.wave;
    const float* C = (const float*)(wsbase() + WS_SSMC) + (size_t)l * SSMC_LAYER; const float* U = (const float*)(wsbase() + WS_U); const float* SST = (const float*)(wsbase() + WS_SST);
    LAS unsigned short* ybuf = (LAS unsigned short*)(F.lds + SSM_LDS_Y); LAS float* bu = (LAS float*)(F.lds + SSM_LDS_X) + wid * 16 * SSM_XROW; LAS unsigned* xsw = (LAS unsigned*)bu;
    const int row0 = b * SEQ + c * SSM_T;
    float xin_r[4] = {0.f, 0.f, 0.f, 0.f}, xin_i[4] = {0.f, 0.f, 0.f, 0.f};
    { float tr_[4], ti_[4];
#pragma unroll
      for (int gi = 0; gi < 4; ++gi) { tr_[gi] = C[SSMC_AT + ((wid * 4 + gi) * 64 + lane) * 2]; ti_[gi] = C[SSMC_AT + ((wid * 4 + gi) * 64 + lane) * 2 + 1]; }
      const float* sp = SST + ((size_t)(b * SSM_NCH * SSM_GROUPS + wid * 4) * 64 + lane) * 2;
      for (int jb = c - ((c + 7) & ~7); jb < c; jb += 8) {
          sf2 sv[8][4];
#pragma unroll
          for (int jj = 0; jj < 8; ++jj) { const int j = jb + jj, jc = j < 0 ? 0 : j;
#pragma unroll
              for (int gi = 0; gi < 4; ++gi) sv[jj][gi] = *(const sf2*)(sp + (size_t)jc * SSM_GROUPS * 128 + gi * 128); }
#pragma unroll
          for (int jj = 0; jj < 8; ++jj) { const float keep = (jb + jj) < 0 ? 0.f : 1.f;
#pragma unroll
              for (int gi = 0; gi < 4; ++gi) { const float sr = sv[jj][gi].x * keep, si = sv[jj][gi].y * keep;
                  const float nr = tr_[gi] * xin_r[gi] - ti_[gi] * xin_i[gi] + sr, ni = tr_[gi] * xin_i[gi] + ti_[gi] * xin_r[gi] + si; xin_r[gi] = nr; xin_i[gi] = ni; } } } }
#pragma unroll
    for (int gi = 0; gi < 4; ++gi) {
        const int g = wid * 4 + gi;
        float ar = C[SSMC_A + (g * 64 + lane) * 2], ai = C[SSMC_A + (g * 64 + lane) * 2 + 1];
        f32x4 bbraw[16]; ssm_load_bb_raw(C, g, lane, bbraw);
        f32x4 cr[4], ci[4];
        { const int q = lane >> 4; const size_t rowoff = ((size_t)(l * SSM_GROUPS + g) * 16 + (lane & 15)) * 64 + 4 * q;
          const float* crp = KF(A_SSM_C_RE) + rowoff; const float* cip = KF(A_SSM_C_IM) + rowoff;
#pragma unroll
          for (int s = 0; s < 4; ++s) { cr[s] = *(const f32x4*)(crp + 16 * s); ci[s] = *(const f32x4*)(cip + 16 * s); } }
        float dsk = KF(A_SSM_D)[l * SSM_WIDTH + g * 16 + (lane & 15)];
        f32x4 uf[4];
        { const float* up = U + (size_t)(row0 + lane) * SSM_WIDTH + g * 16;
#pragma unroll
          for (int i = 0; i < 4; ++i) uf[i] = *(const f32x4*)(up + 4 * i); }
#pragma unroll
        for (int i = 0; i < 16; ++i) asm volatile("" : "+v"(bbraw[i]));
#pragma unroll
        for (int s = 0; s < 4; ++s) { asm volatile("" : "+v"(cr[s])); asm volatile("" : "+v"(ci[s])); }
#pragma unroll
        for (int i = 0; i < 4; ++i) asm volatile("" : "+v"(uf[i]));
        asm volatile("" : "+v"(ar), "+v"(ai), "+v"(dsk));
        bf16x8 bbh[8]; ssm_cvt_bbh(bbraw, lane, bbh);
        float xr = xin_r[gi], xi = xin_i[gi];
        bf16x8 cmh[4];
#pragma unroll
        for (int s = 0; s < 4; ++s) { u32x4 w; w.x = cvt_pk_bf16(cr[s][0], -ci[s][0]); w.y = cvt_pk_bf16(cr[s][1], -ci[s][1]); w.z = cvt_pk_bf16(cr[s][2], -ci[s][2]); w.w = cvt_pk_bf16(cr[s][3], -ci[s][3]);
            cmh[s] = __builtin_bit_cast(bf16x8, w); }
        LAS f32x4* ub = (LAS f32x4*)(F.lds + SSM_LDS_U + wid * 1024);
#pragma unroll 1
        for (int tb = 0; tb < 4; ++tb) {
            if ((lane >> 4) == tb) {
#pragma unroll
                for (int i = 0; i < 4; ++i) ub[(lane & 15) * 4 + i] = uf[i]; }
            LDS_WAIT(); asm volatile("" ::: "memory");
            float uv[4];
#pragma unroll
            for (int i = 0; i < 4; ++i) uv[i] = ((const LAS float*)ub)[(4 * (lane >> 4) + i) * 16 + (lane & 15)];
            const bf16x8 ua = ssm_bproj_a((const LAS float*)ub, lane);
            float bre[16], bim[16];
            ssm_bproj_half(ua, bbh, 0, bu, lane, bre); ssm_bproj_half(ua, bbh, 1, bu, lane, bim);
            asm volatile("" ::: "memory");
#pragma unroll
            for (int tt = 0; tt < 16; ++tt) { const float nr = ar * xr - ai * xi + bre[tt], ni = ar * xi + ai * xr + bim[tt]; xr = nr; xi = ni;
                xsw[tt * 68 + lane] = cvt_pk_bf16(xr, xi); }
            asm volatile("" ::: "memory");
#ifndef PROBE_REP_CPROJ
#define PROBE_REP_CPROJ 1
#endif
            for (int rep_c = 0; rep_c < PROBE_REP_CPROJ; ++rep_c) {
            f32x4 ya = {0.f, 0.f, 0.f, 0.f};
            const LAS unsigned short* xa = (const LAS unsigned short*)(xsw + (lane & 15) * 68) + 8 * (lane >> 4);
#pragma unroll
            for (int s = 0; s < 4; ++s) ya = __builtin_amdgcn_mfma_f32_16x16x32_bf16(*(const LAS bf16x8*)(xa + 32 * s), cmh[s], ya, 0, 0, 0);
            const f32x4 yb = {0.f, 0.f, 0.f, 0.f};
#pragma unroll
            for (int i = 0; i < 4; ++i) { const int t = tb * 16 + 4 * (lane >> 4) + i;
                const float y = gelu_tanh(ya[i] + yb[i] + dsk * uv[i]); ybuf[t * SSM_YROW + g * 16 + (lane & 15)] = (unsigned short)(cvt_pk_bf16(y, 0.f) & 0xffffu); }
            }
            LDS_WAIT(); asm volatile("" ::: "memory");
        }
    }
#ifndef PROBE_REP_GLU
#define PROBE_REP_GLU 1
#endif
    for (int rep_ = 0; rep_ < PROBE_REP_GLU; ++rep_) {
    __syncthreads();
    const int lane2 = F.lane + vzero(); const int r = lane2 & 31, h = lane2 >> 5;
    f32x16 acc[2][2];
#pragma unroll
    for (int a = 0; a < 2; ++a)
#pragma unroll
        for (int q = 0; q < 2; ++q)
#pragma unroll
            for (int e = 0; e < 16; ++e) acc[a][q][e] = 0.f;
    const bf16_t* wg = wptr(P, l, O_WGLU) + (size_t)(wid * 64 + r) * SSM_WIDTH + 8 * h;
    const LAS unsigned short* ya_ = ybuf + r * SSM_YROW + 8 * h;
    bf16x8 wb[8][2];
#pragma unroll
    for (int i = 0; i < 8; ++i) { wb[i][0] = *(const bf16x8*)(wg + 16 * i); wb[i][1] = *(const bf16x8*)(wg + (size_t)32 * SSM_WIDTH + 16 * i); }
    bf16x8 an0 = *(const LAS bf16x8*)(ya_), an1 = *(const LAS bf16x8*)(ya_ + 32 * SSM_YROW);
#pragma unroll
    for (int s = 0; s < 32; ++s) {
        const bf16x8 a0 = an0, a1 = an1;
        if (s + 1 < 32) { an0 = *(const LAS bf16x8*)(ya_ + 16 * (s + 1)); an1 = *(const LAS bf16x8*)(ya_ + 32 * SSM_YROW + 16 * (s + 1)); }
        const bf16x8 b0 = wb[s & 7][0], b1 = wb[s & 7][1];
        acc[0][0] = __builtin_amdgcn_mfma_f32_32x32x16_bf16(a0, b0, acc[0][0], 0, 0, 0); acc[0][1] = __builtin_amdgcn_mfma_f32_32x32x16_bf16(a0, b1, acc[0][1], 0, 0, 0);
        acc[1][0] = __builtin_amdgcn_mfma_f32_32x32x16_bf16(a1, b0, acc[1][0], 0, 0, 0); acc[1][1] = __builtin_amdgcn_mfma_f32_32x32x16_bf16(a1, b1, acc[1][1], 0, 0, 0);
        if (s + 8 < 32) { wb[s & 7][0] = *(const bf16x8*)(wg + 16 * (s + 8)); wb[s & 7][1] = *(const bf16x8*)(wg + (size_t)32 * SSM_WIDTH + 16 * (s + 8)); }
        __builtin_amdgcn_sched_barrier(0);
    }
    LAS unsigned short* obuf = (LAS unsigned short*)(F.lds + SSM_LDS_X);
    { const int lane3 = F.lane + vzero(); const int r = lane3 & 31, h = lane3 >> 5;
#pragma unroll
    for (int q = 0; q < 2; ++q) { const int col = wid * 64 + q * 32 + r; const float bg = KF(A_SSM_B_GLU)[l * SSM_WIDTH + col];
#pragma unroll
        for (int a = 0; a < 2; ++a)
#pragma unroll
            for (int e = 0; e < 16; ++e) { const int row = 32 * a + crow(e, h); const float y = bf2f(ybuf[row * SSM_YROW + col]); const float z = acc[a][q][e] + bg;
                const float ov = y * __builtin_amdgcn_rcpf(1.0f + __builtin_amdgcn_exp2f(-z * LOG2E)); obuf[row * SSM_YROW + col] = (unsigned short)(cvt_pk_bf16(ov, 0.f) & 0xffffu); } } }
    __syncthreads();
    bf16_t* Y = (bf16_t*)(wsbase() + WS_YCAT); rss_t* rss = rssptr(P, l * RSS_PER_LAYER + 5);
#pragma unroll
    for (int i = 0; i < 8; ++i) { const int row = wid * 8 + i; const u32x4 v = *(const LAS u32x4*)(obuf + row * SSM_YROW + 8 * lane);
        float ss = 0.f;
#pragma unroll
        for (int k = 0; k < 4; ++k) { const float lo = __uint_as_float(v[k] << 16), hi = __uint_as_float(v[k] & 0xffff0000u); ss += lo * lo + hi * hi; }
        ss = wave_sum(ss); *(u32x4*)(Y + (size_t)(row0 + row) * D_MIX + 8 * lane) = v; if (lane == 0) rss[row0 + row] = rss_enc(ss); }
    }
    __syncthreads();
}

__device__ __forceinline__ void ycat_normalize(const Frame& F, const Ptrs& P, int l) {
    const int gw = F.vcu * NWAVES + F.wave, NGW = F.G * NWAVES, lane = F.lane + vzero();
    bf16_t* Y = (bf16_t*)(wsbase() + WS_YCAT); const rss_t* r0 = rssptr(P, l * RSS_PER_LAYER + 5) + vzero(); const rss_t* r1 = rssptr(P, l * RSS_PER_LAYER + 6) + vzero(); const rss_t* r2 = rssptr(P, l * RSS_PER_LAYER + 7) + vzero();
    for (int m = gw; m < MTOK; m += NGW) {
        const float s0 = __builtin_amdgcn_rsqf(rss_dec(r0[m]) * (1.0f / SSM_WIDTH) + EPS), s1 = __builtin_amdgcn_rsqf(rss_dec(r1[m]) * (1.0f / SWA_WIDTH) + EPS), s2 = __builtin_amdgcn_rsqf(rss_dec(r2[m]) * (1.0f / MLA_WIDTH) + EPS);
        u32x4* yr = (u32x4*)(Y + (size_t)m * D_MIX) + lane;
#pragma unroll
        for (int j = 0; j < 4; ++j) { const float sc = j == 0 ? s0 : (j == 1 ? s1 : s2); u32x4 v = yr[64 * j];
#pragma unroll
            for (int k = 0; k < 4; ++k) { const float lo = __uint_as_float(v[k] << 16) * sc, hi = __uint_as_float(v[k] & 0xffff0000u) * sc; v[k] = cvt_pk_bf16(lo, hi); }
            yr[64 * j] = v; }
    }
}
__device__ __forceinline__ void final_norm_phase(const Frame& F, const Ptrs& P) {
    const int gw = F.vcu * NWAVES + F.wave, NGW = F.G * NWAVES, lane = F.lane + vzero(); const rss_t* rs = rssptr(P, DEPTH * RSS_PER_LAYER) + vzero();
    const bf16_t* XBp = (const bf16_t*)(wsbase() + WS_XB); const bf16_t* XLp = (const bf16_t*)(wsbase() + WS_XL); float* outp = (float*)karg(A_OUT); const float* gnp = KF(A_FINAL_NORM);
    f32x4 gn[8];
#pragma unroll
    for (int j = 0; j < 4; ++j) { gn[2 * j] = *(const f32x4*)(gnp + 512 * j + 8 * lane); gn[2 * j + 1] = *(const f32x4*)(gnp + 512 * j + 8 * lane + 4); }
    for (int m = gw; m < MTOK; m += NGW) { const rss_t rv = rs[m]; u32x4 hv[4];
#pragma unroll
        for (int j = 0; j < 4; ++j) hv[j] = *(const u32x4*)(XBp + (size_t)m * D_MODEL + 512 * j + 8 * lane);
        const float sc = __builtin_amdgcn_rsqf(rss_dec(rv) * (1.0f / D_MODEL) + EPS);
#pragma unroll
        for (int j = 0; j < 4; ++j) { const size_t off = (size_t)m * D_MODEL + 512 * j + 8 * lane;
            const f32x4 a0 = pg8::bf_lo4((u32x2){hv[j].x, hv[j].y}), a1 = pg8::bf_lo4((u32x2){hv[j].z, hv[j].w});
            *(f32x4*)(outp + off) = a0 * sc * gn[2 * j]; *(f32x4*)(outp + off + 4) = a1 * sc * gn[2 * j + 1]; } }
}

#ifndef PROBE_REP_MLA
#define PROBE_REP_MLA 1
#endif
#ifndef PROBE_REP_SWA
#define PROBE_REP_SWA 1
#endif
#ifndef PROBE_REP_SSM
#define PROBE_REP_SSM 1
#endif
#ifndef PROBE_REP_GU
#define PROBE_REP_GU 1
#endif
#ifndef PROBE_REP_DOWN
#define PROBE_REP_DOWN 1
#endif
#ifndef PROBE_REP_SSM1
#define PROBE_REP_SSM1 1
#endif
#ifndef PG_ALIGN_GU
#define PG_ALIGN_GU true
#endif
#ifndef PG_ALIGN
#define PG_ALIGN true
#endif
#ifndef PG_SP2
#define PG_SP2 true
#endif
#ifndef PROBE_DOWN_NULLEPI
#define PROBE_DOWN_NULLEPI 0
#endif
#ifndef PROBE_REP_P0
#define PROBE_REP_P0 1
#endif
#ifndef MK_PER_PHASE
#define MK_PER_PHASE 0
#endif
constexpr int PH_PER_LAYER = 8, N_PHASES = 1 + DEPTH * PH_PER_LAYER + 1;
struct Args { const void* in[30]; float* out; unsigned char* ws; int ph_lo, ph_hi, pad0, pad1; };
__global__ void __launch_bounds__(NWAVES * 64, 2) mk_fwd(Args args) {
    extern __shared__ __attribute__((aligned(16))) unsigned char lds_raw[];
    Frame F;
    F.lds = (LAS unsigned char*)lds_raw;
    F.tid = threadIdx.x; F.lane = F.tid & 63; F.wave = __builtin_amdgcn_readfirstlane(F.tid >> 6);
    F.G = gridDim.x; { const int bx = blockIdx.x; F.vcu = (F.G % 8 == 0) ? (bx % 8) * (F.G / 8) + bx / 8 : bx; }
    Ptrs P; P.dummy = 0;
    volatile LAS unsigned* MISC = (volatile LAS unsigned*)(F.lds + MISC_OFF);
    for (int u = F.tid; u < (LDS_BYTES - MISC_OFF) / 4; u += NWAVES * 64) ((LAS unsigned*)(F.lds + MISC_OFF))[u] = 0u;
    __syncthreads();
    const int lo = args.ph_lo, hi = args.ph_hi;
    XcdBarrier bar; bar.bar = (unsigned*)(wsbase() + WS_CTL) + CW_BAR; bar.x = 0; bar.st = nullptr;
    if (hi - lo > 1) bar = xcd_barrier_post((unsigned*)(wsbase() + WS_CTL) + CW_BAR, MISC + 8);
    int ph = 0;
#ifndef ONLY_K
#define ONLY_K -1
#endif
    int kk = 0;
#define PHASE_BEGIN if ((ONLY_K < 0 || ONLY_K == kk) && ph >= lo && ph < hi) {
#define PHASE_END   if (ph + 1 < hi) xcd_barrier(bar); } ++ph; ++kk;

#define XB ((bf16_t*)(wsbase() + WS_XB))
#define ACT ((bf16_t*)(wsbase() + WS_ACT))
#define YCAT ((bf16_t*)(wsbase() + WS_YCAT))
#define RCS ((const float*)(wsbase() + WS_ROPE))
#define RSN (RCS + (size_t)MTOK * 32)
#define UU ((float*)(wsbase() + WS_U))
#define QS ((bf16_t*)(wsbase() + WS_QS))
#define KS ((bf16_t*)(wsbase() + WS_KS))
#define VS ((bf16_t*)(wsbase() + WS_VS))
#define CQ ((bf16_t*)(wsbase() + WS_CQ))
#define CKV ((bf16_t*)(wsbase() + WS_CKV))
#define KR ((bf16_t*)(wsbase() + WS_KR))
#define QM ((bf16_t*)(wsbase() + WS_QM))
#define KVM ((bf16_t*)(wsbase() + WS_KVM))
#define KL(k) ({ int _k = (k); asm volatile("" : "+s"(_k)); _k; })

    #ifndef NO_P0
    PHASE_BEGIN for (int rep = 0; rep < PROBE_REP_P0; ++rep) p0_prologue(F, P); PHASE_END
#endif

    for (int l = 0; l < DEPTH; ++l) { kk = 1;
#define rss_l rssptr(P, l * RSS_PER_LAYER)
        PHASE_BEGIN for (int rep = 0; rep < PROBE_REP_GU; ++rep) { pg8::Gemm g{XB, wptr(P, l, O_WGU1), MTOK, 2 * D_FF, KL(D_MODEL)}; pg8::StaticOrder S; S.init(MTOK, 2 * D_FF, F.G, (int)blockIdx.x);
            pg8::EpiSwiGLU E{ACT, D_FF, rss_l + 0 * MTOK, 1.0f / D_MODEL}; pg8::gemm_phase<pg8::EpiSwiGLU, pg8::StaticOrder, PG_ALIGN_GU, PG_SP2>(F.lds, g, S, E); } PHASE_END
        PHASE_BEGIN { pg8::Gemm g{ACT, wptr(P, l, O_WD1), MTOK, D_MODEL, KL(D_FF)}; pg8::StaticOrder S; S.init(MTOK, D_MODEL, F.G, (int)blockIdx.x);
            pg8::EpiResid E{XB, (bf16_t*)(wsbase() + WS_XL), rss_l + 1 * MTOK, 0.5f}; pg8::gemm_phase<pg8::EpiResid, pg8::StaticOrder, PG_ALIGN, PG_SP2>(F.lds, g, S, E); } PHASE_END
        PHASE_BEGIN { pg8::Gemm g{XB, wptr(P, l, O_WIN), MTOK, N_IN_PAD, KL(D_MODEL)}; pg8::StaticOrder S; S.init(MTOK, WIN_MAIN_N, F.G, (int)blockIdx.x);
            pg8::EpiWin E{rss_l + 1 * MTOK, RCS, RSN, UU, QS, KS, VS, CQ, CKV, KR, rss_l + 3 * MTOK, rss_l + 4 * MTOK, 0.125f * LOG2E};
            pg8::gemm_phase<pg8::EpiWin, pg8::StaticOrder, PG_ALIGN, PG_SP2>(F.lds, g, S, E); } PHASE_END
        PHASE_BEGIN {
            const int bx = (int)blockIdx.x, G = F.G; const bool deal = (G == 256); const int xcd = bx & 7, slot = bx >> 3; const bool light = deal && slot < 8;
#if WIN_MAIN_N < 2304
            { pg8::Gemm g{XB, wptr(P, l, O_WIN), MTOK, N_IN_PAD, KL(D_MODEL)}; pg8::DealOrder S;
              if (deal) S = pg8::DealOrder{slot, 0, light ? 1 : 0, 1, xcd * 8, 8}; else S = pg8::DealOrder{bx, G, bx < 64 ? (64 - bx + G - 1) / G : 0, 1, 0, 8};
              pg8::EpiWin E{rss_l + 1 * MTOK, RCS, RSN, UU, QS, KS, VS, CQ, CKV, KR, rss_l + 3 * MTOK, rss_l + 4 * MTOK, 0.125f * LOG2E};
              pg8::gemm_phase<pg8::EpiWin, pg8::DealOrder, PG_ALIGN, PG_SP2>(F.lds, g, S, E); }
#endif
#ifndef NO_UQ
            { pg8::Gemm g{CQ, wptr(P, l, O_WUQ), MTOK, MLA_HEADS * MLA_QK, KL(MLA_QR)}; pg8::DealOrder S;
              if (deal) S = pg8::DealOrder{slot - 8, 24, light ? 0 : 2, 6, xcd * 8, 0}; else S = pg8::DealOrder{bx, G, bx < 384 ? (384 - bx + G - 1) / G : 0, 6, 0, 0};
              pg8::EpiUq E{QM, rss_l + 3 * MTOK, RCS, RSN, 0.07216878364870322f * LOG2E}; pg8::gemm_phase<pg8::EpiUq, pg8::DealOrder, PG_ALIGN, PG_SP2>(F.lds, g, S, E); }
#endif
#ifndef NO_UKV
            { pg8::Gemm g{CKV, wptr(P, l, O_WUKV), MTOK, 2048, KL(MLA_KVR)}; pg8::DealOrder S;
              if (deal) S = light ? pg8::DealOrder{48 + slot, 8, 2, 8, xcd * 8, 0} : pg8::DealOrder{slot - 8, 24, 2, 8, xcd * 8, 0}; else S = pg8::DealOrder{bx, G, bx < 512 ? (512 - bx + G - 1) / G : 0, 8, 0, 0};
              pg8::EpiBf16Rs E{KVM, 2048, rss_l + 4 * MTOK, 1.0f / MLA_KVR, 1.0f}; pg8::gemm_phase<pg8::EpiBf16Rs, pg8::DealOrder, PG_ALIGN, PG_SP2>(F.lds, g, S, E); }
#endif
#ifndef NO_SSM1
            for (int rep = 0; rep < PROBE_REP_SSM * PROBE_REP_SSM1; ++rep) ssm_pass1(F, P, l);
#endif
        } PHASE_END
        PHASE_BEGIN {
#ifndef NO_MLA
            for (int rep = 0; rep < PROBE_REP_MLA; ++rep)
            for (int u = F.vcu; u < 512; u += F.G) { const int half = u >> 8, v = u & 255, bh = v >> 3, s = v & 7, qb = half ? 15 - s : s, b = bh >> 3, hh = bh & 7;
                attn_unit<MLA_QK, MLA_NOPE, MLA_V, false>(F, QM + hh * MLA_QK, MLA_HEADS * MLA_QK, KVM + hh * 256, 2048, KR, MLA_ROPE, KVM + hh * 256 + 128, 2048,
                                                         YCAT + 1024 + hh * MLA_V, D_MIX, rep ? rssptr(P, NRSS) : rss_l + 7 * MTOK, b * SEQ, qb * 256, -1e30f, 0.f); }
#endif
#ifndef NO_SWA
            for (int rep = 0; rep < PROBE_REP_SWA; ++rep)
            for (int u = F.vcu; u < 512; u += F.G) { const int hq = u & 7, qb = (u >> 3) & 15, b = u >> 7, kvh = hq >> 2;
                attn_unit<SWA_HD, SWA_HD, SWA_HD, true, true>(F, QS + hq * SWA_HD, SWA_WIDTH, KS + kvh * SWA_HD, SWA_KV * SWA_HD, nullptr, 0, VS + kvh * SWA_HD, SWA_KV * SWA_HD,
                                                       YCAT + 512 + hq * SWA_HD, D_MIX, rep ? rssptr(P, NRSS + 1) : rss_l + 6 * MTOK, b * SEQ, qb * 256, KF(A_SWA_SINKS)[l * SWA_HEADS + hq] * LOG2E, 1.0f); }
#endif
#ifndef NO_SSM2
            for (int rep = 0; rep < PROBE_REP_SSM; ++rep)
            for (int u = F.vcu; u < BATCH * SSM_NCH; u += F.G) ssm_pass2_unit(F, P, l, u >> 6, u & 63);
#endif
        } PHASE_END
        PHASE_BEGIN { pg8::Gemm g{YCAT, wptr(P, l, O_WOUT), MTOK, D_MODEL, KL(D_MIX)}; pg8::StaticOrder S; S.init(MTOK, D_MODEL, F.G, (int)blockIdx.x);
            pg8::EpiResidSeg E{XB, (bf16_t*)(wsbase() + WS_XL), rss_l + 2 * MTOK, rss_l + 5 * MTOK, rss_l + 6 * MTOK, rss_l + 7 * MTOK};
            pg8::gemm_phase<pg8::EpiResidSeg, pg8::StaticOrder, PG_ALIGN, PG_SP2>(F.lds, g, S, E); } PHASE_END
        PHASE_BEGIN for (int rep = 0; rep < PROBE_REP_GU; ++rep) { pg8::Gemm g{XB, wptr(P, l, O_WGU2), MTOK, 2 * D_FF, KL(D_MODEL)}; pg8::StaticOrder S; S.init(MTOK, 2 * D_FF, F.G, (int)blockIdx.x);
            pg8::EpiSwiGLU E{ACT, D_FF, rss_l + 2 * MTOK, 1.0f / D_MODEL}; pg8::gemm_phase<pg8::EpiSwiGLU, pg8::StaticOrder, PG_ALIGN_GU, PG_SP2>(F.lds, g, S, E); } PHASE_END
        PHASE_BEGIN { pg8::Gemm g{ACT, wptr(P, l, O_WD2), MTOK, D_MODEL, KL(D_FF)}; pg8::StaticOrder S; S.init(MTOK, D_MODEL, F.G, (int)blockIdx.x);
            pg8::EpiResid E{XB, (bf16_t*)(wsbase() + WS_XL), rss_l + RSS_PER_LAYER * MTOK, 0.5f}; pg8::gemm_phase<pg8::EpiResid, pg8::StaticOrder, PG_ALIGN, PG_SP2>(F.lds, g, S, E); } PHASE_END
    }
    kk = 10;
    PHASE_BEGIN final_norm_phase(F, P); PHASE_END
#undef PHASE_BEGIN
#undef PHASE_END
}

extern "C" void kernel_launch(void* const* d_in, const int* in_sizes, int n_in, void* d_out, int out_size, void* d_ws, size_t ws_size, hipStream_t stream) {
    static int grid = 0;
    if (grid == 0) {
        if (n_in != 30 || in_sizes[0] != MTOK * D_MODEL || out_size != MTOK * D_MODEL || ws_size < WS_END + (PROBE_REP_DOWN > 1 ? (size_t)MTOK * D_MODEL * 6 : 0)) {
            fprintf(stderr, "kernel_launch: built for 30 inputs, x/out of %d floats, >= %zu bytes of workspace; got n_in %d, in0 %d, out %d, ws %zu; nothing launched\n", MTOK * D_MODEL, (size_t)WS_END, n_in, n_in > 0 ? in_sizes[0] : -1, out_size, ws_size);
            grid = -1; return; }
        int dev = 0, cus = 0, per_cu = 0;
        if (hipGetDevice(&dev) != hipSuccess || hipDeviceGetAttribute(&cus, hipDeviceAttributeMultiprocessorCount, dev) != hipSuccess) { fprintf(stderr, "kernel_launch: device query failed\n"); grid = -1; return; }
        if (hipFuncSetAttribute((const void*)mk_fwd, hipFuncAttributeMaxDynamicSharedMemorySize, LDS_BYTES) != hipSuccess) { fprintf(stderr, "kernel_launch: hipFuncSetAttribute failed\n"); grid = -1; return; }
        if (hipOccupancyMaxActiveBlocksPerMultiprocessor(&per_cu, (const void*)mk_fwd, NWAVES * 64, LDS_BYTES) != hipSuccess || per_cu < 1)
            fprintf(stderr, "kernel_launch: note: occupancy query reports %d workgroups per CU\n", per_cu);
        (void)hipGetLastError();
        grid = cus;
    }
    if (grid < 0) return;
    if (hipMemsetAsync((char*)d_ws + WS_CTL, 0, CTL_ZERO_BYTES, stream) != hipSuccess) { fprintf(stderr, "kernel_launch: hipMemsetAsync failed\n"); return; }
    Args a{};
    for (int i = 0; i < 30; ++i) a.in[i] = d_in[i];
    a.out = (float*)d_out; a.ws = (unsigned char*)d_ws;
#if MK_PER_PHASE
    for (int p = 0; p < N_PHASES; ++p) { a.ph_lo = p; a.ph_hi = p + 1; hipLaunchKernelGGL(mk_fwd, dim3(grid), dim3(NWAVES * 64), LDS_BYTES, stream, a); }
#else
    a.ph_lo = 0; a.ph_hi = N_PHASES; hipLaunchKernelGGL(mk_fwd, dim3(grid), dim3(NWAVES * 64), LDS_BYTES, stream, a);
#endif
    const hipError_t le = hipPeekAtLastError();
    if (le != hipSuccess) fprintf(stderr, "kernel_launch: launch failed: %s\n", hipGetErrorName(le));
}
```

```cpp
#include <hip/hip_runtime.h>
#include <cstdio>
#include <cstdint>
#include <cmath>

constexpr int D_MODEL = 2048, BATCH = 4, SEQ = 4096, DEPTH = 4, D_FF = 5632;
constexpr int MTOK = BATCH * SEQ;
constexpr float EPS = 1e-6f;
constexpr int SSM_GROUP = 16, SSM_WIDTH = 512, SSM_GROUPS = 32, SSM_STATE = 64;
constexpr int SWA_HEADS = 8, SWA_KV = 2, SWA_HD = 64, SWA_WINDOW = 128, SWA_WIDTH = 512;
constexpr int MLA_HEADS = 8, MLA_QR = 512, MLA_KVR = 256, MLA_NOPE = 128, MLA_ROPE = 64, MLA_V = 128, MLA_WIDTH = 1024;
constexpr int D_MIX = 2048, N_IN = 2112, N_IN_PAD = 2304;
#ifndef WIN_MAIN_N
#define WIN_MAIN_N 2048
#endif
constexpr int MLA_QK = MLA_NOPE + MLA_ROPE;
constexpr float LOG2E = 1.4426950408889634f;
namespace pg8 {
#define PG8_LAS __attribute__((address_space(3)))
typedef unsigned short bf16_t;
typedef short bf16x8 __attribute__((ext_vector_type(8)));
typedef float f32x4 __attribute__((ext_vector_type(4)));
typedef unsigned u32x4 __attribute__((ext_vector_type(4)));
constexpr int BM = 256, BK = 64, HALF = 128, HTB = HALF * BK * 2  , STAGE_BYTES = 8 * HTB, NXCD = 8, WGM = 8;

__host__ __device__ __forceinline__ int lds_byte(int r, int c) { const int st = (r >> 4) * 2 + (c >> 5), rr = r & 15, cc = c & 31, ob = rr * 64 + cc * 2; return st * 1024 + (ob ^ (((ob >> 9) & 1) << 5)); }
__host__ __device__ __forceinline__ void stage_rc(int b, int& R, int& C) { const int st = b / 1024, sb = b % 1024, swz = sb ^ (((sb >> 9) & 1) << 5); R = (st >> 1) * 16 + swz / 64; C = (st & 1) * 32 + (swz % 64) / 2; }
__host__ __device__ __forceinline__ int perm32(int rho) { const int n = rho >> 4, i = rho & 15; return 8 * (i >> 2) + 4 * n + (i & 3); }

struct Unit { int pm, pn; };
struct Gemm { const bf16_t* A; const bf16_t* Bt; int M, N, K; };

struct StaticOrder {
    int nM, nN, nwg, G, c;
    __host__ __device__ void init(int M, int N, int G_, int c_) { nM = M / BM; nN = N / BM; nwg = nM * nN; G = G_; c = c_; }
    __host__ __device__ bool next(int i, Unit& u) const {
        const long L = (long)i * G + c; if (L >= nwg) return false;
        int wgid = (int)L; { const int q = nwg / NXCD, r = nwg % NXCD, xcd = wgid % NXCD, off = wgid / NXCD; wgid = (xcd < r ? xcd * (q + 1) : r * (q + 1) + (xcd - r) * q) + off; }
        const int nig = WGM * nN, gid = wgid / nig, fm = gid * WGM, gsz = (nM - fm) < WGM ? (nM - fm) : WGM;
        u.pm = fm + ((wgid % nig) % gsz); u.pn = (wgid % nig) / gsz; return true;
    }
    __device__ __forceinline__ void a_ready(const Unit&) const {}
    __device__ __forceinline__ void done(const Unit&) const {}
};

struct DealOrder {
    int first, stride, cnt, nN, pm0, pn0;
    __host__ __device__ bool next(int i, Unit& u) const { if (i >= cnt) return false; const int lu = first + i * stride; u.pm = pm0 + lu / nN; u.pn = pn0 + lu % nN; return true; }
    __device__ __forceinline__ void a_ready(const Unit&) const {}
    __device__ __forceinline__ void done(const Unit&) const {}
};

__device__ __forceinline__ unsigned cvt_pk_bf16(float lo, float hi) { unsigned r; asm("v_cvt_pk_bf16_f32 %0, %1, %2" : "=v"(r) : "v"(lo), "v"(hi)); return r; }
typedef float f32x2 __attribute__((ext_vector_type(2)));
__device__ __forceinline__ f32x2 gelu_pk(f32x2 v) {
    const f32x2 av = __builtin_elementwise_abs(v), d = av * 0.2316418882f + 1.0f;
    f32x2 t; t.x = __builtin_amdgcn_rcpf(d.x); t.y = __builtin_amdgcn_rcpf(d.y);
    f32x2 q = t * 0.5307027145f + (-0.7265760135f); q = q * t + 0.7107068705f; q = q * t + (-0.142248368f); q = q * t + 0.127414796f; q = q * t;
    const f32x2 s = (v * v) * (-0.72134752044f);
    f32x2 e; e.x = __builtin_amdgcn_exp2f(s.x); e.y = __builtin_amdgcn_exp2f(s.y);
    const f32x2 m = v * (q * e), r = v - m;
    f32x2 o; o.x = v.x < 0.f ? m.x : r.x; o.y = v.y < 0.f ? m.y : r.y; return o;
}

template <int ACT  > struct EpiBf16 {
    static constexpr bool PERM = true, AFTER_DRAIN = false; static_assert(ACT == 0 || ACT == 1, "EpiBf16: ACT is 0 (none) or 1 (gelu_pk)");
    bf16_t* O; int ldc; const float* bias; int split_cols; size_t split_stride; float scale0;
    __device__ __forceinline__ void operator()(const f32x4 (&acc)[2][2][4][2], const Unit& u, int wr, int wc, int fr, int fq) const {
        const int row0 = u.pm * BM + wr * 64 + fr; int colt = u.pn * BM; bf16_t* base = O;
        float sc = 1.f; if (split_cols) { const int t = colt / split_cols; base += (size_t)t * split_stride; colt -= t * split_cols; if (t == 0) sc = scale0; }
        const int col0 = colt + wc * 32 + 8 * fq, bcol0 = u.pn * BM + wc * 32 + 8 * fq;
        f32x4 bv[2][2];
#pragma unroll
        for (int bj = 0; bj < 2; ++bj)
#pragma unroll
            for (int n = 0; n < 2; ++n) bv[bj][n] = bias ? *(const f32x4*)(bias + bcol0 + bj * HALF + 4 * n) : (f32x4){0.f, 0.f, 0.f, 0.f};
#pragma unroll
        for (int ai = 0; ai < 2; ++ai)
#pragma unroll
            for (int m = 0; m < 4; ++m) { bf16_t* rowp = base + (size_t)(row0 + ai * HALF + m * 16) * ldc + col0;
#pragma unroll
                for (int bj = 0; bj < 2; ++bj) { f32x4 v0 = acc[ai][bj][m][0] + bv[bj][0], v1 = acc[ai][bj][m][1] + bv[bj][1];
                    if (ACT == 1) { f32x2 a = gelu_pk((f32x2){v0[0], v0[1]}), b = gelu_pk((f32x2){v0[2], v0[3]}), c = gelu_pk((f32x2){v1[0], v1[1]}), d = gelu_pk((f32x2){v1[2], v1[3]});
                        v0 = (f32x4){a.x, a.y, b.x, b.y}; v1 = (f32x4){c.x, c.y, d.x, d.y}; }
                    v0 = v0 * sc; v1 = v1 * sc; u32x4 w; w.x = cvt_pk_bf16(v0[0], v0[1]); w.y = cvt_pk_bf16(v0[2], v0[3]); w.z = cvt_pk_bf16(v1[0], v1[1]); w.w = cvt_pk_bf16(v1[2], v1[3]);
                    *(u32x4*)(rowp + bj * HALF) = w; } }
    }
};


typedef unsigned u32x2 __attribute__((ext_vector_type(2)));
__device__ __forceinline__ int epi_vz() { int z; asm volatile("v_mov_b32 %0, 0" : "=v"(z)); return z; }
__device__ __forceinline__ void store8_bf16(bf16_t* p, f32x4 v0, f32x4 v1) {
    u32x4 w; w.x = cvt_pk_bf16(v0[0], v0[1]); w.y = cvt_pk_bf16(v0[2], v0[3]); w.z = cvt_pk_bf16(v1[0], v1[1]); w.w = cvt_pk_bf16(v1[2], v1[3]); *(u32x4*)p = w;
}
#ifndef ACT_NT
#define ACT_NT 0
#endif
__device__ __forceinline__ void store8_bf16_nt(bf16_t* p, f32x4 v0, f32x4 v1) {
    u32x4 w; w.x = cvt_pk_bf16(v0[0], v0[1]); w.y = cvt_pk_bf16(v0[2], v0[3]); w.z = cvt_pk_bf16(v1[0], v1[1]); w.w = cvt_pk_bf16(v1[2], v1[3]);
    if (ACT_NT) __builtin_nontemporal_store(w, (u32x4*)p); else *(u32x4*)p = w;
}
__device__ __forceinline__ float sumsq8(f32x4 a, f32x4 b) { return (a[0] * a[0] + a[1] * a[1]) + (a[2] * a[2] + a[3] * a[3]) + (b[0] * b[0] + b[1] * b[1]) + (b[2] * b[2] + b[3] * b[3]); }
__device__ __forceinline__ float silu_mul(float g, float u) { return g * __builtin_amdgcn_rcpf(1.0f + __builtin_amdgcn_exp2f(-g * LOG2E)) * u; }
__device__ __forceinline__ f32x4 silu_mul4(f32x4 g, f32x4 u) {
    const f32x4 a = g * (-LOG2E); f32x4 e, r;
#pragma unroll
    for (int k = 0; k < 4; ++k) e[k] = __builtin_amdgcn_exp2f(a[k]);
    const f32x4 d = e + 1.0f;
#pragma unroll
    for (int k = 0; k < 4; ++k) r[k] = __builtin_amdgcn_rcpf(d[k]);
    return (g * r) * u;
}
typedef unsigned long long rss_t;
__device__ __forceinline__ rss_t rss_enc(float ss) { return (rss_t)(long long)((double)ss * 4294967296.0); }
__device__ __forceinline__ float rss_dec(rss_t v) { return (float)((double)(long long)v * (1.0 / 4294967296.0)); }
__device__ __forceinline__ void row_atomic(rss_t* dst, float ss, int fq) { ss += __shfl_xor(ss, 16); ss += __shfl_xor(ss, 32); if (fq == 0) atomicAdd(dst, rss_enc(ss)); }
__device__ __forceinline__ void row_scales8(const rss_t* rss, int row0, float invn, float mul, float (&rs)[8]) {
    rss_t v[8];
#pragma unroll
    for (int i = 0; i < 8; ++i) v[i] = rss[row0 + (i >> 2) * HALF + (i & 3) * 16];
#pragma unroll
    for (int i = 0; i < 8; ++i) rs[i] = __builtin_amdgcn_rsqf(rss_dec(v[i]) * invn + EPS) * mul;
}

struct EpiSwiGLU {
    static constexpr bool PERM = true, AFTER_DRAIN = false, INIT_ACC = false, KSEG = false;
    bf16_t* O; int ldc; const rss_t* rss; float invn;
    __device__ __forceinline__ void operator()(const f32x4 (&acc)[2][2][4][2], const Unit& u, int wr, int wc, int fr_, int fq_) const { const int ez = epi_vz(), fr = fr_ + ez, fq = fq_ + ez;
        const int row0 = u.pm * BM + wr * 64 + fr, col0 = u.pn * HALF + wc * 32 + 8 * fq;
        float rs8[8]; row_scales8(rss, row0, invn, 1.0f, rs8);
#pragma unroll
        for (int ai = 0; ai < 2; ++ai)
#pragma unroll
            for (int m = 0; m < 4; ++m) { const int row = row0 + ai * HALF + m * 16; const float rs = rs8[4 * ai + m];
                const f32x4 h0 = silu_mul4(acc[ai][0][m][0] * rs, acc[ai][1][m][0] * rs), h1 = silu_mul4(acc[ai][0][m][1] * rs, acc[ai][1][m][1] * rs);
                store8_bf16_nt(O + (size_t)row * ldc + col0, h0, h1); }
    }
};
#ifndef RESID_LO
#define RESID_LO 0
#endif
#ifndef RESID_BATCH16
#define RESID_BATCH16 0
#endif
__device__ __forceinline__ f32x4 bf_lo4(u32x2 w) { return (f32x4){__uint_as_float(w.x << 16), __uint_as_float(w.x & 0xffff0000u), __uint_as_float(w.y << 16), __uint_as_float(w.y & 0xffff0000u)}; }
__device__ __forceinline__ float resid8(bf16_t* xb, bf16_t* xl, size_t off, f32x4 d0, f32x4 d1) {
    const u32x4 hv = *(const u32x4*)(xb + off);
    f32x4 a0 = bf_lo4((u32x2){hv.x, hv.y}), a1 = bf_lo4((u32x2){hv.z, hv.w});
    if (RESID_LO) { const u32x4 lv = *(const u32x4*)(xl + off); a0 = a0 + bf_lo4((u32x2){lv.x, lv.y}); a1 = a1 + bf_lo4((u32x2){lv.z, lv.w}); }
    const f32x4 v0 = a0 + d0, v1 = a1 + d1;
    u32x4 w; w.x = cvt_pk_bf16(v0[0], v0[1]); w.y = cvt_pk_bf16(v0[2], v0[3]); w.z = cvt_pk_bf16(v1[0], v1[1]); w.w = cvt_pk_bf16(v1[2], v1[3]);
    *(u32x4*)(xb + off) = w;
    if (RESID_LO) { const f32x4 r0 = v0 - bf_lo4((u32x2){w.x, w.y}), r1 = v1 - bf_lo4((u32x2){w.z, w.w}); store8_bf16(xl + off, r0, r1); }
    return sumsq8(v0, v1);
}
__device__ __forceinline__ float resid8v(bf16_t* xb, size_t off, u32x4 hv, f32x4 d0, f32x4 d1) {
    static_assert(!RESID_LO, "batched residual epilogue: bf16-only residual stream");
    const f32x4 v0 = bf_lo4((u32x2){hv.x, hv.y}) + d0, v1 = bf_lo4((u32x2){hv.z, hv.w}) + d1;
    u32x4 w; w.x = cvt_pk_bf16(v0[0], v0[1]); w.y = cvt_pk_bf16(v0[2], v0[3]); w.z = cvt_pk_bf16(v1[0], v1[1]); w.w = cvt_pk_bf16(v1[2], v1[3]);
    *(u32x4*)(xb + off) = w;
    return sumsq8(v0, v1);
}
struct EpiResid {
    static constexpr bool PERM = true, AFTER_DRAIN = false, INIT_ACC = false, KSEG = false;
    bf16_t* xb; bf16_t* xl; rss_t* rss_out; float scale;
    __device__ __forceinline__ void init(f32x4 (&acc)[2][2][4][2], const Unit& u, int wr, int wc, int fr_, int fq_) const {}
    __device__ __forceinline__ void operator()(const f32x4 (&acc)[2][2][4][2], const Unit& u, int wr, int wc, int fr_, int fq_) const { const int ez = epi_vz(), fr = fr_ + ez, fq = fq_ + ez;
        const int row0 = u.pm * BM + wr * 64 + fr, col0 = u.pn * BM + wc * 32 + 8 * fq;
        u32x4 hv[2][4][2];
#if RESID_BATCH16
#pragma unroll
        for (int ai = 0; ai < 2; ++ai)
#pragma unroll
            for (int m = 0; m < 4; ++m)
#pragma unroll
                for (int bj = 0; bj < 2; ++bj) hv[ai][m][bj] = *(const u32x4*)(xb + (size_t)(row0 + ai * HALF + m * 16) * D_MODEL + col0 + bj * HALF);
#endif
#pragma unroll
        for (int ai = 0; ai < 2; ++ai) {
#if !RESID_BATCH16
#pragma unroll
            for (int m = 0; m < 4; ++m)
#pragma unroll
                for (int bj = 0; bj < 2; ++bj) hv[ai][m][bj] = *(const u32x4*)(xb + (size_t)(row0 + ai * HALF + m * 16) * D_MODEL + col0 + bj * HALF);
#endif
#pragma unroll
            for (int m = 0; m < 4; ++m) { const int row = row0 + ai * HALF + m * 16; const size_t off = (size_t)row * D_MODEL + col0; float ss = 0.f;
#pragma unroll
                for (int bj = 0; bj < 2; ++bj) ss += resid8v(xb, off + bj * HALF, hv[ai][m][bj], acc[ai][bj][m][0] * scale, acc[ai][bj][m][1] * scale);
                if (rss_out) row_atomic(rss_out + row, ss, fq); } }
    }
};
struct EpiResidSeg {
    static constexpr bool PERM = true, AFTER_DRAIN = false, INIT_ACC = false, KSEG = true;
    bf16_t* xb; bf16_t* xl; rss_t* rss_out; const rss_t* r0; const rss_t* r1; const rss_t* r2;
    __device__ __forceinline__ void init(f32x4 (&acc)[2][2][4][2], const Unit& u, int wr, int wc, int fr_, int fq_) const {}
    __device__ __forceinline__ bool seg_boundary(int t) const { return t == SSM_WIDTH / BK || t == (SSM_WIDTH + SWA_WIDTH) / BK; }
    __device__ __forceinline__ float rsc(const rss_t* r, int row, float invn) const { return __builtin_amdgcn_rsqf(rss_dec(r[row]) * invn + EPS); }
    __device__ __forceinline__ void rescale(f32x4 (&acc)[2][2][4][2], const Unit& u, int t, int wr, int wc, int fr_, int fq_) const { const int ez = epi_vz(), fr = fr_ + ez;
        const int row0 = u.pm * BM + wr * 64 + fr; const bool first = (t == SSM_WIDTH / BK);
        float fa[8], fb[8];
        row_scales8(first ? r0 : r1, row0, 1.0f / SSM_WIDTH, 1.0f, fa); row_scales8(first ? r1 : r2, row0, first ? 1.0f / SWA_WIDTH : 1.0f / MLA_WIDTH, 1.0f, fb);
        static_assert(SSM_WIDTH == SWA_WIDTH, "the first two segments share 1/n");
#pragma unroll
        for (int ai = 0; ai < 2; ++ai)
#pragma unroll
            for (int m = 0; m < 4; ++m) { const float f = fa[4 * ai + m] * __builtin_amdgcn_rcpf(fb[4 * ai + m]);
#pragma unroll
                for (int bj = 0; bj < 2; ++bj) { acc[ai][bj][m][0] = acc[ai][bj][m][0] * f; acc[ai][bj][m][1] = acc[ai][bj][m][1] * f; } }
    }
    __device__ __forceinline__ void operator()(const f32x4 (&acc)[2][2][4][2], const Unit& u, int wr, int wc, int fr_, int fq_) const { const int ez = epi_vz(), fr = fr_ + ez, fq = fq_ + ez;
        const int row0 = u.pm * BM + wr * 64 + fr, col0 = u.pn * BM + wc * 32 + 8 * fq;
        float rs8[8]; row_scales8(r2, row0, 1.0f / MLA_WIDTH, 1.0f, rs8);
        u32x4 hv[2][4][2];
#if RESID_BATCH16
#pragma unroll
        for (int ai = 0; ai < 2; ++ai)
#pragma unroll
            for (int m = 0; m < 4; ++m)
#pragma unroll
                for (int bj = 0; bj < 2; ++bj) hv[ai][m][bj] = *(const u32x4*)(xb + (size_t)(row0 + ai * HALF + m * 16) * D_MODEL + col0 + bj * HALF);
#endif
#pragma unroll
        for (int ai = 0; ai < 2; ++ai) {
#if !RESID_BATCH16
#pragma unroll
            for (int m = 0; m < 4; ++m)
#pragma unroll
                for (int bj = 0; bj < 2; ++bj) hv[ai][m][bj] = *(const u32x4*)(xb + (size_t)(row0 + ai * HALF + m * 16) * D_MODEL + col0 + bj * HALF);
#endif
#pragma unroll
            for (int m = 0; m < 4; ++m) { const int row = row0 + ai * HALF + m * 16; const size_t off = (size_t)row * D_MODEL + col0; float ss = 0.f; const float sc = rs8[4 * ai + m];
#pragma unroll
                for (int bj = 0; bj < 2; ++bj) ss += resid8v(xb, off + bj * HALF, hv[ai][m][bj], acc[ai][bj][m][0] * sc, acc[ai][bj][m][1] * sc);
                row_atomic(rss_out + row, ss, fq); } }
    }
};
struct EpiNull {
    static constexpr bool PERM = true, AFTER_DRAIN = false, INIT_ACC = false, KSEG = false;
    float* sink;
    __device__ __forceinline__ void init(f32x4 (&acc)[2][2][4][2], const Unit& u, int wr, int wc, int fr_, int fq_) const {}
    __device__ __forceinline__ void operator()(const f32x4 (&acc)[2][2][4][2], const Unit& u, int wr, int wc, int fr, int fq) const {
        float s = 0.f;
#pragma unroll
        for (int ai = 0; ai < 2; ++ai)
#pragma unroll
            for (int bj = 0; bj < 2; ++bj)
#pragma unroll
                for (int m = 0; m < 4; ++m) s += acc[ai][bj][m][0][0] + acc[ai][bj][m][1][3] + acc[ai][bj][m][0][2] + acc[ai][bj][m][1][1];
        if (s == 123.456f) sink[u.pm * 8 + u.pn] = s;
    }
};
struct EpiBf16Rs {
    static constexpr bool PERM = true, AFTER_DRAIN = false, INIT_ACC = false, KSEG = false;
    bf16_t* O; int ldc; const rss_t* rss; float invn; float scale;
    __device__ __forceinline__ void operator()(const f32x4 (&acc)[2][2][4][2], const Unit& u, int wr, int wc, int fr_, int fq_) const { const int ez = epi_vz(), fr = fr_ + ez, fq = fq_ + ez;
        const int row0 = u.pm * BM + wr * 64 + fr, col0 = u.pn * BM + wc * 32 + 8 * fq;
float rs8[8]; row_scales8(rss, row0, invn, scale, rs8);
#pragma unroll
        for (int ai = 0; ai < 2; ++ai)
#pragma unroll
            for (int m = 0; m < 4; ++m) { const int row = row0 + ai * HALF + m * 16; const float rs = rs8[4 * ai + m];
#pragma unroll
                for (int bj = 0; bj < 2; ++bj) store8_bf16(O + (size_t)row * ldc + col0 + bj * HALF, acc[ai][bj][m][0] * rs, acc[ai][bj][m][1] * rs); }
    }
};
__device__ __forceinline__ void rope8(const f32x4 x1a, const f32x4 x1b, const f32x4 x2a, const f32x4 x2b, const float* cs, const float* sn, int i0, float sc, bf16_t* o1, bf16_t* o2) {
    const f32x4 ca = *(const f32x4*)(cs + i0), cb = *(const f32x4*)(cs + i0 + 4), sa = *(const f32x4*)(sn + i0), sb = *(const f32x4*)(sn + i0 + 4);
    store8_bf16(o1, (x1a * ca - x2a * sa) * sc, (x1b * cb - x2b * sb) * sc);
    store8_bf16(o2, (x2a * ca + x1a * sa) * sc, (x2b * cb + x1b * sb) * sc);
}
struct RopeTb { f32x4 ca, cb, sa, sb; };
__device__ __forceinline__ RopeTb rope_load(const float* cs, const float* sn, int row, int i0) {
    RopeTb t; const float* c = cs + (size_t)row * 32 + i0; const float* s = sn + (size_t)row * 32 + i0; t.ca = *(const f32x4*)c; t.cb = *(const f32x4*)(c + 4); t.sa = *(const f32x4*)s; t.sb = *(const f32x4*)(s + 4); return t; }
__device__ __forceinline__ void rope8v(const f32x4 x1a, const f32x4 x1b, const f32x4 x2a, const f32x4 x2b, const RopeTb& t, float sc, bf16_t* o1, bf16_t* o2) {
    store8_bf16(o1, (x1a * t.ca - x2a * t.sa) * sc, (x1b * t.cb - x2b * t.sb) * sc);
    store8_bf16(o2, (x2a * t.ca + x1a * t.sa) * sc, (x2b * t.cb + x1b * t.sb) * sc);
}
struct EpiWin {
    static constexpr bool PERM = true, AFTER_DRAIN = false, INIT_ACC = false, KSEG = false;
    const rss_t* rss; const float* cs; const float* sn;
    float* U; bf16_t* QS; bf16_t* KS; bf16_t* VS; bf16_t* CQ; bf16_t* CKV; bf16_t* KR; rss_t* rss_cq; rss_t* rss_ckv; float qscale; bf16_t* UB;
    __device__ __forceinline__ void operator()(const f32x4 (&acc)[2][2][4][2], const Unit& u, int wr, int wc, int fr_, int fq_) const { const int ez = epi_vz(), fr = fr_ + ez, fq = fq_ + ez;
        const int row0 = u.pm * BM + wr * 64 + fr, pn = u.pn, i0 = 8 * fq;
        if (pn == 8 && wc != 0) return;
        float rs8[8]; row_scales8(rss, row0, 1.0f / D_MODEL, 1.0f, rs8);
        const bool rope = (pn == 2) || (pn == 3) || (pn == 4 && wc < 2) || (pn == 8);
#pragma unroll
        for (int aim = 0; aim < 4; ++aim) { const int ai = aim >> 1; RopeTb tb[4];
            if (rope) {
#pragma unroll
                for (int m = 2 * (aim & 1); m < 2 * (aim & 1) + 2; ++m) tb[m] = rope_load(cs, sn, row0 + ai * HALF + m * 16, i0); }
#pragma unroll
            for (int m = 2 * (aim & 1); m < 2 * (aim & 1) + 2; ++m) { const int row = row0 + ai * HALF + m * 16; const float rs = rs8[4 * ai + m];
                const f32x4 a00 = acc[ai][0][m][0] * rs, a01 = acc[ai][0][m][1] * rs, a10 = acc[ai][1][m][0] * rs, a11 = acc[ai][1][m][1] * rs;
                if (pn < 2) { float* p = U + (size_t)row * SSM_WIDTH + pn * BM + wc * 32 + 8 * fq;
                    *(f32x4*)p = a00; *(f32x4*)(p + 4) = a01; *(f32x4*)(p + HALF) = a10; *(f32x4*)(p + HALF + 4) = a11;
                    { const int c0 = pn * BM + wc * 32 + 8 * fq; bf16_t* ub = UB + ((size_t)((c0 >> 4) * 256 + (row >> 6)) * 1024 + (row & 63) * 16 + (c0 & 15));
                      store8_bf16(ub, a00, a01); store8_bf16(ub + (size_t)(HALF >> 4) * 256 * 1024, a10, a11); } }
                else if (pn < 4) { bf16_t* p = QS + (size_t)row * SWA_WIDTH + ((pn - 2) * 4 + wc) * SWA_HD + i0;
                    rope8v(a00, a01, a10, a11, tb[m], qscale, p, p + 32); }
                else if (pn == 4) {
                    if (wc < 2) { bf16_t* p = KS + (size_t)row * (SWA_KV * SWA_HD) + wc * SWA_HD + i0; rope8v(a00, a01, a10, a11, tb[m], 1.0f, p, p + 32); }
                    else { bf16_t* p = VS + (size_t)row * (SWA_KV * SWA_HD) + (wc - 2) * 32 + i0; store8_bf16(p, a00, a01); store8_bf16(p + 64, a10, a11); } }
                else if (pn < 7) { bf16_t* p = CQ + (size_t)row * MLA_QR + (pn - 5) * BM + wc * 32 + 8 * fq; store8_bf16(p, a00, a01); store8_bf16(p + HALF, a10, a11);
                    row_atomic(rss_cq + row, sumsq8(a00, a01) + sumsq8(a10, a11), fq); }
                else if (pn == 7) { bf16_t* p = CKV + (size_t)row * MLA_KVR + wc * 32 + 8 * fq; store8_bf16(p, a00, a01); store8_bf16(p + HALF, a10, a11);
                    row_atomic(rss_ckv + row, sumsq8(a00, a01) + sumsq8(a10, a11), fq); }
                else { bf16_t* p = KR + (size_t)row * MLA_ROPE + i0; rope8v(a00, a01, a10, a11, tb[m], 1.0f, p, p + 32); }
            } }
    }
};
struct EpiUq {
    static constexpr bool PERM = true, AFTER_DRAIN = false, INIT_ACC = false, KSEG = false;
    bf16_t* QM; const rss_t* rss; const float* cs; const float* sn; float qscale;
    __device__ __forceinline__ void operator()(const f32x4 (&acc)[2][2][4][2], const Unit& u, int wr, int wc, int fr_, int fq_) const { const int ez = epi_vz(), fr = fr_ + ez, fq = fq_ + ez;
        const int row0 = u.pm * BM + wr * 64 + fr, pn = u.pn, i0 = 8 * fq;
        float rs8[8]; row_scales8(rss, row0, 1.0f / MLA_QR, 1.0f, rs8);
#pragma unroll
        for (int aim = 0; aim < 4; ++aim) { const int ai = aim >> 1; RopeTb tb[4];
            if (pn >= 4) {
#pragma unroll
                for (int m = 2 * (aim & 1); m < 2 * (aim & 1) + 2; ++m) tb[m] = rope_load(cs, sn, row0 + ai * HALF + m * 16, i0); }
#pragma unroll
            for (int m = 2 * (aim & 1); m < 2 * (aim & 1) + 2; ++m) { const int row = row0 + ai * HALF + m * 16; const float rs = rs8[4 * ai + m];
                bf16_t* qrow = QM + (size_t)row * (MLA_HEADS * MLA_QK);
                if (pn < 4) { const float s = rs * qscale;
                    store8_bf16(qrow + (2 * pn) * MLA_QK + wc * 32 + 8 * fq, acc[ai][0][m][0] * s, acc[ai][0][m][1] * s);
                    store8_bf16(qrow + (2 * pn + 1) * MLA_QK + wc * 32 + 8 * fq, acc[ai][1][m][0] * s, acc[ai][1][m][1] * s); }
                else { bf16_t* p = qrow + ((pn - 4) * 4 + wc) * MLA_QK + MLA_NOPE + i0;
                    rope8v(acc[ai][0][m][0] * rs, acc[ai][0][m][1] * rs, acc[ai][1][m][0] * rs, acc[ai][1][m][1] * rs, tb[m], qscale, p, p + 32); }
            } }
    }
};
template <class Epi, class Sched, bool ALIGN_EPI = false, bool SP2 = false>
__device__ __forceinline__ void gemm_phase(PG8_LAS unsigned char* lds, const Gemm g, const Sched& S, const Epi& E) {
    int tid_z; asm volatile("v_mov_b32 %0, 0" : "=v"(tid_z));
    const int tid = threadIdx.x + tid_z, wid = __builtin_amdgcn_readfirstlane(tid >> 6), lane = tid & 63, wr = wid >> 2, wc = wid & 3, fr = lane & 15, fq = lane >> 4;
    const int K = g.K, nt = K / BK;
    unsigned voffA[2], voffB[2];
#pragma unroll
    for (int i = 0; i < 2; ++i) { int R, C; stage_rc(tid * 16 + i * 8192, R, C); const int Rb = Epi::PERM ? ((R & ~31) + perm32(R & 31)) : R;
        voffA[i] = (unsigned)(R * K + C) * 2u; voffB[i] = (unsigned)(Rb * K + C) * 2u; }
    const size_t kstep = (size_t)(BK * 2);
    const size_t hstep = (size_t)HALF * K * 2;
    const size_t tstep = 2 * hstep;
    const unsigned ldsw = (unsigned)wid * 1024u;
    const int aoff = lds_byte(wr * 64 + fr, fq * 8), boff = lds_byte(wc * 32 + fr, fq * 8);
#define PG8_SA(b, h) (((b) * 2 + (h)) * HTB)
#define PG8_SB(b, h) ((4 + (b) * 2 + (h)) * HTB)
#define PG8_STAGE(bufoff, gbase, voff) do { _Pragma("unroll") for (int _i = 0; _i < 2; ++_i) \
        __builtin_amdgcn_global_load_lds((const unsigned*)((const char*)(gbase) + (voff)[_i]), (PG8_LAS unsigned*)(lds + (bufoff) + ldsw + _i * 8192), 16, 0, 0); } while (0)
#define PG8_LDA(dst, b, h) do { _Pragma("unroll") for (int m = 0; m < 4; ++m) _Pragma("unroll") for (int k = 0; k < 2; ++k) dst[m][k] = *(const PG8_LAS bf16x8*)(lds + PG8_SA(b, h) + aoff + m * 2048 + k * 1024); } while (0)
#define PG8_LDB(dst, b, h) do { _Pragma("unroll") for (int n = 0; n < 2; ++n) _Pragma("unroll") for (int k = 0; k < 2; ++k) dst[n][k] = *(const PG8_LAS bf16x8*)(lds + PG8_SB(b, h) + boff + n * 2048 + k * 1024); } while (0)
#define PG8_MMA(ai, bj, At, Bt) do { __builtin_amdgcn_s_setprio(1); _Pragma("unroll") for (int m = 0; m < 4; ++m) _Pragma("unroll") for (int n = 0; n < 2; ++n) _Pragma("unroll") for (int k = 0; k < 2; ++k) \
        acc[ai][bj][m][n] = __builtin_amdgcn_mfma_f32_16x16x32_bf16(Bt[n][k], At[m][k], acc[ai][bj][m][n], 0, 0, 0); __builtin_amdgcn_s_setprio(0); } while (0)
#define PG8_WAIT_V(n) asm volatile("s_waitcnt vmcnt(" #n ")" ::: "memory")
#define PG8_WAIT_L(n) asm volatile("s_waitcnt lgkmcnt(" #n ")" ::: "memory")
#define PG8_BAR __builtin_amdgcn_s_barrier()
#define PG8_SCHED __builtin_amdgcn_sched_barrier(0)
    Unit cur, nxt; int ui = 0;
    if (!S.next(0, cur)) return;
    f32x4 acc[2][2][4][2];
    if constexpr (Epi::INIT_ACC) E.init(acc, cur, wr, wc, fr, fq);
    else {
#pragma unroll
    for (int a = 0; a < 2; ++a)
#pragma unroll
        for (int b = 0; b < 2; ++b)
#pragma unroll
            for (int m = 0; m < 4; ++m)
#pragma unroll
                for (int n = 0; n < 2; ++n) acc[a][b][m][n] = (f32x4){0.f, 0.f, 0.f, 0.f};
    }
    bf16x8 At[4][2], B0[2][2], B1[2][2];
    const char* cA = (const char*)g.A + (size_t)cur.pm * tstep; const char* cB = (const char*)g.Bt + (size_t)cur.pn * tstep;
    S.a_ready(cur);
    if constexpr (SP2) {
        PG8_STAGE(PG8_SB(0, 0), cB, voffB); PG8_STAGE(PG8_SB(0, 1), cB + hstep, voffB); PG8_STAGE(PG8_SA(0, 0), cA, voffA); PG8_STAGE(PG8_SA(0, 1), cA + hstep, voffA);
        if (wr == 1) PG8_BAR;
        PG8_WAIT_V(2); PG8_BAR;
        PG8_STAGE(PG8_SB(1, 0), cB + kstep, voffB); PG8_STAGE(PG8_SA(1, 0), cA + kstep, voffA); PG8_STAGE(PG8_SB(1, 1), cB + hstep + kstep, voffB);
        PG8_WAIT_V(6); PG8_BAR;
    } else {
        PG8_STAGE(PG8_SB(0, 0), cB, voffB); PG8_STAGE(PG8_SA(0, 0), cA, voffA); PG8_STAGE(PG8_SB(0, 1), cB + hstep, voffB); PG8_STAGE(PG8_SA(0, 1), cA + hstep, voffA);
        if (wr == 1) PG8_BAR;
        PG8_WAIT_V(4); PG8_BAR;
        PG8_STAGE(PG8_SB(1, 0), cB + kstep, voffB); PG8_STAGE(PG8_SA(1, 0), cA + kstep, voffA); PG8_STAGE(PG8_SB(1, 1), cB + hstep + kstep, voffB);
        PG8_WAIT_V(6); PG8_BAR;
    }
    for (;;) {
        const bool has_next = S.next(ui + 1, nxt);
        const char* nA = has_next ? (const char*)g.A + (size_t)nxt.pm * tstep : cA; const char* nB = has_next ? (const char*)g.Bt + (size_t)nxt.pn * tstep : cB;
        for (int t = 0; t < nt; t += 2) {
            if constexpr (Epi::KSEG) { if (E.seg_boundary(t)) E.rescale(acc, cur, t, wr, wc, fr, fq); }
            const bool last = (t == nt - 2);
            const char* a1 = cA + (size_t)(t + 1) * kstep;
            const char* a2 = last ? nA : cA + (size_t)(t + 2) * kstep; const char* b2 = last ? nB : cB + (size_t)(t + 2) * kstep;
            const char* a3 = a2 + kstep; const char* b3 = b2 + kstep;
            if (last && has_next) S.a_ready(nxt);
            if constexpr (SP2) {
            PG8_LDB(B0, 0, 0); PG8_LDB(B1, 0, 1); PG8_SCHED; PG8_LDA(At, 0, 0); PG8_STAGE(PG8_SA(1, 1), a1 + hstep, voffA);
            PG8_WAIT_V(8); PG8_WAIT_L(0); PG8_BAR; PG8_MMA(0, 0, At, B0); PG8_MMA(0, 1, At, B1); PG8_BAR; PG8_SCHED;
            PG8_LDA(At, 0, 1); PG8_STAGE(PG8_SB(0, 0), b2, voffB); PG8_STAGE(PG8_SB(0, 1), b2 + hstep, voffB); PG8_STAGE(PG8_SA(0, 0), a2, voffA);
            PG8_WAIT_V(8); PG8_WAIT_L(0); PG8_BAR; PG8_MMA(1, 0, At, B0); PG8_MMA(1, 1, At, B1); PG8_BAR; PG8_SCHED;
            PG8_LDB(B0, 1, 0); PG8_LDB(B1, 1, 1); PG8_SCHED; PG8_LDA(At, 1, 0); PG8_STAGE(PG8_SA(0, 1), a2 + hstep, voffA);
            PG8_WAIT_V(8); PG8_WAIT_L(0); PG8_BAR; PG8_MMA(0, 0, At, B0); PG8_MMA(0, 1, At, B1); PG8_BAR; PG8_SCHED;
            PG8_LDA(At, 1, 1); PG8_STAGE(PG8_SB(1, 0), b3, voffB); PG8_STAGE(PG8_SB(1, 1), b3 + hstep, voffB); PG8_STAGE(PG8_SA(1, 0), a3, voffA);
            PG8_WAIT_V(8); PG8_WAIT_L(0); PG8_BAR; PG8_MMA(1, 0, At, B0); PG8_MMA(1, 1, At, B1); PG8_BAR; PG8_SCHED;
            } else {
            PG8_LDB(B0, 0, 0); PG8_SCHED; PG8_LDA(At, 0, 0); PG8_STAGE(PG8_SA(1, 1), a1 + hstep, voffA);
            PG8_WAIT_L(8); PG8_BAR; PG8_WAIT_L(0); PG8_MMA(0, 0, At, B0); PG8_BAR; PG8_SCHED;
            PG8_LDB(B1, 0, 1); PG8_STAGE(PG8_SB(0, 0), b2, voffB);
            PG8_BAR; PG8_WAIT_L(0); PG8_MMA(0, 1, At, B1); PG8_BAR;
            PG8_LDA(At, 0, 1); PG8_STAGE(PG8_SA(0, 0), a2, voffA);
            PG8_BAR; PG8_WAIT_L(0); PG8_MMA(1, 0, At, B0); PG8_BAR; PG8_SCHED;
            PG8_STAGE(PG8_SB(0, 1), b2 + hstep, voffB);
            PG8_WAIT_V(6); PG8_BAR; PG8_MMA(1, 1, At, B1); PG8_BAR;
            PG8_LDB(B0, 1, 0); PG8_SCHED; PG8_LDA(At, 1, 0); PG8_STAGE(PG8_SA(0, 1), a2 + hstep, voffA);
            PG8_WAIT_L(8); PG8_BAR; PG8_WAIT_L(0); PG8_MMA(0, 0, At, B0); PG8_BAR; PG8_SCHED;
            PG8_LDB(B1, 1, 1); PG8_STAGE(PG8_SB(1, 0), b3, voffB);
            PG8_BAR; PG8_WAIT_L(0); PG8_MMA(0, 1, At, B1); PG8_BAR;
            PG8_LDA(At, 1, 1); PG8_STAGE(PG8_SA(1, 0), a3, voffA);
            PG8_BAR; PG8_WAIT_L(0); PG8_MMA(1, 0, At, B0); PG8_BAR; PG8_SCHED;
            PG8_STAGE(PG8_SB(1, 1), b3 + hstep, voffB);
            PG8_WAIT_V(6); PG8_BAR; PG8_MMA(1, 1, At, B1); PG8_BAR;
            }
        }
        if constexpr (ALIGN_EPI) { if (wr == 0) PG8_BAR; }
        if constexpr (!Epi::AFTER_DRAIN) { E(acc, cur, wr, wc, fr, fq); S.done(cur); }
        if (!has_next) break;
        if constexpr (Epi::INIT_ACC) E.init(acc, nxt, wr, wc, fr, fq);
        else {
#pragma unroll
        for (int a = 0; a < 2; ++a)
#pragma unroll
            for (int b = 0; b < 2; ++b)
#pragma unroll
                for (int m = 0; m < 4; ++m)
#pragma unroll
                    for (int n = 0; n < 2; ++n) acc[a][b][m][n] = (f32x4){0.f, 0.f, 0.f, 0.f};
        }
        cur = nxt; cA = nA; cB = nB; ++ui;
        if constexpr (ALIGN_EPI) { if (wr == 1) PG8_BAR; }
    }
    PG8_WAIT_V(0);
    if constexpr (!ALIGN_EPI) { if (wr == 0) PG8_BAR; }
    PG8_BAR;
    if constexpr (Epi::AFTER_DRAIN) { E.fused(acc, cur, wr, wc, fr, fq, lds, wid, lane); S.done(cur); }
#undef PG8_SA
#undef PG8_SB
#undef PG8_STAGE
#undef PG8_LDA
#undef PG8_LDB
#undef PG8_MMA
#undef PG8_WAIT_V
#undef PG8_WAIT_L
#undef PG8_BAR
#undef PG8_SCHED
}
}
#define GAS __attribute__((address_space(1)))
#define LAS __attribute__((address_space(3)))
typedef unsigned short bf16;
typedef unsigned v4u __attribute__((ext_vector_type(4)));
typedef float f32x4 __attribute__((ext_vector_type(4)));
typedef short bf16x8 __attribute__((ext_vector_type(8)));
typedef GAS unsigned gu32;
typedef GAS unsigned long long gu64;
#define RLX_AGENT __ATOMIC_RELAXED, __HIP_MEMORY_SCOPE_AGENT
#define LDS_WAIT() asm volatile("s_waitcnt lgkmcnt(0)" ::: "memory")
#define VM_WAIT() asm volatile("s_waitcnt vmcnt(0)" ::: "memory")
__device__ __forceinline__ unsigned long long rt() { return __builtin_amdgcn_s_memrealtime(); }
__device__ __forceinline__ unsigned f2bf(float f) { unsigned u = __builtin_bit_cast(unsigned, f); return (u + 0x7fffu + ((u >> 16) & 1u)) >> 16; }
__device__ __forceinline__ unsigned pk2(float lo, float hi) { return f2bf(lo) | (f2bf(hi) << 16); }

#define XB_TMO      128
#define XB_XCNT(j)  (256  + 64 * (j))
#define XB_XSUB(j)  (1280 + 64 * (j))
#define XB_XGEN(j)  (2304 + 64 * (j))
#define XB_TOP      3328
#define XB_TOPGEN   3392
#define XCD_BAR_WORDS 3456
#define XB_SPIN_CAP (1u << 18)

__device__ __forceinline__ unsigned xb_ld(unsigned* p)              { return __hip_atomic_load(p, __ATOMIC_RELAXED, __HIP_MEMORY_SCOPE_AGENT); }
__device__ __forceinline__ unsigned xb_add(unsigned* p, unsigned v) { return __hip_atomic_fetch_add(p, v, __ATOMIC_RELAXED, __HIP_MEMORY_SCOPE_AGENT); }
__device__ __forceinline__ unsigned xb_xcc_id() { return (unsigned)__builtin_amdgcn_s_getreg((3 << 11) | 20) & 0xFu; }
#define XB_SPIN(cond, bar) do { unsigned _sp = 0; while (cond) { __builtin_amdgcn_s_sleep(1); \
    if ((++_sp & 255u) == 0u) { if (xb_ld(&(bar)[XB_TMO])) break; if (_sp > XB_SPIN_CAP) { atomicAdd(&(bar)[XB_TMO], 1u); break; } } } } while (0)

struct XcdBarrier {
    unsigned* bar; unsigned x;
    volatile LAS unsigned* st;
};

__device__ __forceinline__ XcdBarrier xcd_barrier_post(unsigned* bar, volatile LAS unsigned* st) {
    XcdBarrier b; b.bar = bar; b.x = xb_xcc_id(); b.st = st;
    if (threadIdx.x == 0) (void)xb_add(&bar[XB_XCNT(b.x)], 1u);
    return b;
}
__device__ __forceinline__ void xcd_barrier_complete(unsigned* bar, unsigned x, unsigned& nloc, unsigned& nx) {
    const unsigned G = gridDim.x * gridDim.y * gridDim.z;
    unsigned sum, cnt, mine, sp = 0u;
    for (;;) {
        sum = 0u; cnt = 0u; mine = 0u;
#pragma unroll
        for (unsigned j = 0; j < 16; ++j) { const unsigned c = xb_ld(&bar[XB_XCNT(j)]); sum += c; cnt += (c > 0u) ? 1u : 0u; mine = (j == x) ? c : mine; }
        if (sum == G) break;
        __builtin_amdgcn_s_sleep(1);
        if ((++sp & 255u) == 0u) { if (xb_ld(&bar[XB_TMO])) break; if (sp > XB_SPIN_CAP) { atomicAdd(&bar[XB_TMO], 1u); break; } }
    }
    nloc = mine > 0u ? mine : 1u; nx = cnt > 0u ? cnt : 1u;
}

__device__ __forceinline__ void xcd_barrier(const XcdBarrier& b) {
    asm volatile("s_waitcnt vmcnt(0)" ::: "memory");
    __syncthreads();
    if (threadIdx.x == 0) {
        unsigned* bar = b.bar;
        __builtin_amdgcn_s_waitcnt(0);
        unsigned nloc = b.st[0], nx = b.st[1];
        if (nloc == 0u) { xcd_barrier_complete(bar, b.x, nloc, nx); b.st[0] = nloc; b.st[1] = nx; }
        const unsigned old = xb_add(&bar[XB_XSUB(b.x)], 1u);
        const unsigned gen = old / nloc;
        if (old + 1u == (gen + 1u) * nloc) {
            __builtin_amdgcn_fence(__ATOMIC_RELEASE, "agent");
            asm volatile("s_waitcnt vmcnt(0)" ::: "memory");
            const unsigned og = xb_add(&bar[XB_TOP], 1u);
            const unsigned tg = og / nx;
            if (og + 1u == (tg + 1u) * nx) xb_add(&bar[XB_TOPGEN], 1u);
            else XB_SPIN(xb_ld(&bar[XB_TOPGEN]) == tg, bar);
            __builtin_amdgcn_fence(__ATOMIC_ACQUIRE, "agent");
            xb_add(&bar[XB_XGEN(b.x)], 1u);
            asm volatile("s_waitcnt vmcnt(0)" ::: "memory");
        } else {
            XB_SPIN(xb_ld(&bar[XB_XGEN(b.x)]) == gen, bar);
            __builtin_amdgcn_fence(__ATOMIC_ACQUIRE, "agent");
            asm volatile("s_waitcnt vmcnt(0)" ::: "memory");
        }
    }
    __syncthreads();
}

constexpr int NWAVES = 8;
constexpr size_t MiB = 1u << 20;
constexpr size_t WS_CTL = 0, CTL_ZERO_BYTES = 8 * MiB;
constexpr int CW_BAR = 4096;
constexpr size_t RSS_OFF = 1 * MiB;
constexpr int RSS_PER_LAYER = 8, NRSS = DEPTH * RSS_PER_LAYER + 1;
static_assert(RSS_OFF + (size_t)(NRSS + 2) * MTOK * 8 <= CTL_ZERO_BYTES && (CW_BAR + 3456) * 4 <= (int)RSS_OFF, "control region");
constexpr size_t E_WGU = (size_t)2 * D_FF * D_MODEL, E_WD = (size_t)D_MODEL * D_FF, E_WIN = (size_t)N_IN_PAD * D_MODEL, E_WUQ = (size_t)MLA_HEADS * MLA_QK * MLA_QR,
                 E_WUKV = (size_t)MLA_HEADS * 256 * MLA_KVR, E_WGLU = (size_t)SSM_WIDTH * SSM_WIDTH, E_WOUT = (size_t)D_MODEL * D_MIX;
constexpr size_t O_WGU1 = 0, O_WD1 = O_WGU1 + E_WGU, O_WIN = O_WD1 + E_WD, O_WUQ = O_WIN + E_WIN, O_WUKV = O_WUQ + E_WUQ, O_WGLU = O_WUKV + E_WUKV, O_WOUT = O_WGLU + E_WGLU,
                 O_WGU2 = O_WOUT + E_WOUT, O_WD2 = O_WGU2 + E_WGU, E_LAYER = O_WD2 + E_WD;
constexpr size_t WS_W = CTL_ZERO_BYTES;
constexpr size_t WS_XB = WS_W + (size_t)DEPTH * E_LAYER * 2;
constexpr size_t WS_XL = WS_XB + (size_t)MTOK * D_MODEL * 2;
constexpr size_t WS_ROPE = WS_XL + (size_t)MTOK * D_MODEL * 2;
constexpr size_t WS_SSMC = WS_ROPE + (size_t)MTOK * 32 * 4 * 2;
constexpr size_t SSMC_A = 0, SSMC_AT = 32 * 64 * 2, SSMC_BB = 2 * 32 * 64 * 2, SSMC_LAYER = SSMC_BB + 32 * 64 * 32;
constexpr size_t WS_SST = WS_SSMC + (size_t)DEPTH * SSMC_LAYER * 4;
constexpr size_t WS_ACT = WS_SST + (size_t)BATCH * 64 * 32 * 64 * 2 * 4;
constexpr size_t WS_U = WS_ACT;
constexpr size_t WS_QS = WS_U + (size_t)MTOK * 512 * 4, WS_KS = WS_QS + (size_t)MTOK * 512 * 2, WS_VS = WS_KS + (size_t)MTOK * 128 * 2, WS_CQ = WS_VS + (size_t)MTOK * 128 * 2,
                 WS_CKV = WS_CQ + (size_t)MTOK * 512 * 2, WS_KR = WS_CKV + (size_t)MTOK * 256 * 2, WS_QM = WS_KR + (size_t)MTOK * 64 * 2, WS_KVM = WS_QM + (size_t)MTOK * 1536 * 2,
                 WS_YCAT = WS_KVM + (size_t)MTOK * 2048 * 2, WS_MIXEND = WS_YCAT + (size_t)MTOK * 2048 * 2;
constexpr size_t WS_ACTEND = WS_ACT + (size_t)MTOK * D_FF * 2;
constexpr size_t WS_END0 = (WS_MIXEND > WS_ACTEND ? WS_MIXEND : WS_ACTEND);
constexpr size_t WS_UB = WS_END0;
constexpr size_t WS_P1W = WS_UB + (size_t)32 * 256 * 1024 * 2;
constexpr size_t WS_END = WS_P1W + (size_t)DEPTH * 32 * 128 * 1024 * 2;
static_assert(WS_W % 256 == 0 && WS_XB % 256 == 0 && WS_ROPE % 256 == 0 && WS_SSMC % 256 == 0 && WS_SST % 256 == 0 && WS_ACT % 256 == 0, "alignment");

constexpr int RING_BYTES = 146432;
constexpr int MISC_OFF = RING_BYTES;
constexpr int LDS_BYTES = 147456;
static_assert(MISC_OFF + 128 <= LDS_BYTES, "LDS map");

typedef unsigned short bf16_t;
typedef float f32x16 __attribute__((ext_vector_type(16)));
typedef short s16x4 __attribute__((ext_vector_type(4)));
typedef unsigned u32x4 __attribute__((ext_vector_type(4)));
typedef unsigned u32x2 __attribute__((ext_vector_type(2)));
using pg8::cvt_pk_bf16; using pg8::rss_t; using pg8::rss_enc; using pg8::rss_dec;
__device__ __forceinline__ float bf2f(unsigned short b) { return __uint_as_float((unsigned)b << 16); }
__device__ __forceinline__ float wave_sum(float v) {
#pragma unroll
    for (int o = 1; o < 64; o <<= 1) v += __shfl_xor(v, o);
    return v;
}
__device__ __forceinline__ int vzero() { int z; asm volatile("v_mov_b32 %0, 0" : "=v"(z)); return z; }

struct Frame {
    LAS unsigned char* lds;
    int tid, lane, wave;
    int vcu, G;
};

__device__ __forceinline__ void conv_item(const float* W, int ldw, int K, int src_col0, const float* gain, bf16_t* WT, int dst_row0, int k0, LAS float* scr, int lane) {
#pragma unroll 8
    for (int i = 0; i < 32; ++i) { const int kk = 2 * i + (lane >> 5); float v = W[(size_t)(k0 + kk) * ldw + src_col0 + (lane & 31)]; if (gain) v *= gain[k0 + kk]; scr[kk * 33 + (lane & 31)] = v; }
    LDS_WAIT(); asm volatile("" ::: "memory");
    const int c = lane & 7;
#pragma unroll
    for (int j = 0; j < 4; ++j) { const int n = (lane >> 3) + 8 * j; const LAS float* s = scr + (8 * c) * 33 + n;
        u32x4 o; o.x = cvt_pk_bf16(s[0 * 33], s[1 * 33]); o.y = cvt_pk_bf16(s[2 * 33], s[3 * 33]); o.z = cvt_pk_bf16(s[4 * 33], s[5 * 33]); o.w = cvt_pk_bf16(s[6 * 33], s[7 * 33]);
        *(u32x4*)(WT + (size_t)(dst_row0 + n) * K + k0 + 8 * c) = o; }
    LDS_WAIT(); asm volatile("" ::: "memory");
}
__device__ __forceinline__ void zero_item(bf16_t* WT, int K, int dst_row0, int k0, int lane) {
    const int c = lane & 7;
#pragma unroll
    for (int j = 0; j < 4; ++j) { const int n = (lane >> 3) + 8 * j; *(u32x4*)(WT + (size_t)(dst_row0 + n) * K + k0 + 8 * c) = (u32x4){0u, 0u, 0u, 0u}; }
}
__device__ __forceinline__ int win_src_col(int db) {
    const int t = db >> 3, j = db & 7;
    if (t < 2) return db * 32;
    if (t < 4) return 512 + ((t - 2) * 4 + (j & 3)) * 64 + (j >> 2) * 32;
    if (t == 4) { if ((j & 3) < 2) return 1024 + (j & 3) * 64 + (j >> 2) * 32;
                  return 1152 + (j >> 2) * 64 + ((j & 3) - 2) * 32; }
    if (t < 8) return 1280 + (db - 40) * 32;
    if (j == 0) return 2048; if (j == 4) return 2080;
    return -1;
}
__device__ __forceinline__ int wuq_src_col(int db) {
    const int t = db >> 3, j = db & 7;
    if (t < 4) return (2 * t + (j >> 2)) * MLA_QK + (j & 3) * 32;
    return ((t - 4) * 4 + (j & 3)) * MLA_QK + MLA_NOPE + (j >> 2) * 32;
}

enum ArgIdx { A_X = 0, A_POS, A_FFN1_NORM, A_FFN1_WG, A_FFN1_WU, A_FFN1_WD, A_MIX_NORM, A_W_IN, A_SSM_LOG_DT, A_SSM_A_RE, A_SSM_A_IM, A_SSM_B_RE, A_SSM_B_IM, A_SSM_C_RE, A_SSM_C_IM, A_SSM_D,
              A_SSM_W_GLU, A_SSM_B_GLU, A_SWA_SINKS, A_MLA_Q_NORM, A_MLA_W_UQ, A_MLA_KV_NORM, A_MLA_W_UKV, A_OUT_NORM, A_W_OUT, A_FFN2_NORM, A_FFN2_WG, A_FFN2_WU, A_FFN2_WD, A_FINAL_NORM, A_OUT, A_WS };
__device__ __forceinline__ const void* karg(int i) {
    unsigned long long v; asm volatile("s_load_dwordx2 %0, %1, %2\n\ts_waitcnt lgkmcnt(0)" : "=s"(v) : "s"(__builtin_amdgcn_kernarg_segment_ptr()), "i"(i * 8) : "memory");
    return (const void*)(const GAS unsigned char*)v; }
#define KF(i) ((const float*)karg(i))
struct Ptrs { int dummy; };
__device__ __forceinline__ unsigned char* wsbase() { return (unsigned char*)karg(A_WS); }
__device__ __forceinline__ bf16_t* wptr(const Ptrs&, int l, size_t off) { return (bf16_t*)(wsbase() + WS_W) + (size_t)l * E_LAYER + off; }
__device__ __forceinline__ rss_t* rssptr(const Ptrs&, int idx) { return (rss_t*)(wsbase() + RSS_OFF) + (size_t)idx * MTOK; }

constexpr int CI_GU = (2 * D_FF / 32) * (D_MODEL / 64), CI_D = (D_MODEL / 32) * (D_FF / 64), CI_IN = (N_IN_PAD / 32) * (D_MODEL / 64), CI_UQ = (MLA_HEADS * MLA_QK / 32) * (MLA_QR / 64),
              CI_UKV = (2048 / 32) * (MLA_KVR / 64), CI_GLU = (SSM_WIDTH / 32) * (SSM_WIDTH / 64), CI_OUT = (D_MODEL / 32) * (D_MIX / 64);
constexpr int CI_LAYER = 2 * (CI_GU + CI_D) + CI_IN + CI_UQ + CI_UKV + CI_GLU + CI_OUT, CI_TOTAL = DEPTH * CI_LAYER;
struct ConvJob { const float* src; const float* gain; bf16_t* dst; int ldw, K; };
__device__ __forceinline__ void conv_decode(int I, ConvJob& J) {
    const int l = I / CI_LAYER; int r = I - l * CI_LAYER;
    const float* W; const float* gn = nullptr; int ldw, K, db, kb, sc; size_t off;
    if (r < 2 * (CI_GU + CI_D)) { const int f = r >= (CI_GU + CI_D); if (f) r -= CI_GU + CI_D;
        if (r < CI_GU) { K = D_MODEL; ldw = D_FF; db = r / (D_MODEL / 64); kb = r % (D_MODEL / 64); const int t = db >> 3, j = db & 7;
            W = ((j < 4) ? (f ? KF(A_FFN2_WG) : KF(A_FFN1_WG)) : (f ? KF(A_FFN2_WU) : KF(A_FFN1_WU))) + (size_t)l * D_MODEL * D_FF; gn = (f ? KF(A_FFN2_NORM) : KF(A_FFN1_NORM)) + (size_t)l * D_MODEL;
            sc = t * 128 + (j & 3) * 32; off = f ? O_WGU2 : O_WGU1; }
        else { r -= CI_GU; K = D_FF; ldw = D_MODEL; db = r / (D_FF / 64); kb = r % (D_FF / 64); W = (f ? KF(A_FFN2_WD) : KF(A_FFN1_WD)) + (size_t)l * D_FF * D_MODEL; sc = db * 32; off = f ? O_WD2 : O_WD1; } }
    else { r -= 2 * (CI_GU + CI_D);
        if (r < CI_IN) { K = D_MODEL; ldw = N_IN; db = r / (D_MODEL / 64); kb = r % (D_MODEL / 64); W = KF(A_W_IN) + (size_t)l * D_MODEL * N_IN; gn = KF(A_MIX_NORM) + (size_t)l * D_MODEL; sc = win_src_col(db); off = O_WIN; }
        else if ((r -= CI_IN) < CI_UQ) { K = MLA_QR; ldw = MLA_HEADS * MLA_QK; db = r / (MLA_QR / 64); kb = r % (MLA_QR / 64); W = KF(A_MLA_W_UQ) + (size_t)l * MLA_QR * (MLA_HEADS * MLA_QK); gn = KF(A_MLA_Q_NORM) + (size_t)l * MLA_QR; sc = wuq_src_col(db); off = O_WUQ; }
        else if ((r -= CI_UQ) < CI_UKV) { K = MLA_KVR; ldw = 2048; db = r / (MLA_KVR / 64); kb = r % (MLA_KVR / 64); W = KF(A_MLA_W_UKV) + (size_t)l * MLA_KVR * 2048; gn = KF(A_MLA_KV_NORM) + (size_t)l * MLA_KVR; sc = db * 32; off = O_WUKV; }
        else if ((r -= CI_UKV) < CI_GLU) { K = SSM_WIDTH; ldw = SSM_WIDTH; db = r / (SSM_WIDTH / 64); kb = r % (SSM_WIDTH / 64); W = KF(A_SSM_W_GLU) + (size_t)l * SSM_WIDTH * SSM_WIDTH; sc = db * 32; off = O_WGLU; }
        else { r -= CI_GLU; K = D_MIX; ldw = D_MODEL; db = r / (D_MIX / 64); kb = r % (D_MIX / 64); W = KF(A_W_OUT) + (size_t)l * D_MIX * D_MODEL; gn = KF(A_OUT_NORM) + (size_t)l * D_MIX; sc = db * 32; off = O_WOUT; } }
    J.src = sc >= 0 ? W + (size_t)(kb * 64) * ldw + sc : nullptr; J.gain = gn ? gn + kb * 64 : nullptr; J.ldw = ldw; J.K = K;
    J.dst = (bf16_t*)(wsbase() + WS_W) + (size_t)l * E_LAYER + off + (size_t)(db * 32) * K + kb * 64;
}
#define CONV_LOAD(J, v) do { if ((J).src) { const float* _s = (J).src + (size_t)(lane >> 5) * (J).ldw + (lane & 31); const size_t _st = (size_t)2 * (J).ldw; \
        _Pragma("unroll") for (int _i = 0; _i < 32; ++_i) v[_i] = _s[_i * _st]; } else { _Pragma("unroll") for (int _i = 0; _i < 32; ++_i) v[_i] = 0.f; } } while (0)
#define CONV_STORE(J, v) do { _Pragma("unroll") for (int _i = 0; _i < 32; ++_i) scr[(2 * _i + (lane >> 5)) * 33 + (lane & 31)] = v[_i]; \
        LDS_WAIT(); asm volatile("" ::: "memory"); \
        const int _c = lane & 7; f32x4 _g0 = {1.f, 1.f, 1.f, 1.f}, _g1 = {1.f, 1.f, 1.f, 1.f}; if ((J).gain) { _g0 = *(const f32x4*)((J).gain + 8 * _c); _g1 = *(const f32x4*)((J).gain + 8 * _c + 4); } \
        _Pragma("unroll") for (int _j = 0; _j < 4; ++_j) { const int _n = (lane >> 3) + 8 * _j; const LAS float* _s = scr + (8 * _c) * 33 + _n; \
            u32x4 _o; _o.x = cvt_pk_bf16(_s[0 * 33] * _g0[0], _s[1 * 33] * _g0[1]); _o.y = cvt_pk_bf16(_s[2 * 33] * _g0[2], _s[3 * 33] * _g0[3]); \
                      _o.z = cvt_pk_bf16(_s[4 * 33] * _g1[0], _s[5 * 33] * _g1[1]); _o.w = cvt_pk_bf16(_s[6 * 33] * _g1[2], _s[7 * 33] * _g1[3]); \
            *(u32x4*)((J).dst + (size_t)_n * (J).K + 8 * _c) = _o; } \
        LDS_WAIT(); asm volatile("" ::: "memory"); } while (0)

__device__ __forceinline__ void p0_prologue(const Frame& F, const Ptrs& P) {
    LAS float* scr = (LAS float*)(F.lds + F.wave * 16384);
    const int gw = F.vcu * NWAVES + F.wave, NGW = F.G * NWAVES, lane = F.lane + vzero();
    { ConvJob JA, JB; float va[32], vb[32];
      int I = gw;
      if (I < CI_TOTAL) { conv_decode(I, JA); CONV_LOAD(JA, va); }
      while (I < CI_TOTAL) {
          const bool hasB = I + NGW < CI_TOTAL; if (hasB) { conv_decode(I + NGW, JB); CONV_LOAD(JB, vb); }
          CONV_STORE(JA, va);
          if (!hasB) break;
          const bool hasA = I + 2 * NGW < CI_TOTAL; if (hasA) { conv_decode(I + 2 * NGW, JA); CONV_LOAD(JA, va); }
          CONV_STORE(JB, vb);
          I += 2 * NGW; if (!hasA) break;
      } }
    { rss_t* rss0 = rssptr(P, 0); bf16_t* XBp = (bf16_t*)(wsbase() + WS_XB); bf16_t* XLp = (bf16_t*)(wsbase() + WS_XL);
      for (int m = gw; m < MTOK; m += NGW) { const f32x4* xr = (const f32x4*)(KF(A_X) + (size_t)m * D_MODEL) + lane; float s = 0.f; u32x2* o8 = (u32x2*)(XBp + (size_t)m * D_MODEL) + lane; u32x2* l8 = (u32x2*)(XLp + (size_t)m * D_MODEL) + lane;
          f32x4 xv[8];
#pragma unroll
          for (int j = 0; j < 8; ++j) xv[j] = xr[64 * j];
#pragma unroll
          for (int j = 0; j < 8; ++j) { const f32x4 v = xv[j]; s += (v[0] * v[0] + v[1] * v[1]) + (v[2] * v[2] + v[3] * v[3]); u32x2 w; w.x = cvt_pk_bf16(v[0], v[1]); w.y = cvt_pk_bf16(v[2], v[3]); o8[64 * j] = w;
              if (RESID_LO) { const f32x4 rm = v - pg8::bf_lo4(w); u32x2 wl; wl.x = cvt_pk_bf16(rm[0], rm[1]); wl.y = cvt_pk_bf16(rm[2], rm[3]); l8[64 * j] = wl; } }
          s = wave_sum(s); if (lane == 0) rss0[m] = rss_enc(s); } }
    { float* cs = (float*)(wsbase() + WS_ROPE); float* sn = cs + (size_t)MTOK * 32; const int gt = gw * 64 + lane, NT = NGW * 64;
      for (int e = gt; e < MTOK * 32; e += NT) { const int row = e >> 5, i = e & 31; const float inv_freq = exp2f(-(float)i * (13.287712379549449f / 32.0f)); const float ang = (float)((const int*)karg(A_POS))[row] * inv_freq;
          float s, c; sincosf(ang, &s, &c); cs[e] = c; sn[e] = s; } }
    { const int gt = gw * 64 + lane, NT = NGW * 64;
      for (int e = gt; e < DEPTH * 32 * 64; e += NT) { const int l = e >> 11, gp = e & 2047, g = gp >> 6;
          float* C = (float*)(wsbase() + WS_SSMC) + (size_t)l * SSMC_LAYER;
          const double lr = (double)KF(A_SSM_A_RE)[e], li = (double)KF(A_SSM_A_IM)[e], dt = exp((double)KF(A_SSM_LOG_DT)[l * 32 + g]);
          const double mag = exp(lr * dt), ar = mag * cos(li * dt), ai = mag * sin(li * dt);
          const double magT = exp(lr * dt * 64.0), aTr = magT * cos(li * dt * 64.0), aTi = magT * sin(li * dt * 64.0);
          const double den = lr * lr + li * li, nr = ar - 1.0, qr = (nr * lr + ai * li) / den, qi = (ai * lr - nr * li) / den;
          C[SSMC_A + gp * 2] = (float)ar; C[SSMC_A + gp * 2 + 1] = (float)ai; C[SSMC_AT + gp * 2] = (float)aTr; C[SSMC_AT + gp * 2 + 1] = (float)aTi;
          const float* br = KF(A_SSM_B_RE) + (size_t)e * 16; const float* bi = KF(A_SSM_B_IM) + (size_t)e * 16; float* bb = C + SSMC_BB + (size_t)gp * 32;
          f32x4 brv[4], biv[4];
#pragma unroll
          for (int i = 0; i < 4; ++i) { brv[i] = *(const f32x4*)(br + 4 * i); biv[i] = *(const f32x4*)(bi + 4 * i); }
#pragma unroll
          for (int i = 0; i < 4; ++i) { f32x4 o_re, o_im;
#pragma unroll
              for (int k = 0; k < 4; ++k) { const double r = (double)brv[i][k], im = (double)biv[i][k]; o_re[k] = (float)(qr * r - qi * im); o_im[k] = (float)(qr * im + qi * r); }
              *(f32x4*)(bb + 4 * i) = o_re; *(f32x4*)(bb + 16 + 4 * i) = o_im; } } }
}

__device__ __forceinline__ int crow(int r, int hi) { return (r & 3) + 8 * (r >> 2) + 4 * hi; }
__device__ __forceinline__ s16x4 vtr(const LAS unsigned char* p) { typedef short v4i16_t __attribute__((ext_vector_type(4))); return __builtin_bit_cast(s16x4, __builtin_amdgcn_ds_read_tr16_b64_v4i16((LAS v4i16_t*)p)); }

template <int DK, int DK1, int DV, bool WIN, bool ALLST = false>
__device__ __forceinline__ void attn_unit(const Frame& F, const bf16_t* __restrict__ Q, int qld, const bf16_t* __restrict__ K1, int k1ld, const bf16_t* __restrict__ K2, int k2ld,
                                          const bf16_t* __restrict__ V, int vld, bf16_t* __restrict__ O, int old_, rss_t* __restrict__ rss, int rowbase, int q0, float m_init, float l_init) {
    constexpr int KROW = (DK + 8) * 2, VROW = (DV + 8) * 2, KBYTES = 64 * KROW, VBYTES = 64 * VROW, BUFB = KBYTES + VBYTES;
    constexpr int NKC = DK / 64, NVC = DV / 64, KCH = DK / 8, VCH = DV / 8;
    static_assert(2 * BUFB <= RING_BYTES, "attention tiles fit the phase scratch");
    const int zz = vzero();
    const int tid = F.tid + zz, lane = F.lane + zz, r = lane & 31, h = lane >> 5;
    const int wid = (F.wave < 4) ? F.wave : (F.wave ^ 2);
    LAS unsigned char* lds = F.lds;
    const int t_lo = WIN ? ((q0 >= SWA_WINDOW ? q0 - SWA_WINDOW : 0) >> 6) : 0, t_hi = (q0 + 256) >> 6;
    const bf16_t* ksrc[NKC]; int kdst[NKC]; int kld_[NKC]; const bf16_t* vsrc[NVC]; int vdst[NVC];
#pragma unroll
    for (int i = 0; i < NKC; ++i) { const int id = tid + i * 512, row = id / KCH, cc = id % KCH;
        ksrc[i] = (cc < DK1 / 8) ? K1 + (size_t)(rowbase + row) * k1ld + cc * 8 : K2 + (size_t)(rowbase + row) * k2ld + (cc - DK1 / 8) * 8; kdst[i] = row * KROW + cc * 16; kld_[i] = (cc < DK1 / 8) ? k1ld : k2ld; }
#pragma unroll
    for (int i = 0; i < NVC; ++i) { const int id = tid + i * 512, row = id / VCH, cc = id % VCH; vsrc[i] = V + (size_t)(rowbase + row) * vld + cc * 8; vdst[i] = KBYTES + row * VROW + cc * 16; }
    u32x4 kst[NKC], vst[NVC];
#define ATT_LOAD(t) do { _Pragma("unroll") for (int i = 0; i < NKC; ++i) kst[i] = *(const u32x4*)(ksrc[i] + (size_t)(t) * 64 * kld_[i]); \
                         _Pragma("unroll") for (int i = 0; i < NVC; ++i) vst[i] = *(const u32x4*)(vsrc[i] + (size_t)(t) * 64 * vld); } while (0)
#define ATT_STORE(buf) do { _Pragma("unroll") for (int i = 0; i < NKC; ++i) *(LAS u32x4*)(lds + (buf) * BUFB + kdst[i]) = kst[i]; \
                            _Pragma("unroll") for (int i = 0; i < NVC; ++i) *(LAS u32x4*)(lds + (buf) * BUFB + vdst[i]) = vst[i]; } while (0)
    constexpr float ATT_THR = 8.0f;
#define ATT_TILE(KT, VT) do { \
        if (active) { \
            const LAS unsigned char* kb = lds + (KT) + r * KROW + 16 * h; \
            f32x16 p0, p1; \
            _Pragma("unroll") \
            for (int e = 0; e < 16; ++e) { p0[e] = 0.f; p1[e] = 0.f; } \
              \
            bf16x8 kfa0 = *(const LAS bf16x8*)(kb), kfa1 = *(const LAS bf16x8*)(kb + 32 * KROW), kfb0 = *(const LAS bf16x8*)(kb + 32), kfb1 = *(const LAS bf16x8*)(kb + 32 * KROW + 32); \
            __builtin_amdgcn_s_setprio(1); \
            _Pragma("unroll") \
            for (int s = 0; s < DK / 16; s += 2) { \
                p0 = __builtin_amdgcn_mfma_f32_32x32x16_bf16(kfa0, qf[s], p0, 0, 0, 0); p1 = __builtin_amdgcn_mfma_f32_32x32x16_bf16(kfa1, qf[s], p1, 0, 0, 0); \
                if (s + 2 < DK / 16) { kfa0 = *(const LAS bf16x8*)(kb + 32 * (s + 2)); kfa1 = *(const LAS bf16x8*)(kb + 32 * KROW + 32 * (s + 2)); } \
                __builtin_amdgcn_sched_barrier(0); \
                p0 = __builtin_amdgcn_mfma_f32_32x32x16_bf16(kfb0, qf[s + 1], p0, 0, 0, 0); p1 = __builtin_amdgcn_mfma_f32_32x32x16_bf16(kfb1, qf[s + 1], p1, 0, 0, 0); \
                if (s + 3 < DK / 16) { kfb0 = *(const LAS bf16x8*)(kb + 32 * (s + 3)); kfb1 = *(const LAS bf16x8*)(kb + 32 * KROW + 32 * (s + 3)); } \
                __builtin_amdgcn_sched_barrier(0); } \
            __builtin_amdgcn_s_setprio(0); \
            const bool need_mask = (kb0 + 63 > wq0) || (WIN && kb0 + SWA_WINDOW <= wq0 + 31); \
            if (need_mask) { \
                const float NEG = -__builtin_inff(); \
            _Pragma("unroll") \
                for (int e = 0; e < 16; ++e) { const int d0 = qpos - (kb0 + crow(e, h)), d1 = d0 - 32; \
                    if (d0 < 0 || (WIN && d0 >= SWA_WINDOW)) p0[e] = NEG; \
                    if (d1 < 0 || (WIN && d1 >= SWA_WINDOW)) p1[e] = NEG; } \
            } \
            float mxa = __builtin_fmaxf(__builtin_fmaxf(p0[0], p0[1]), p1[0]), mxb = __builtin_fmaxf(__builtin_fmaxf(p0[2], p0[3]), p1[1]); mxa = __builtin_fmaxf(__builtin_fmaxf(mxa, p1[2]), p1[3]); \
            _Pragma("unroll") \
            for (int e = 4; e < 16; e += 4) { mxa = __builtin_fmaxf(__builtin_fmaxf(mxa, p0[e]), p0[e + 1]); mxb = __builtin_fmaxf(__builtin_fmaxf(mxb, p0[e + 2]), p0[e + 3]); mxa = __builtin_fmaxf(__builtin_fmaxf(mxa, p1[e]), p1[e + 1]); mxb = __builtin_fmaxf(__builtin_fmaxf(mxb, p1[e + 2]), p1[e + 3]); } \
            float mx = __builtin_fmaxf(mxa, mxb); mx = __builtin_fmaxf(mx, __shfl_xor(mx, 32)); \
            if (!__all(mx - m_run <= ATT_THR)) { const float mnew = fmaxf(m_run, mx), alpha = __builtin_amdgcn_exp2f(m_run - mnew); m_run = mnew; l_run *= alpha; \
            _Pragma("unroll") \
                for (int i = 0; i < DV / 32; ++i) \
            _Pragma("unroll") \
                    for (int e = 0; e < 16; ++e) o[i][e] *= alpha; } \
            const float mn = m_run; float ps = 0.f; \
            _Pragma("unroll") \
            for (int e = 0; e < 16; ++e) { p0[e] = __builtin_amdgcn_exp2f(p0[e] - mn); p1[e] = __builtin_amdgcn_exp2f(p1[e] - mn); ps += p0[e] + p1[e]; } \
            l_run += ps; \
            bf16x8 pb[4]; \
            _Pragma("unroll") \
            for (int ks = 0; ks < 4; ++ks) { const int b = (ks & 1) * 8; u32x4 w; \
                if (ks < 2) { w.x = cvt_pk_bf16(p0[b], p0[b + 1]); w.y = cvt_pk_bf16(p0[b + 2], p0[b + 3]); w.z = cvt_pk_bf16(p0[b + 4], p0[b + 5]); w.w = cvt_pk_bf16(p0[b + 6], p0[b + 7]); } \
                else        { w.x = cvt_pk_bf16(p1[b], p1[b + 1]); w.y = cvt_pk_bf16(p1[b + 2], p1[b + 3]); w.z = cvt_pk_bf16(p1[b + 4], p1[b + 5]); w.w = cvt_pk_bf16(p1[b + 6], p1[b + 7]); } \
                pb[ks] = __builtin_bit_cast(bf16x8, w); } \
            const LAS unsigned char* vb = lds + (VT) + (4 * h + ((lane & 15) >> 2)) * VROW + (16 * ((lane >> 4) & 1) + 4 * (lane & 3)) * 2; \
              \
            bf16x8 vfr[4]; \
              \
            _Pragma("unroll") \
            for (int j = 0; j < 4; ++j) { const int i_ = j % (DV / 32), ks_ = j / (DV / 32); const s16x4 lo = vtr(vb + (16 * ks_) * VROW + 64 * i_), hi = vtr(vb + (16 * ks_ + 8) * VROW + 64 * i_); vfr[j] = (bf16x8){lo[0], lo[1], lo[2], lo[3], hi[0], hi[1], hi[2], hi[3]}; } \
            __builtin_amdgcn_s_setprio(1); \
            _Pragma("unroll") \
            for (int j = 0; j < 4 * (DV / 32); ++j) { \
                o[j % (DV / 32)] = __builtin_amdgcn_mfma_f32_32x32x16_bf16(vfr[j & 3], pb[j / (DV / 32)], o[j % (DV / 32)], 0, 0, 0); \
                if (j + 4 < 4 * (DV / 32)) { const int jn = j + 4, i_ = jn % (DV / 32), ks_ = jn / (DV / 32); const s16x4 lo = vtr(vb + (16 * ks_) * VROW + 64 * i_), hi = vtr(vb + (16 * ks_ + 8) * VROW + 64 * i_); vfr[j & 3] = (bf16x8){lo[0], lo[1], lo[2], lo[3], hi[0], hi[1], hi[2], hi[3]}; } \
                __builtin_amdgcn_sched_barrier(0); } \
            __builtin_amdgcn_s_setprio(0); \
        } \
    } while (0)
    constexpr int NTMAX = ALLST ? 6 : 1;
    static_assert(!ALLST || NTMAX * (KBYTES + VBYTES) <= RING_BYTES, "whole-window staging fits the phase scratch");
    u32x4 ka[NTMAX][NKC], va[NTMAX][NVC];
    if constexpr (ALLST) {
#pragma unroll
        for (int jt = 0; jt < NTMAX; ++jt) if (t_lo + jt < t_hi) {
#pragma unroll
            for (int i = 0; i < NKC; ++i) ka[jt][i] = *(const u32x4*)(ksrc[i] + (size_t)(t_lo + jt) * 64 * kld_[i]);
#pragma unroll
            for (int i = 0; i < NVC; ++i) va[jt][i] = *(const u32x4*)(vsrc[i] + (size_t)(t_lo + jt) * 64 * vld); }
    } else { ATT_LOAD(t_lo); }
    bf16x8 qf[DK / 16];
    { const bf16_t* qrow = Q + (size_t)(rowbase + q0 + wid * 32 + r) * qld + 8 * h;
#pragma unroll
      for (int s = 0; s < DK / 16; ++s) qf[s] = *(const bf16x8*)(qrow + 16 * s);
#pragma unroll
      for (int s = 0; s < DK / 16; ++s) asm volatile("" : "+v"(qf[s])); }
    f32x16 o[DV / 32];
#pragma unroll
    for (int i = 0; i < DV / 32; ++i)
#pragma unroll
        for (int e = 0; e < 16; ++e) o[i][e] = 0.f;
    float m_run = m_init, l_run = (h == 0) ? l_init : 0.f;
    const int qpos = q0 + wid * 32 + r, wq0 = q0 + wid * 32;
    if constexpr (ALLST) {
#pragma unroll
        for (int jt = 0; jt < NTMAX; ++jt) if (t_lo + jt < t_hi) {
#pragma unroll
            for (int i = 0; i < NKC; ++i) *(LAS u32x4*)(lds + jt * KBYTES + kdst[i]) = ka[jt][i];
#pragma unroll
            for (int i = 0; i < NVC; ++i) *(LAS u32x4*)(lds + NTMAX * KBYTES + jt * VBYTES + (vdst[i] - KBYTES)) = va[jt][i]; }
        __syncthreads();
#pragma unroll 1
        for (int t = t_lo; t < t_hi; ++t) { const int jt = t - t_lo; const int kb0 = 64 * t;
            const bool active = (kb0 <= wq0 + 31) && (!WIN || kb0 + 63 + SWA_WINDOW > wq0);
            ATT_TILE(jt * KBYTES, NTMAX * KBYTES + jt * VBYTES); }
        __syncthreads();
    } else {
    ATT_STORE(0);
    __syncthreads();
    for (int t = t_lo; t < t_hi; ++t) {
        const int cur = (t - t_lo) & 1;
        if (t + 1 < t_hi) ATT_LOAD(t + 1);
        const int kb0 = 64 * t;
        const bool active = (kb0 <= wq0 + 31) && (!WIN || kb0 + 63 + SWA_WINDOW > wq0);
        ATT_TILE(cur * BUFB, cur * BUFB + KBYTES);
        if (t + 1 < t_hi) ATT_STORE(cur ^ 1);
        __syncthreads();
    }
    }
    const float lt = l_run + __shfl_xor(l_run, 32), inv = 1.0f / lt;
    float ss = 0.f;
    bf16_t* orow = O + (size_t)(rowbase + qpos) * old_;
#pragma unroll
    for (int i = 0; i < DV / 32; ++i)
#pragma unroll
        for (int pgi = 0; pgi < 2; ++pgi) { u32x2 w[2];
#pragma unroll
            for (int k = 0; k < 2; ++k) { const int g = 2 * pgi + k; const float a = o[i][4 * g] * inv, b = o[i][4 * g + 1] * inv, c = o[i][4 * g + 2] * inv, d = o[i][4 * g + 3] * inv;
                ss += (a * a + b * b) + (c * c + d * d); w[k].x = cvt_pk_bf16(a, b); w[k].y = cvt_pk_bf16(c, d); }
            const u32x2 snd = h ? w[0] : w[1]; u32x2 rcv; rcv.x = (unsigned)__shfl_xor((int)snd.x, 32); rcv.y = (unsigned)__shfl_xor((int)snd.y, 32);
            const u32x4 st = h ? (u32x4){rcv.x, rcv.y, w[1].x, w[1].y} : (u32x4){w[0].x, w[0].y, rcv.x, rcv.y};
            *(u32x4*)(orow + 32 * i + 16 * pgi + 8 * h) = st; }
    ss += __shfl_xor(ss, 32);
    if (h == 0) atomicAdd(rss + rowbase + qpos, rss_enc(ss));
#undef ATT_LOAD
#undef ATT_TILE
#undef ATT_STORE
}


constexpr int SSM_T = 64, SSM_NCH = SEQ / SSM_T;
__device__ __forceinline__ float gelu_tanh(float y) { const float z = 1.5957691216057308f * (y + 0.044715f * y * y * y); return y * __builtin_amdgcn_rcpf(1.0f + __builtin_amdgcn_exp2f(-z * LOG2E)); }

constexpr int SSM_YROW = 520;
constexpr int SSM_XBROW = 136;
constexpr int SSM_XROW = 132;
constexpr int SSM_LDS_Y = 0, SSM_LDS_X = SSM_T * SSM_YROW * 2, SSM_LDS_U = SSM_LDS_X + NWAVES * 16 * SSM_XROW * 4, SSM_LDS_END = SSM_LDS_U + NWAVES * 1024;
static_assert(SSM_LDS_END <= RING_BYTES && SSM_LDS_U - SSM_LDS_X >= SSM_T * SSM_YROW * 2, "SSM LDS map (the out tile reuses the state scratch)");
__device__ __forceinline__ void ssm_load_bb_raw(const float* C, int g, int lane, f32x4 (&raw)[16]) {
    const int q = lane >> 4, n = lane & 15;
#pragma unroll
    for (int blk = 0; blk < 8; ++blk) { const float* src = C + SSMC_BB + (size_t)(g * 64 + 16 * (blk & 3) + n) * 32 + (blk >> 2) * 16 + 8 * (q & 1); raw[2 * blk] = *(const f32x4*)src; raw[2 * blk + 1] = *(const f32x4*)(src + 4); }
}
__device__ __forceinline__ void ssm_cvt_bbh(const f32x4 (&raw)[16], int lane, bf16x8 (&bbh)[8]) {
    const int q = lane >> 4;
#pragma unroll
    for (int blk = 0; blk < 8; ++blk) { const f32x4 v0 = raw[2 * blk], v1 = raw[2 * blk + 1]; u32x4 w; w.x = cvt_pk_bf16(v0[0], v0[1]); w.y = cvt_pk_bf16(v0[2], v0[3]); w.z = cvt_pk_bf16(v1[0], v1[1]); w.w = cvt_pk_bf16(v1[2], v1[3]);
        if (q >= 2) w = (u32x4){0u, 0u, 0u, 0u}; bbh[blk] = __builtin_bit_cast(bf16x8, w); }
}
__device__ __forceinline__ void ssm_load_bbh(const float* C, int g, int lane, bf16x8 (&bbh)[8]) {
    f32x4 raw[16]; ssm_load_bb_raw(C, g, lane, raw);
#pragma unroll
    for (int i = 0; i < 16; ++i) asm volatile("" : "+v"(raw[i]));
    ssm_cvt_bbh(raw, lane, bbh);
}
__device__ __forceinline__ void ssm_bproj16(const LAS float* ubf, const bf16x8 (&bbh)[8], LAS float* bu, int lane) {
    const int q = lane >> 4, n = lane & 15;
    const f32x4 v0 = *(const LAS f32x4*)(ubf + n * 16 + 8 * (q & 1)), v1 = *(const LAS f32x4*)(ubf + n * 16 + 8 * (q & 1) + 4);
    u32x4 w; w.x = cvt_pk_bf16(v0[0], v0[1]); w.y = cvt_pk_bf16(v0[2], v0[3]); w.z = cvt_pk_bf16(v1[0], v1[1]); w.w = cvt_pk_bf16(v1[2], v1[3]);
    if (q >= 2) w = (u32x4){0u, 0u, 0u, 0u};
    const bf16x8 a = __builtin_bit_cast(bf16x8, w);
#pragma unroll
    for (int blk = 0; blk < 8; ++blk) { f32x4 d = {0.f, 0.f, 0.f, 0.f}; d = __builtin_amdgcn_mfma_f32_16x16x32_bf16(a, bbh[blk], d, 0, 0, 0);
#pragma unroll
        for (int i = 0; i < 4; ++i) bu[(4 * q + i) * SSM_XROW + 16 * blk + n] = d[i]; }
}

constexpr int SSM_BTROW = 20;
__device__ __forceinline__ bf16x8 ssm_bproj_a(const LAS float* ubf, int lane) {
    const int q = lane >> 4, n = lane & 15;
    const f32x4 v0 = *(const LAS f32x4*)(ubf + n * 16 + 8 * (q & 1)), v1 = *(const LAS f32x4*)(ubf + n * 16 + 8 * (q & 1) + 4);
    u32x4 w; w.x = cvt_pk_bf16(v0[0], v0[1]); w.y = cvt_pk_bf16(v0[2], v0[3]); w.z = cvt_pk_bf16(v1[0], v1[1]); w.w = cvt_pk_bf16(v1[2], v1[3]);
    if (q >= 2) w = (u32x4){0u, 0u, 0u, 0u};
    return __builtin_bit_cast(bf16x8, w);
}
__device__ __forceinline__ void ssm_bproj_half(const bf16x8 a, const bf16x8 (&bbh)[8], int half, LAS float* bt, int lane, float (&out)[16]) {
    const int q = lane >> 4, n = lane & 15;
#pragma unroll
    for (int b4 = 0; b4 < 4; ++b4) { f32x4 d = {0.f, 0.f, 0.f, 0.f}; d = __builtin_amdgcn_mfma_f32_16x16x32_bf16(a, bbh[half * 4 + b4], d, 0, 0, 0);
        *(LAS f32x4*)(bt + (16 * b4 + n) * SSM_BTROW + 4 * q) = d; }
#pragma unroll
    for (int i = 0; i < 4; ++i) { const f32x4 v = *(const LAS f32x4*)(bt + lane * SSM_BTROW + 4 * i); out[4 * i] = v[0]; out[4 * i + 1] = v[1]; out[4 * i + 2] = v[2]; out[4 * i + 3] = v[3]; }
}

typedef float sf2 __attribute__((ext_vector_type(2)));
#ifndef P1_LIGHT_T
#define P1_LIGHT_T 1
#endif
__device__ __forceinline__ void ssm_p1w_gen(const Frame& F) {
    const int gt = (F.vcu * NWAVES + F.wave) * 64 + F.lane + vzero(), NT = F.G * NWAVES * 64;
    for (int e = gt; e < DEPTH * 32 * 64 * 4; e += NT) { const int tq = e & 3, gp = (e >> 2) & 2047, l = e >> 13;
        const float* C = (const float*)(wsbase() + WS_SSMC) + (size_t)l * SSMC_LAYER;
        const float ar = C[SSMC_A + gp * 2], ai = C[SSMC_A + gp * 2 + 1];
        f32x4 bb[8];
#pragma unroll
        for (int i = 0; i < 8; ++i) bb[i] = *(const f32x4*)(C + SSMC_BB + (size_t)gp * 32 + 4 * i);
        float pr = 1.f, pi = 0.f;
        for (int m = 0; m < 48 - 16 * tq; ++m) { const float nr = pr * ar - pi * ai, ni = pr * ai + pi * ar; pr = nr; pi = ni; }
        bf16_t* wre = (bf16_t*)(wsbase() + WS_P1W) + ((size_t)(l * 32 + (gp >> 6)) * 128 + (gp & 63)) * 1024; bf16_t* wim = wre + (size_t)64 * 1024;
#pragma unroll 1
        for (int tt = 15; tt >= 0; --tt) { const int t = 16 * tq + tt;
#pragma unroll
            for (int h8 = 0; h8 < 2; ++h8) { f32x4 r0, r1, i0, i1;
#pragma unroll
                for (int k = 0; k < 4; ++k) { const float br0 = bb[2 * h8][k], bi0 = bb[4 + 2 * h8][k], br1 = bb[2 * h8 + 1][k], bi1 = bb[4 + 2 * h8 + 1][k];
                    r0[k] = pr * br0 - pi * bi0; i0[k] = pr * bi0 + pi * br0; r1[k] = pr * br1 - pi * bi1; i1[k] = pr * bi1 + pi * br1; }
                pg8::store8_bf16(wre + t * 16 + 8 * h8, r0, r1); pg8::store8_bf16(wim + t * 16 + 8 * h8, i0, i1); }
            const float nr = pr * ar - pi * ai, ni = pr * ai + pi * ar; pr = nr; pi = ni; }
    }
}
__device__ __forceinline__ void ssm_pass1(const Frame& F, const Ptrs& P, int l) {
    const int lane = F.lane + vzero(), wid = F.wave, n = lane & 15, q = lane >> 4;
    float* XIN = (float*)(wsbase() + WS_SST);
    const float* C = (const float*)(wsbase() + WS_SSMC) + (size_t)l * SSMC_LAYER;
    LAS float* Sl = (LAS float*)F.lds;
    for (int item = F.vcu; item < 256; item += F.G) { const int g = item >> 3, b = (item >> 1) & 3, h = item & 1;
        const int nblk = wid & 3, mb0 = 2 * (wid >> 2);
        const int j = 16 * nblk + n, prow = (j < 32) ? (32 * h + j) : (64 + 32 * h + (j - 32));
        const bf16_t* ap = (const bf16_t*)(wsbase() + WS_UB) + ((size_t)(g * 256 + b * 64 + mb0 * 16 + n)) * 1024 + 8 * q;
        const bf16_t* bp = (const bf16_t*)(wsbase() + WS_P1W) + ((size_t)((l * 32 + g) * 128 + prow)) * 1024 + 8 * q;
        f32x4 d0 = {0.f, 0.f, 0.f, 0.f}, d1 = d0;
#pragma unroll 1
        for (int kb = 0; kb < 4; ++kb) {
            u32x4 a0[8], a1[8], bf[8];
#pragma unroll
            for (int s = 0; s < 8; ++s) { const int ko = 32 * (8 * kb + s); a0[s] = *(const u32x4*)(ap + ko); a1[s] = *(const u32x4*)(ap + (size_t)16 * 1024 + ko); bf[s] = *(const u32x4*)(bp + ko); }
#pragma unroll
            for (int s = 0; s < 8; ++s) { asm volatile("" : "+v"(a0[s])); asm volatile("" : "+v"(a1[s])); asm volatile("" : "+v"(bf[s])); }
#pragma unroll
            for (int s = 0; s < 8; ++s) { const bf16x8 bv = __builtin_bit_cast(bf16x8, bf[s]);
                d0 = __builtin_amdgcn_mfma_f32_16x16x32_bf16(__builtin_bit_cast(bf16x8, a0[s]), bv, d0, 0, 0, 0);
                d1 = __builtin_amdgcn_mfma_f32_16x16x32_bf16(__builtin_bit_cast(bf16x8, a1[s]), bv, d1, 0, 0, 0); }
        }
#pragma unroll
        for (int r = 0; r < 4; ++r) { Sl[(mb0 * 16 + 4 * q + r) * 65 + j] = d0[r]; Sl[((mb0 + 1) * 16 + 4 * q + r) * 65 + j] = d1[r]; }
        __syncthreads();
        if (wid == 0 && lane < 32) {
            const int pst = 32 * h + lane; const float tr = C[SSMC_AT + (g * 64 + pst) * 2], ti = C[SSMC_AT + (g * 64 + pst) * 2 + 1];
            float xr = 0.f, xi = 0.f; float* xo = XIN + ((size_t)((b * SSM_NCH) * SSM_GROUPS + g) * 64 + pst) * 2;
#pragma unroll 4
            for (int c = 0; c < SSM_NCH; ++c) { *(sf2*)(xo + (size_t)c * SSM_GROUPS * 128) = (sf2){xr, xi};
                const float sr = Sl[c * 65 + lane], si = Sl[c * 65 + 32 + lane];
                const float nr = tr * xr - ti * xi + sr, ni = tr * xi + ti * xr + si; xr = nr; xi = ni; }
        }
        __syncthreads();
    }
}

__device__ __forceinline__ void ssm_pass2_unit(const Frame& F, const Ptrs& P, int l, int b, int c) {
    const int vz = vzero(); const int lane = F.lane + vz, wid = F.wave;
    const float* C = (const float*)(wsbase() + WS_SSMC) + (size_t)l * SSMC_LAYER; const float* U = (const float*)(wsbase() + WS_U); const float* SST = (const float*)(wsbase() + WS_SST);
    LAS unsigned short* ybuf = (LAS unsigned short*)(F.lds + SSM_LDS_Y); LAS float* bu = (LAS float*)(F.lds + SSM_LDS_X) + wid * 16 * SSM_XROW; LAS unsigned* xsw = (LAS unsigned*)bu;
    const int row0 = b * SEQ + c * SSM_T;
    float xin_r[4], xin_i[4];
    { const float* sp = SST + ((size_t)((b * SSM_NCH + c) * SSM_GROUPS + wid * 4) * 64 + lane) * 2;
#pragma unroll
      for (int gi = 0; gi < 4; ++gi) { const sf2 v = *(const sf2*)(sp + gi * 128); xin_r[gi] = v.x; xin_i[gi] = v.y; } }
#pragma unroll
    for (int gi = 0; gi < 4; ++gi) {
        const int g = wid * 4 + gi;
        float ar = C[SSMC_A + (g * 64 + lane) * 2], ai = C[SSMC_A + (g * 64 + lane) * 2 + 1];
        f32x4 bbraw[16]; ssm_load_bb_raw(C, g, lane, bbraw);
        f32x4 cr[4], ci[4];
        { const int q = lane >> 4; const size_t rowoff = ((size_t)(l * SSM_GROUPS + g) * 16 + (lane & 15)) * 64 + 4 * q;
          const float* crp = KF(A_SSM_C_RE) + rowoff; const float* cip = KF(A_SSM_C_IM) + rowoff;
#pragma unroll
          for (int s = 0; s < 4; ++s) { cr[s] = *(const f32x4*)(crp + 16 * s); ci[s] = *(const f32x4*)(cip + 16 * s); } }
        float dsk = KF(A_SSM_D)[l * SSM_WIDTH + g * 16 + (lane & 15)];
        f32x4 uf[4];
        { const float* up = U + (size_t)(row0 + lane) * SSM_WIDTH + g * 16;
#pragma unroll
          for (int i = 0; i < 4; ++i) uf[i] = *(const f32x4*)(up + 4 * i); }
#pragma unroll
        for (int i = 0; i < 16; ++i) asm volatile("" : "+v"(bbraw[i]));
#pragma unroll
        for (int s = 0; s < 4; ++s) { asm volatile("" : "+v"(cr[s])); asm volatile("" : "+v"(ci[s])); }
#pragma unroll
        for (int i = 0; i < 4; ++i) asm volatile("" : "+v"(uf[i]));
        asm volatile("" : "+v"(ar), "+v"(ai), "+v"(dsk));
        bf16x8 bbh[8]; ssm_cvt_bbh(bbraw, lane, bbh);
        float xr = xin_r[gi], xi = xin_i[gi];
        bf16x8 cmh[4];
#pragma unroll
        for (int s = 0; s < 4; ++s) { u32x4 w; w.x = cvt_pk_bf16(cr[s][0], -ci[s][0]); w.y = cvt_pk_bf16(cr[s][1], -ci[s][1]); w.z = cvt_pk_bf16(cr[s][2], -ci[s][2]); w.w = cvt_pk_bf16(cr[s][3], -ci[s][3]);
            cmh[s] = __builtin_bit_cast(bf16x8, w); }
        LAS f32x4* ub = (LAS f32x4*)(F.lds + SSM_LDS_U + wid * 1024);
#pragma unroll 1
        for (int tb = 0; tb < 4; ++tb) {
            if ((lane >> 4) == tb) {
#pragma unroll
                for (int i = 0; i < 4; ++i) ub[(lane & 15) * 4 + i] = uf[i]; }
            LDS_WAIT(); asm volatile("" ::: "memory");
            float uv[4];
#pragma unroll
            for (int i = 0; i < 4; ++i) uv[i] = ((const LAS float*)ub)[(4 * (lane >> 4) + i) * 16 + (lane & 15)];
            const bf16x8 ua = ssm_bproj_a((const LAS float*)ub, lane);
            float bre[16], bim[16];
            ssm_bproj_half(ua, bbh, 0, bu, lane, bre); ssm_bproj_half(ua, bbh, 1, bu, lane, bim);
            asm volatile("" ::: "memory");
#pragma unroll
            for (int tt = 0; tt < 16; ++tt) { const float nr = ar * xr - ai * xi + bre[tt], ni = ar * xi + ai * xr + bim[tt]; xr = nr; xi = ni;
                xsw[tt * 68 + lane] = cvt_pk_bf16(xr, xi); }
            asm volatile("" ::: "memory");
#ifndef PROBE_REP_CPROJ
#define PROBE_REP_CPROJ 1
#endif
            for (int rep_c = 0; rep_c < PROBE_REP_CPROJ; ++rep_c) {
            f32x4 ya = {0.f, 0.f, 0.f, 0.f};
            const LAS unsigned short* xa = (const LAS unsigned short*)(xsw + (lane & 15) * 68) + 8 * (lane >> 4);
#pragma unroll
            for (int s = 0; s < 4; ++s) ya = __builtin_amdgcn_mfma_f32_16x16x32_bf16(*(const LAS bf16x8*)(xa + 32 * s), cmh[s], ya, 0, 0, 0);
            const f32x4 yb = {0.f, 0.f, 0.f, 0.f};
#pragma unroll
            for (int i = 0; i < 4; ++i) { const int t = tb * 16 + 4 * (lane >> 4) + i;
                const float y = gelu_tanh(ya[i] + yb[i] + dsk * uv[i]); ybuf[t * SSM_YROW + g * 16 + (lane & 15)] = (unsigned short)(cvt_pk_bf16(y, 0.f) & 0xffffu); }
            }
            LDS_WAIT(); asm volatile("" ::: "memory");
        }
    }
#ifndef PROBE_REP_GLU
#define PROBE_REP_GLU 1
#endif
    for (int rep_ = 0; rep_ < PROBE_REP_GLU; ++rep_) {
    __syncthreads();
    const int lane2 = F.lane + vzero(); const int r = lane2 & 31, h = lane2 >> 5;
    f32x16 acc[2][2];
#pragma unroll
    for (int a = 0; a < 2; ++a)
#pragma unroll
        for (int q = 0; q < 2; ++q)
#pragma unroll
            for (int e = 0; e < 16; ++e) acc[a][q][e] = 0.f;
    const bf16_t* wg = wptr(P, l, O_WGLU) + (size_t)(wid * 64 + r) * SSM_WIDTH + 8 * h;
    const LAS unsigned short* ya_ = ybuf + r * SSM_YROW + 8 * h;
    bf16x8 wb[8][2];
#pragma unroll
    for (int i = 0; i < 8; ++i) { wb[i][0] = *(const bf16x8*)(wg + 16 * i); wb[i][1] = *(const bf16x8*)(wg + (size_t)32 * SSM_WIDTH + 16 * i); }
    bf16x8 an0 = *(const LAS bf16x8*)(ya_), an1 = *(const LAS bf16x8*)(ya_ + 32 * SSM_YROW);
#pragma unroll
    for (int s = 0; s < 32; ++s) {
        const bf16x8 a0 = an0, a1 = an1;
        if (s + 1 < 32) { an0 = *(const LAS bf16x8*)(ya_ + 16 * (s + 1)); an1 = *(const LAS bf16x8*)(ya_ + 32 * SSM_YROW + 16 * (s + 1)); }
        const bf16x8 b0 = wb[s & 7][0], b1 = wb[s & 7][1];
        acc[0][0] = __builtin_amdgcn_mfma_f32_32x32x16_bf16(a0, b0, acc[0][0], 0, 0, 0); acc[0][1] = __builtin_amdgcn_mfma_f32_32x32x16_bf16(a0, b1, acc[0][1], 0, 0, 0);
        acc[1][0] = __builtin_amdgcn_mfma_f32_32x32x16_bf16(a1, b0, acc[1][0], 0, 0, 0); acc[1][1] = __builtin_amdgcn_mfma_f32_32x32x16_bf16(a1, b1, acc[1][1], 0, 0, 0);
        if (s + 8 < 32) { wb[s & 7][0] = *(const bf16x8*)(wg + 16 * (s + 8)); wb[s & 7][1] = *(const bf16x8*)(wg + (size_t)32 * SSM_WIDTH + 16 * (s + 8)); }
        __builtin_amdgcn_sched_barrier(0);
    }
    LAS unsigned short* obuf = (LAS unsigned short*)(F.lds + SSM_LDS_X);
    { const int lane3 = F.lane + vzero(); const int r = lane3 & 31, h = lane3 >> 5;
#pragma unroll
    for (int q = 0; q < 2; ++q) { const int col = wid * 64 + q * 32 + r; const float bg = KF(A_SSM_B_GLU)[l * SSM_WIDTH + col];
#pragma unroll
        for (int a = 0; a < 2; ++a)
#pragma unroll
            for (int e = 0; e < 16; ++e) { const int row = 32 * a + crow(e, h); const float y = bf2f(ybuf[row * SSM_YROW + col]); const float z = acc[a][q][e] + bg;
                const float ov = y * __builtin_amdgcn_rcpf(1.0f + __builtin_amdgcn_exp2f(-z * LOG2E)); obuf[row * SSM_YROW + col] = (unsigned short)(cvt_pk_bf16(ov, 0.f) & 0xffffu); } } }
    __syncthreads();
    bf16_t* Y = (bf16_t*)(wsbase() + WS_YCAT); rss_t* rss = rssptr(P, l * RSS_PER_LAYER + 5);
#pragma unroll
    for (int i = 0; i < 8; ++i) { const int row = wid * 8 + i; const u32x4 v = *(const LAS u32x4*)(obuf + row * SSM_YROW + 8 * lane);
        float ss = 0.f;
#pragma unroll
        for (int k = 0; k < 4; ++k) { const float lo = __uint_as_float(v[k] << 16), hi = __uint_as_float(v[k] & 0xffff0000u); ss += lo * lo + hi * hi; }
        ss = wave_sum(ss); *(u32x4*)(Y + (size_t)(row0 + row) * D_MIX + 8 * lane) = v; if (lane == 0) rss[row0 + row] = rss_enc(ss); }
    }
    __syncthreads();
}

__device__ __forceinline__ void ycat_normalize(const Frame& F, const Ptrs& P, int l) {
    const int gw = F.vcu * NWAVES + F.wave, NGW = F.G * NWAVES, lane = F.lane + vzero();
    bf16_t* Y = (bf16_t*)(wsbase() + WS_YCAT); const rss_t* r0 = rssptr(P, l * RSS_PER_LAYER + 5) + vzero(); const rss_t* r1 = rssptr(P, l * RSS_PER_LAYER + 6) + vzero(); const rss_t* r2 = rssptr(P, l * RSS_PER_LAYER + 7) + vzero();
    for (int m = gw; m < MTOK; m += NGW) {
        const float s0 = __builtin_amdgcn_rsqf(rss_dec(r0[m]) * (1.0f / SSM_WIDTH) + EPS), s1 = __builtin_amdgcn_rsqf(rss_dec(r1[m]) * (1.0f / SWA_WIDTH) + EPS), s2 = __builtin_amdgcn_rsqf(rss_dec(r2[m]) * (1.0f / MLA_WIDTH) + EPS);
        u32x4* yr = (u32x4*)(Y + (size_t)m * D_MIX) + lane;
#pragma unroll
        for (int j = 0; j < 4; ++j) { const float sc = j == 0 ? s0 : (j == 1 ? s1 : s2); u32x4 v = yr[64 * j];
#pragma unroll
            for (int k = 0; k < 4; ++k) { const float lo = __uint_as_float(v[k] << 16) * sc, hi = __uint_as_float(v[k] & 0xffff0000u) * sc; v[k] = cvt_pk_bf16(lo, hi); }
            yr[64 * j] = v; }
    }
}
__device__ __forceinline__ void final_norm_phase(const Frame& F, const Ptrs& P) {
    const int gw = F.vcu * NWAVES + F.wave, NGW = F.G * NWAVES, lane = F.lane + vzero(); const rss_t* rs = rssptr(P, DEPTH * RSS_PER_LAYER) + vzero();
    const bf16_t* XBp = (const bf16_t*)(wsbase() + WS_XB); const bf16_t* XLp = (const bf16_t*)(wsbase() + WS_XL); float* outp = (float*)karg(A_OUT); const float* gnp = KF(A_FINAL_NORM);
    f32x4 gn[8];
#pragma unroll
    for (int j = 0; j < 4; ++j) { gn[2 * j] = *(const f32x4*)(gnp + 512 * j + 8 * lane); gn[2 * j + 1] = *(const f32x4*)(gnp + 512 * j + 8 * lane + 4); }
    for (int m = gw; m < MTOK; m += NGW) { const rss_t rv = rs[m]; u32x4 hv[4];
#pragma unroll
        for (int j = 0; j < 4; ++j) hv[j] = *(const u32x4*)(XBp + (size_t)m * D_MODEL + 512 * j + 8 * lane);
        const float sc = __builtin_amdgcn_rsqf(rss_dec(rv) * (1.0f / D_MODEL) + EPS);
#pragma unroll
        for (int j = 0; j < 4; ++j) { const size_t off = (size_t)m * D_MODEL + 512 * j + 8 * lane;
            const f32x4 a0 = pg8::bf_lo4((u32x2){hv[j].x, hv[j].y}), a1 = pg8::bf_lo4((u32x2){hv[j].z, hv[j].w});
            *(f32x4*)(outp + off) = a0 * sc * gn[2 * j]; *(f32x4*)(outp + off + 4) = a1 * sc * gn[2 * j + 1]; } }
}

#ifndef PROBE_REP_MLA
#define PROBE_REP_MLA 1
#endif
#ifndef PROBE_REP_SWA
#define PROBE_REP_SWA 1
#endif
#ifndef PROBE_REP_SSM
#define PROBE_REP_SSM 1
#endif
#ifndef PROBE_REP_GU
#define PROBE_REP_GU 1
#endif
#ifndef PROBE_REP_DOWN
#define PROBE_REP_DOWN 1
#endif
#ifndef PROBE_REP_SSM1
#define PROBE_REP_SSM1 1
#endif
#ifndef PG_ALIGN_GU
#define PG_ALIGN_GU true
#endif
#ifndef PG_ALIGN
#define PG_ALIGN true
#endif
#ifndef PG_SP2
#define PG_SP2 true
#endif
#ifndef PROBE_DOWN_NULLEPI
#define PROBE_DOWN_NULLEPI 0
#endif
#ifndef PROBE_REP_P0
#define PROBE_REP_P0 1
#endif
#ifndef MK_PER_PHASE
#define MK_PER_PHASE 0
#endif
constexpr int PH_PER_LAYER = 8, N_PHASES = 1 + DEPTH * PH_PER_LAYER + 1;
struct Args { const void* in[30]; float* out; unsigned char* ws; int ph_lo, ph_hi, pad0, pad1; };
__global__ void __launch_bounds__(NWAVES * 64, 2) mk_fwd(Args args) {
    extern __shared__ __attribute__((aligned(16))) unsigned char lds_raw[];
    Frame F;
    F.lds = (LAS unsigned char*)lds_raw;
    F.tid = threadIdx.x; F.lane = F.tid & 63; F.wave = __builtin_amdgcn_readfirstlane(F.tid >> 6);
    F.G = gridDim.x; { const int bx = blockIdx.x; F.vcu = (F.G % 8 == 0) ? (bx % 8) * (F.G / 8) + bx / 8 : bx; }
    Ptrs P; P.dummy = 0;
    volatile LAS unsigned* MISC = (volatile LAS unsigned*)(F.lds + MISC_OFF);
    for (int u = F.tid; u < (LDS_BYTES - MISC_OFF) / 4; u += NWAVES * 64) ((LAS unsigned*)(F.lds + MISC_OFF))[u] = 0u;
    __syncthreads();
    const int lo = args.ph_lo, hi = args.ph_hi;
    XcdBarrier bar; bar.bar = (unsigned*)(wsbase() + WS_CTL) + CW_BAR; bar.x = 0; bar.st = nullptr;
    if (hi - lo > 1) bar = xcd_barrier_post((unsigned*)(wsbase() + WS_CTL) + CW_BAR, MISC + 8);
    int ph = 0;
#ifndef ONLY_K
#define ONLY_K -1
#endif
    int kk = 0;
#define PHASE_BEGIN if ((ONLY_K < 0 || ONLY_K == kk) && ph >= lo && ph < hi) {
#define PHASE_END   if (ph + 1 < hi) xcd_barrier(bar); } ++ph; ++kk;

#define XB ((bf16_t*)(wsbase() + WS_XB))
#define ACT ((bf16_t*)(wsbase() + WS_ACT))
#define YCAT ((bf16_t*)(wsbase() + WS_YCAT))
#define RCS ((const float*)(wsbase() + WS_ROPE))
#define RSN (RCS + (size_t)MTOK * 32)
#define UU ((float*)(wsbase() + WS_U))
#define QS ((bf16_t*)(wsbase() + WS_QS))
#define KS ((bf16_t*)(wsbase() + WS_KS))
#define VS ((bf16_t*)(wsbase() + WS_VS))
#define CQ ((bf16_t*)(wsbase() + WS_CQ))
#define CKV ((bf16_t*)(wsbase() + WS_CKV))
#define KR ((bf16_t*)(wsbase() + WS_KR))
#define QM ((bf16_t*)(wsbase() + WS_QM))
#define KVM ((bf16_t*)(wsbase() + WS_KVM))
#define KL(k) ({ int _k = (k); asm volatile("" : "+s"(_k)); _k; })

    #ifndef NO_P0
    PHASE_BEGIN for (int rep = 0; rep < PROBE_REP_P0; ++rep) p0_prologue(F, P); PHASE_END
#endif

    for (int l = 0; l < DEPTH; ++l) { kk = 1;
#define rss_l rssptr(P, l * RSS_PER_LAYER)
        PHASE_BEGIN if (l == 0) ssm_p1w_gen(F);
            for (int rep = 0; rep < PROBE_REP_GU; ++rep) { pg8::Gemm g{XB, wptr(P, l, O_WGU1), MTOK, 2 * D_FF, KL(D_MODEL)}; pg8::StaticOrder S; S.init(MTOK, 2 * D_FF, F.G, (int)blockIdx.x);
            pg8::EpiSwiGLU E{ACT, D_FF, rss_l + 0 * MTOK, 1.0f / D_MODEL}; pg8::gemm_phase<pg8::EpiSwiGLU, pg8::StaticOrder, PG_ALIGN_GU, PG_SP2>(F.lds, g, S, E); } PHASE_END
        PHASE_BEGIN { pg8::Gemm g{ACT, wptr(P, l, O_WD1), MTOK, D_MODEL, KL(D_FF)}; pg8::StaticOrder S; S.init(MTOK, D_MODEL, F.G, (int)blockIdx.x);
            pg8::EpiResid E{XB, (bf16_t*)(wsbase() + WS_XL), rss_l + 1 * MTOK, 0.5f}; pg8::gemm_phase<pg8::EpiResid, pg8::StaticOrder, PG_ALIGN, PG_SP2>(F.lds, g, S, E); } PHASE_END
        PHASE_BEGIN { pg8::Gemm g{XB, wptr(P, l, O_WIN), MTOK, N_IN_PAD, KL(D_MODEL)}; pg8::StaticOrder S; S.init(MTOK, WIN_MAIN_N, F.G, (int)blockIdx.x);
            pg8::EpiWin E{rss_l + 1 * MTOK, RCS, RSN, UU, QS, KS, VS, CQ, CKV, KR, rss_l + 3 * MTOK, rss_l + 4 * MTOK, 0.125f * LOG2E, (bf16_t*)(wsbase() + WS_UB)};
            pg8::gemm_phase<pg8::EpiWin, pg8::StaticOrder, PG_ALIGN, PG_SP2>(F.lds, g, S, E); } PHASE_END
        PHASE_BEGIN {
            const int bx = (int)blockIdx.x, G = F.G; const bool deal = (G == 256); const int xcd = bx & 7, slot = bx >> 3; const bool light = deal && slot < 8;
#if WIN_MAIN_N < 2304
            { pg8::Gemm g{XB, wptr(P, l, O_WIN), MTOK, N_IN_PAD, KL(D_MODEL)}; pg8::DealOrder S;
              if (deal) S = pg8::DealOrder{slot, 0, light ? 1 : 0, 1, xcd * 8, 8}; else S = pg8::DealOrder{bx, G, bx < 64 ? (64 - bx + G - 1) / G : 0, 1, 0, 8};
              pg8::EpiWin E{rss_l + 1 * MTOK, RCS, RSN, UU, QS, KS, VS, CQ, CKV, KR, rss_l + 3 * MTOK, rss_l + 4 * MTOK, 0.125f * LOG2E, (bf16_t*)(wsbase() + WS_UB)};
              pg8::gemm_phase<pg8::EpiWin, pg8::DealOrder, PG_ALIGN, PG_SP2>(F.lds, g, S, E); }
#endif
#ifndef NO_UQ
            { pg8::Gemm g{CQ, wptr(P, l, O_WUQ), MTOK, MLA_HEADS * MLA_QK, KL(MLA_QR)}; pg8::DealOrder S;
              if (deal) S = pg8::DealOrder{slot - 8, 24, light ? 0 : 2, 6, xcd * 8, 0}; else S = pg8::DealOrder{bx, G, bx < 384 ? (384 - bx + G - 1) / G : 0, 6, 0, 0};
              pg8::EpiUq E{QM, rss_l + 3 * MTOK, RCS, RSN, 0.07216878364870322f * LOG2E}; pg8::gemm_phase<pg8::EpiUq, pg8::DealOrder, PG_ALIGN, PG_SP2>(F.lds, g, S, E); }
#endif
#ifndef NO_UKV
            { pg8::Gemm g{CKV, wptr(P, l, O_WUKV), MTOK, 2048, KL(MLA_KVR)}; pg8::DealOrder S;
              if (deal) S = light ? pg8::DealOrder{48 + slot, 8, 2, 8, xcd * 8, 0} : pg8::DealOrder{slot - 8, 24, 2, 8, xcd * 8, 0}; else S = pg8::DealOrder{bx, G, bx < 512 ? (512 - bx + G - 1) / G : 0, 8, 0, 0};
              pg8::EpiBf16Rs E{KVM, 2048, rss_l + 4 * MTOK, 1.0f / MLA_KVR, 1.0f}; pg8::gemm_phase<pg8::EpiBf16Rs, pg8::DealOrder, PG_ALIGN, PG_SP2>(F.lds, g, S, E); }
#endif
#ifndef NO_SSM1
            for (int rep = 0; rep < PROBE_REP_SSM * PROBE_REP_SSM1; ++rep) ssm_pass1(F, P, l);
#endif
        } PHASE_END
        PHASE_BEGIN {
#ifndef NO_MLA
            for (int rep = 0; rep < PROBE_REP_MLA; ++rep)
            for (int u = F.vcu; u < 512; u += F.G) { const int half = u >> 8, v = u & 255, bh = v >> 3, s = v & 7, qb = half ? 15 - s : s, b = bh >> 3, hh = bh & 7;
                attn_unit<MLA_QK, MLA_NOPE, MLA_V, false>(F, QM + hh * MLA_QK, MLA_HEADS * MLA_QK, KVM + hh * 256, 2048, KR, MLA_ROPE, KVM + hh * 256 + 128, 2048,
                                                         YCAT + 1024 + hh * MLA_V, D_MIX, rep ? rssptr(P, NRSS) : rss_l + 7 * MTOK, b * SEQ, qb * 256, -1e30f, 0.f); }
#endif
#ifndef NO_SWA
            for (int rep = 0; rep < PROBE_REP_SWA; ++rep)
            for (int u = F.vcu; u < 512; u += F.G) { const int hq = u & 7, qb = (u >> 3) & 15, b = u >> 7, kvh = hq >> 2;
                attn_unit<SWA_HD, SWA_HD, SWA_HD, true, true>(F, QS + hq * SWA_HD, SWA_WIDTH, KS + kvh * SWA_HD, SWA_KV * SWA_HD, nullptr, 0, VS + kvh * SWA_HD, SWA_KV * SWA_HD,
                                                       YCAT + 512 + hq * SWA_HD, D_MIX, rep ? rssptr(P, NRSS + 1) : rss_l + 6 * MTOK, b * SEQ, qb * 256, KF(A_SWA_SINKS)[l * SWA_HEADS + hq] * LOG2E, 1.0f); }
#endif
#ifndef NO_SSM2
            for (int rep = 0; rep < PROBE_REP_SSM; ++rep)
            for (int u = F.vcu; u < BATCH * SSM_NCH; u += F.G) ssm_pass2_unit(F, P, l, u >> 6, u & 63);
#endif
        } PHASE_END
        PHASE_BEGIN { pg8::Gemm g{YCAT, wptr(P, l, O_WOUT), MTOK, D_MODEL, KL(D_MIX)}; pg8::StaticOrder S; S.init(MTOK, D_MODEL, F.G, (int)blockIdx.x);
            pg8::EpiResidSeg E{XB, (bf16_t*)(wsbase() + WS_XL), rss_l + 2 * MTOK, rss_l + 5 * MTOK, rss_l + 6 * MTOK, rss_l + 7 * MTOK};
            pg8::gemm_phase<pg8::EpiResidSeg, pg8::StaticOrder, PG_ALIGN, PG_SP2>(F.lds, g, S, E); } PHASE_END
        PHASE_BEGIN for (int rep = 0; rep < PROBE_REP_GU; ++rep) { pg8::Gemm g{XB, wptr(P, l, O_WGU2), MTOK, 2 * D_FF, KL(D_MODEL)}; pg8::StaticOrder S; S.init(MTOK, 2 * D_FF, F.G, (int)blockIdx.x);
            pg8::EpiSwiGLU E{ACT, D_FF, rss_l + 2 * MTOK, 1.0f / D_MODEL}; pg8::gemm_phase<pg8::EpiSwiGLU, pg8::StaticOrder, PG_ALIGN_GU, PG_SP2>(F.lds, g, S, E); } PHASE_END
        PHASE_BEGIN { pg8::Gemm g{ACT, wptr(P, l, O_WD2), MTOK, D_MODEL, KL(D_FF)}; pg8::StaticOrder S; S.init(MTOK, D_MODEL, F.G, (int)blockIdx.x);
            pg8::EpiResid E{XB, (bf16_t*)(wsbase() + WS_XL), rss_l + RSS_PER_LAYER * MTOK, 0.5f}; pg8::gemm_phase<pg8::EpiResid, pg8::StaticOrder, PG_ALIGN, PG_SP2>(F.lds, g, S, E); } PHASE_END
    }
    kk = 10;
    PHASE_BEGIN final_norm_phase(F, P); PHASE_END
#undef PHASE_BEGIN
#undef PHASE_END
}

extern "C" void kernel_launch(void* const* d_in, const int* in_sizes, int n_in, void* d_out, int out_size, void* d_ws, size_t ws_size, hipStream_t stream) {
    static int grid = 0;
    if (grid == 0) {
        if (n_in != 30 || in_sizes[0] != MTOK * D_MODEL || out_size != MTOK * D_MODEL || ws_size < WS_END + (PROBE_REP_DOWN > 1 ? (size_t)MTOK * D_MODEL * 6 : 0)) {
            fprintf(stderr, "kernel_launch: built for 30 inputs, x/out of %d floats, >= %zu bytes of workspace; got n_in %d, in0 %d, out %d, ws %zu; nothing launched\n", MTOK * D_MODEL, (size_t)WS_END, n_in, n_in > 0 ? in_sizes[0] : -1, out_size, ws_size);
            grid = -1; return; }
        int dev = 0, cus = 0, per_cu = 0;
        if (hipGetDevice(&dev) != hipSuccess || hipDeviceGetAttribute(&cus, hipDeviceAttributeMultiprocessorCount, dev) != hipSuccess) { fprintf(stderr, "kernel_launch: device query failed\n"); grid = -1; return; }
        if (hipFuncSetAttribute((const void*)mk_fwd, hipFuncAttributeMaxDynamicSharedMemorySize, LDS_BYTES) != hipSuccess) { fprintf(stderr, "kernel_launch: hipFuncSetAttribute failed\n"); grid = -1; return; }
        if (hipOccupancyMaxActiveBlocksPerMultiprocessor(&per_cu, (const void*)mk_fwd, NWAVES * 64, LDS_BYTES) != hipSuccess || per_cu < 1)
            fprintf(stderr, "kernel_launch: note: occupancy query reports %d workgroups per CU\n", per_cu);
        (void)hipGetLastError();
        grid = cus;
    }
    if (grid < 0) return;
    if (hipMemsetAsync((char*)d_ws + WS_CTL, 0, CTL_ZERO_BYTES, stream) != hipSuccess) { fprintf(stderr, "kernel_launch: hipMemsetAsync failed\n"); return; }
    Args a{};
    for (int i = 0; i < 30; ++i) a.in[i] = d_in[i];
    a.out = (float*)d_out; a.ws = (unsigned char*)d_ws;
#if MK_PER_PHASE
    for (int p = 0; p < N_PHASES; ++p) { a.ph_lo = p; a.ph_hi = p + 1; hipLaunchKernelGGL(mk_fwd, dim3(grid), dim3(NWAVES * 64), LDS_BYTES, stream, a); }
#else
    a.ph_lo = 0; a.ph_hi = N_PHASES; hipLaunchKernelGGL(mk_fwd, dim3(grid), dim3(NWAVES * 64), LDS_BYTES, stream, a);
#endif
    const hipError_t le = hipPeekAtLastError();
    if (le != hipSuccess) fprintf(stderr, "kernel_launch: launch failed: %s\n", hipGetErrorName(le));
}
```

```cpp
#include <hip/hip_runtime.h>
#include <cstdio>
#include <cstdint>
#include <cmath>

constexpr int D_MODEL = 2048, BATCH = 4, SEQ = 4096, DEPTH = 4, D_FF = 5632;
constexpr int MTOK = BATCH * SEQ;
constexpr float EPS = 1e-6f;
constexpr int SSM_GROUP = 16, SSM_WIDTH = 512, SSM_GROUPS = 32, SSM_STATE = 64;
constexpr int SWA_HEADS = 8, SWA_KV = 2, SWA_HD = 64, SWA_WINDOW = 128, SWA_WIDTH = 512;
constexpr int MLA_HEADS = 8, MLA_QR = 512, MLA_KVR = 256, MLA_NOPE = 128, MLA_ROPE = 64, MLA_V = 128, MLA_WIDTH = 1024;
constexpr int D_MIX = 2048, N_IN = 2112, N_IN_PAD = 2304;
#ifndef WIN_MAIN_N
#define WIN_MAIN_N 2048
#endif
constexpr int MLA_QK = MLA_NOPE + MLA_ROPE;
constexpr float LOG2E = 1.4426950408889634f;
namespace pg8 {
#define PG8_LAS __attribute__((address_space(3)))
typedef unsigned short bf16_t;
typedef short bf16x8 __attribute__((ext_vector_type(8)));
typedef float f32x4 __attribute__((ext_vector_type(4)));
typedef unsigned u32x4 __attribute__((ext_vector_type(4)));
constexpr int BM = 256, BK = 64, HALF = 128, HTB = HALF * BK * 2  , STAGE_BYTES = 8 * HTB, NXCD = 8, WGM = 8;

__host__ __device__ __forceinline__ int lds_byte(int r, int c) { const int st = (r >> 4) * 2 + (c >> 5), rr = r & 15, cc = c & 31, ob = rr * 64 + cc * 2; return st * 1024 + (ob ^ (((ob >> 9) & 1) << 5)); }
__host__ __device__ __forceinline__ void stage_rc(int b, int& R, int& C) { const int st = b / 1024, sb = b % 1024, swz = sb ^ (((sb >> 9) & 1) << 5); R = (st >> 1) * 16 + swz / 64; C = (st & 1) * 32 + (swz % 64) / 2; }
__host__ __device__ __forceinline__ int perm32(int rho) { const int n = rho >> 4, i = rho & 15; return 8 * (i >> 2) + 4 * n + (i & 3); }

struct Unit { int pm, pn; };
struct Gemm { const bf16_t* A; const bf16_t* Bt; int M, N, K; };

struct StaticOrder {
    int nM, nN, nwg, G, c;
    __host__ __device__ void init(int M, int N, int G_, int c_) { nM = M / BM; nN = N / BM; nwg = nM * nN; G = G_; c = c_; }
    __host__ __device__ bool next(int i, Unit& u) const {
        const long L = (long)i * G + c; if (L >= nwg) return false;
        int wgid = (int)L; { const int q = nwg / NXCD, r = nwg % NXCD, xcd = wgid % NXCD, off = wgid / NXCD; wgid = (xcd < r ? xcd * (q + 1) : r * (q + 1) + (xcd - r) * q) + off; }
        const int nig = WGM * nN, gid = wgid / nig, fm = gid * WGM, gsz = (nM - fm) < WGM ? (nM - fm) : WGM;
        u.pm = fm + ((wgid % nig) % gsz); u.pn = (wgid % nig) / gsz; return true;
    }
    __device__ __forceinline__ void a_ready(const Unit&) const {}
    __device__ __forceinline__ void done(const Unit&) const {}
};

struct DealOrder {
    int first, stride, cnt, nN, pm0, pn0;
    __host__ __device__ bool next(int i, Unit& u) const { if (i >= cnt) return false; const int lu = first + i * stride; u.pm = pm0 + lu / nN; u.pn = pn0 + lu % nN; return true; }
    __device__ __forceinline__ void a_ready(const Unit&) const {}
    __device__ __forceinline__ void done(const Unit&) const {}
};

__device__ __forceinline__ unsigned cvt_pk_bf16(float lo, float hi) { unsigned r; asm("v_cvt_pk_bf16_f32 %0, %1, %2" : "=v"(r) : "v"(lo), "v"(hi)); return r; }
typedef float f32x2 __attribute__((ext_vector_type(2)));
__device__ __forceinline__ f32x2 gelu_pk(f32x2 v) {
    const f32x2 av = __builtin_elementwise_abs(v), d = av * 0.2316418882f + 1.0f;
    f32x2 t; t.x = __builtin_amdgcn_rcpf(d.x); t.y = __builtin_amdgcn_rcpf(d.y);
    f32x2 q = t * 0.5307027145f + (-0.7265760135f); q = q * t + 0.7107068705f; q = q * t + (-0.142248368f); q = q * t + 0.127414796f; q = q * t;
    const f32x2 s = (v * v) * (-0.72134752044f);
    f32x2 e; e.x = __builtin_amdgcn_exp2f(s.x); e.y = __builtin_amdgcn_exp2f(s.y);
    const f32x2 m = v * (q * e), r = v - m;
    f32x2 o; o.x = v.x < 0.f ? m.x : r.x; o.y = v.y < 0.f ? m.y : r.y; return o;
}

template <int ACT  > struct EpiBf16 {
    static constexpr bool PERM = true, AFTER_DRAIN = false; static_assert(ACT == 0 || ACT == 1, "EpiBf16: ACT is 0 (none) or 1 (gelu_pk)");
    bf16_t* O; int ldc; const float* bias; int split_cols; size_t split_stride; float scale0;
    __device__ __forceinline__ void operator()(const f32x4 (&acc)[2][2][4][2], const Unit& u, int wr, int wc, int fr, int fq) const {
        const int row0 = u.pm * BM + wr * 64 + fr; int colt = u.pn * BM; bf16_t* base = O;
        float sc = 1.f; if (split_cols) { const int t = colt / split_cols; base += (size_t)t * split_stride; colt -= t * split_cols; if (t == 0) sc = scale0; }
        const int col0 = colt + wc * 32 + 8 * fq, bcol0 = u.pn * BM + wc * 32 + 8 * fq;
        f32x4 bv[2][2];
#pragma unroll
        for (int bj = 0; bj < 2; ++bj)
#pragma unroll
            for (int n = 0; n < 2; ++n) bv[bj][n] = bias ? *(const f32x4*)(bias + bcol0 + bj * HALF + 4 * n) : (f32x4){0.f, 0.f, 0.f, 0.f};
#pragma unroll
        for (int ai = 0; ai < 2; ++ai)
#pragma unroll
            for (int m = 0; m < 4; ++m) { bf16_t* rowp = base + (size_t)(row0 + ai * HALF + m * 16) * ldc + col0;
#pragma unroll
                for (int bj = 0; bj < 2; ++bj) { f32x4 v0 = acc[ai][bj][m][0] + bv[bj][0], v1 = acc[ai][bj][m][1] + bv[bj][1];
                    if (ACT == 1) { f32x2 a = gelu_pk((f32x2){v0[0], v0[1]}), b = gelu_pk((f32x2){v0[2], v0[3]}), c = gelu_pk((f32x2){v1[0], v1[1]}), d = gelu_pk((f32x2){v1[2], v1[3]});
                        v0 = (f32x4){a.x, a.y, b.x, b.y}; v1 = (f32x4){c.x, c.y, d.x, d.y}; }
                    v0 = v0 * sc; v1 = v1 * sc; u32x4 w; w.x = cvt_pk_bf16(v0[0], v0[1]); w.y = cvt_pk_bf16(v0[2], v0[3]); w.z = cvt_pk_bf16(v1[0], v1[1]); w.w = cvt_pk_bf16(v1[2], v1[3]);
                    *(u32x4*)(rowp + bj * HALF) = w; } }
    }
};


typedef unsigned u32x2 __attribute__((ext_vector_type(2)));
__device__ __forceinline__ int epi_vz() { int z; asm volatile("v_mov_b32 %0, 0" : "=v"(z)); return z; }
__device__ __forceinline__ void store8_bf16(bf16_t* p, f32x4 v0, f32x4 v1) {
    u32x4 w; w.x = cvt_pk_bf16(v0[0], v0[1]); w.y = cvt_pk_bf16(v0[2], v0[3]); w.z = cvt_pk_bf16(v1[0], v1[1]); w.w = cvt_pk_bf16(v1[2], v1[3]); *(u32x4*)p = w;
}
#ifndef ACT_NT
#define ACT_NT 0
#endif
__device__ __forceinline__ void store8_bf16_nt(bf16_t* p, f32x4 v0, f32x4 v1) {
    u32x4 w; w.x = cvt_pk_bf16(v0[0], v0[1]); w.y = cvt_pk_bf16(v0[2], v0[3]); w.z = cvt_pk_bf16(v1[0], v1[1]); w.w = cvt_pk_bf16(v1[2], v1[3]);
    if (ACT_NT) __builtin_nontemporal_store(w, (u32x4*)p); else *(u32x4*)p = w;
}
__device__ __forceinline__ float sumsq8(f32x4 a, f32x4 b) { return (a[0] * a[0] + a[1] * a[1]) + (a[2] * a[2] + a[3] * a[3]) + (b[0] * b[0] + b[1] * b[1]) + (b[2] * b[2] + b[3] * b[3]); }
__device__ __forceinline__ float silu_mul(float g, float u) { return g * __builtin_amdgcn_rcpf(1.0f + __builtin_amdgcn_exp2f(-g * LOG2E)) * u; }
__device__ __forceinline__ f32x4 silu_mul4(f32x4 g, f32x4 u) {
    const f32x4 a = g * (-LOG2E); f32x4 e, r;
#pragma unroll
    for (int k = 0; k < 4; ++k) e[k] = __builtin_amdgcn_exp2f(a[k]);
    const f32x4 d = e + 1.0f;
#pragma unroll
    for (int k = 0; k < 4; ++k) r[k] = __builtin_amdgcn_rcpf(d[k]);
    return (g * r) * u;
}
typedef unsigned long long rss_t;
__device__ __forceinline__ rss_t rss_enc(float ss) { return (rss_t)(long long)((double)ss * 4294967296.0); }
__device__ __forceinline__ float rss_dec(rss_t v) { return (float)((double)(long long)v * (1.0 / 4294967296.0)); }
__device__ __forceinline__ void row_atomic(rss_t* dst, float ss, int fq) { ss += __shfl_xor(ss, 16); ss += __shfl_xor(ss, 32); if (fq == 0) atomicAdd(dst, rss_enc(ss)); }
__device__ __forceinline__ void row_scales8(const rss_t* rss, int row0, float invn, float mul, float (&rs)[8]) {
    rss_t v[8];
#pragma unroll
    for (int i = 0; i < 8; ++i) v[i] = rss[row0 + (i >> 2) * HALF + (i & 3) * 16];
#pragma unroll
    for (int i = 0; i < 8; ++i) rs[i] = __builtin_amdgcn_rsqf(rss_dec(v[i]) * invn + EPS) * mul;
}

struct EpiSwiGLU {
    static constexpr bool PERM = true, AFTER_DRAIN = false, INIT_ACC = false, KSEG = false;
    bf16_t* O; int ldc; const rss_t* rss; float invn;
    __device__ __forceinline__ void operator()(const f32x4 (&acc)[2][2][4][2], const Unit& u, int wr, int wc, int fr_, int fq_) const { const int ez = epi_vz(), fr = fr_ + ez, fq = fq_ + ez;
        const int row0 = u.pm * BM + wr * 64 + fr, col0 = u.pn * HALF + wc * 32 + 8 * fq;
        float rs8[8]; row_scales8(rss, row0, invn, 1.0f, rs8);
#pragma unroll
        for (int ai = 0; ai < 2; ++ai)
#pragma unroll
            for (int m = 0; m < 4; ++m) { const int row = row0 + ai * HALF + m * 16; const float rs = rs8[4 * ai + m];
                const f32x4 h0 = silu_mul4(acc[ai][0][m][0] * rs, acc[ai][1][m][0] * rs), h1 = silu_mul4(acc[ai][0][m][1] * rs, acc[ai][1][m][1] * rs);
                store8_bf16_nt(O + (size_t)row * ldc + col0, h0, h1); }
    }
};
#ifndef RESID_LO
#define RESID_LO 0
#endif
#ifndef RESID_BATCH16
#define RESID_BATCH16 0
#endif
__device__ __forceinline__ f32x4 bf_lo4(u32x2 w) { return (f32x4){__uint_as_float(w.x << 16), __uint_as_float(w.x & 0xffff0000u), __uint_as_float(w.y << 16), __uint_as_float(w.y & 0xffff0000u)}; }
__device__ __forceinline__ float resid8(bf16_t* xb, bf16_t* xl, size_t off, f32x4 d0, f32x4 d1) {
    const u32x4 hv = *(const u32x4*)(xb + off);
    f32x4 a0 = bf_lo4((u32x2){hv.x, hv.y}), a1 = bf_lo4((u32x2){hv.z, hv.w});
    if (RESID_LO) { const u32x4 lv = *(const u32x4*)(xl + off); a0 = a0 + bf_lo4((u32x2){lv.x, lv.y}); a1 = a1 + bf_lo4((u32x2){lv.z, lv.w}); }
    const f32x4 v0 = a0 + d0, v1 = a1 + d1;
    u32x4 w; w.x = cvt_pk_bf16(v0[0], v0[1]); w.y = cvt_pk_bf16(v0[2], v0[3]); w.z = cvt_pk_bf16(v1[0], v1[1]); w.w = cvt_pk_bf16(v1[2], v1[3]);
    *(u32x4*)(xb + off) = w;
    if (RESID_LO) { const f32x4 r0 = v0 - bf_lo4((u32x2){w.x, w.y}), r1 = v1 - bf_lo4((u32x2){w.z, w.w}); store8_bf16(xl + off, r0, r1); }
    return sumsq8(v0, v1);
}
__device__ __forceinline__ float resid8v(bf16_t* xb, size_t off, u32x4 hv, f32x4 d0, f32x4 d1) {
    static_assert(!RESID_LO, "batched residual epilogue: bf16-only residual stream");
    const f32x4 v0 = bf_lo4((u32x2){hv.x, hv.y}) + d0, v1 = bf_lo4((u32x2){hv.z, hv.w}) + d1;
    u32x4 w; w.x = cvt_pk_bf16(v0[0], v0[1]); w.y = cvt_pk_bf16(v0[2], v0[3]); w.z = cvt_pk_bf16(v1[0], v1[1]); w.w = cvt_pk_bf16(v1[2], v1[3]);
    *(u32x4*)(xb + off) = w;
    return sumsq8(v0, v1);
}
struct EpiResid {
    static constexpr bool PERM = true, AFTER_DRAIN = false, INIT_ACC = false, KSEG = false;
    bf16_t* xb; bf16_t* xl; rss_t* rss_out; float scale;
    __device__ __forceinline__ void init(f32x4 (&acc)[2][2][4][2], const Unit& u, int wr, int wc, int fr_, int fq_) const {}
    __device__ __forceinline__ void operator()(const f32x4 (&acc)[2][2][4][2], const Unit& u, int wr, int wc, int fr_, int fq_) const { const int ez = epi_vz(), fr = fr_ + ez, fq = fq_ + ez;
        const int row0 = u.pm * BM + wr * 64 + fr, col0 = u.pn * BM + wc * 32 + 8 * fq;
        u32x4 hv[2][4][2];
#if RESID_BATCH16
#pragma unroll
        for (int ai = 0; ai < 2; ++ai)
#pragma unroll
            for (int m = 0; m < 4; ++m)
#pragma unroll
                for (int bj = 0; bj < 2; ++bj) hv[ai][m][bj] = *(const u32x4*)(xb + (size_t)(row0 + ai * HALF + m * 16) * D_MODEL + col0 + bj * HALF);
#endif
#pragma unroll
        for (int ai = 0; ai < 2; ++ai) {
#if !RESID_BATCH16
#pragma unroll
            for (int m = 0; m < 4; ++m)
#pragma unroll
                for (int bj = 0; bj < 2; ++bj) hv[ai][m][bj] = *(const u32x4*)(xb + (size_t)(row0 + ai * HALF + m * 16) * D_MODEL + col0 + bj * HALF);
#endif
#pragma unroll
            for (int m = 0; m < 4; ++m) { const int row = row0 + ai * HALF + m * 16; const size_t off = (size_t)row * D_MODEL + col0; float ss = 0.f;
#pragma unroll
                for (int bj = 0; bj < 2; ++bj) ss += resid8v(xb, off + bj * HALF, hv[ai][m][bj], acc[ai][bj][m][0] * scale, acc[ai][bj][m][1] * scale);
                if (rss_out) row_atomic(rss_out + row, ss, fq); } }
    }
};
struct EpiResidSeg {
    static constexpr bool PERM = true, AFTER_DRAIN = false, INIT_ACC = false, KSEG = true;
    bf16_t* xb; bf16_t* xl; rss_t* rss_out; const rss_t* r0; const rss_t* r1; const rss_t* r2;
    __device__ __forceinline__ void init(f32x4 (&acc)[2][2][4][2], const Unit& u, int wr, int wc, int fr_, int fq_) const {}
    __device__ __forceinline__ bool seg_boundary(int t) const { return t == SSM_WIDTH / BK || t == (SSM_WIDTH + SWA_WIDTH) / BK; }
    __device__ __forceinline__ float rsc(const rss_t* r, int row, float invn) const { return __builtin_amdgcn_rsqf(rss_dec(r[row]) * invn + EPS); }
    __device__ __forceinline__ void rescale(f32x4 (&acc)[2][2][4][2], const Unit& u, int t, int wr, int wc, int fr_, int fq_) const { const int ez = epi_vz(), fr = fr_ + ez;
        const int row0 = u.pm * BM + wr * 64 + fr; const bool first = (t == SSM_WIDTH / BK);
        float fa[8], fb[8];
        row_scales8(first ? r0 : r1, row0, 1.0f / SSM_WIDTH, 1.0f, fa); row_scales8(first ? r1 : r2, row0, first ? 1.0f / SWA_WIDTH : 1.0f / MLA_WIDTH, 1.0f, fb);
        static_assert(SSM_WIDTH == SWA_WIDTH, "the first two segments share 1/n");
#pragma unroll
        for (int ai = 0; ai < 2; ++ai)
#pragma unroll
            for (int m = 0; m < 4; ++m) { const float f = fa[4 * ai + m] * __builtin_amdgcn_rcpf(fb[4 * ai + m]);
#pragma unroll
                for (int bj = 0; bj < 2; ++bj) { acc[ai][bj][m][0] = acc[ai][bj][m][0] * f; acc[ai][bj][m][1] = acc[ai][bj][m][1] * f; } }
    }
    __device__ __forceinline__ void operator()(const f32x4 (&acc)[2][2][4][2], const Unit& u, int wr, int wc, int fr_, int fq_) const { const int ez = epi_vz(), fr = fr_ + ez, fq = fq_ + ez;
        const int row0 = u.pm * BM + wr * 64 + fr, col0 = u.pn * BM + wc * 32 + 8 * fq;
        float rs8[8]; row_scales8(r2, row0, 1.0f / MLA_WIDTH, 1.0f, rs8);
        u32x4 hv[2][4][2];
#if RESID_BATCH16
#pragma unroll
        for (int ai = 0; ai < 2; ++ai)
#pragma unroll
            for (int m = 0; m < 4; ++m)
#pragma unroll
                for (int bj = 0; bj < 2; ++bj) hv[ai][m][bj] = *(const u32x4*)(xb + (size_t)(row0 + ai * HALF + m * 16) * D_MODEL + col0 + bj * HALF);
#endif
#pragma unroll
        for (int ai = 0; ai < 2; ++ai) {
#if !RESID_BATCH16
#pragma unroll
            for (int m = 0; m < 4; ++m)
#pragma unroll
                for (int bj = 0; bj < 2; ++bj) hv[ai][m][bj] = *(const u32x4*)(xb + (size_t)(row0 + ai * HALF + m * 16) * D_MODEL + col0 + bj * HALF);
#endif
#pragma unroll
            for (int m = 0; m < 4; ++m) { const int row = row0 + ai * HALF + m * 16; const size_t off = (size_t)row * D_MODEL + col0; float ss = 0.f; const float sc = rs8[4 * ai + m];
#pragma unroll
                for (int bj = 0; bj < 2; ++bj) ss += resid8v(xb, off + bj * HALF, hv[ai][m][bj], acc[ai][bj][m][0] * sc, acc[ai][bj][m][1] * sc);
                row_atomic(rss_out + row, ss, fq); } }
    }
};
struct EpiNull {
    static constexpr bool PERM = true, AFTER_DRAIN = false, INIT_ACC = false, KSEG = false;
    float* sink;
    __device__ __forceinline__ void init(f32x4 (&acc)[2][2][4][2], const Unit& u, int wr, int wc, int fr_, int fq_) const {}
    __device__ __forceinline__ void operator()(const f32x4 (&acc)[2][2][4][2], const Unit& u, int wr, int wc, int fr, int fq) const {
        float s = 0.f;
#pragma unroll
        for (int ai = 0; ai < 2; ++ai)
#pragma unroll
            for (int bj = 0; bj < 2; ++bj)
#pragma unroll
                for (int m = 0; m < 4; ++m) s += acc[ai][bj][m][0][0] + acc[ai][bj][m][1][3] + acc[ai][bj][m][0][2] + acc[ai][bj][m][1][1];
        if (s == 123.456f) sink[u.pm * 8 + u.pn] = s;
    }
};
struct EpiBf16Rs {
    static constexpr bool PERM = true, AFTER_DRAIN = false, INIT_ACC = false, KSEG = false;
    bf16_t* O; int ldc; const rss_t* rss; float invn; float scale;
    __device__ __forceinline__ void operator()(const f32x4 (&acc)[2][2][4][2], const Unit& u, int wr, int wc, int fr_, int fq_) const { const int ez = epi_vz(), fr = fr_ + ez, fq = fq_ + ez;
        const int row0 = u.pm * BM + wr * 64 + fr, col0 = u.pn * BM + wc * 32 + 8 * fq;
float rs8[8]; row_scales8(rss, row0, invn, scale, rs8);
#pragma unroll
        for (int ai = 0; ai < 2; ++ai)
#pragma unroll
            for (int m = 0; m < 4; ++m) { const int row = row0 + ai * HALF + m * 16; const float rs = rs8[4 * ai + m];
#pragma unroll
                for (int bj = 0; bj < 2; ++bj) store8_bf16(O + (size_t)row * ldc + col0 + bj * HALF, acc[ai][bj][m][0] * rs, acc[ai][bj][m][1] * rs); }
    }
};
__device__ __forceinline__ void rope8(const f32x4 x1a, const f32x4 x1b, const f32x4 x2a, const f32x4 x2b, const float* cs, const float* sn, int i0, float sc, bf16_t* o1, bf16_t* o2) {
    const f32x4 ca = *(const f32x4*)(cs + i0), cb = *(const f32x4*)(cs + i0 + 4), sa = *(const f32x4*)(sn + i0), sb = *(const f32x4*)(sn + i0 + 4);
    store8_bf16(o1, (x1a * ca - x2a * sa) * sc, (x1b * cb - x2b * sb) * sc);
    store8_bf16(o2, (x2a * ca + x1a * sa) * sc, (x2b * cb + x1b * sb) * sc);
}
struct RopeTb { f32x4 ca, cb, sa, sb; };
__device__ __forceinline__ RopeTb rope_load(const float* cs, const float* sn, int row, int i0) {
    RopeTb t; const float* c = cs + (size_t)row * 32 + i0; const float* s = sn + (size_t)row * 32 + i0; t.ca = *(const f32x4*)c; t.cb = *(const f32x4*)(c + 4); t.sa = *(const f32x4*)s; t.sb = *(const f32x4*)(s + 4); return t; }
__device__ __forceinline__ void rope8v(const f32x4 x1a, const f32x4 x1b, const f32x4 x2a, const f32x4 x2b, const RopeTb& t, float sc, bf16_t* o1, bf16_t* o2) {
    store8_bf16(o1, (x1a * t.ca - x2a * t.sa) * sc, (x1b * t.cb - x2b * t.sb) * sc);
    store8_bf16(o2, (x2a * t.ca + x1a * t.sa) * sc, (x2b * t.cb + x1b * t.sb) * sc);
}
struct EpiWin {
    static constexpr bool PERM = true, AFTER_DRAIN = false, INIT_ACC = false, KSEG = false;
    const rss_t* rss; const float* cs; const float* sn;
    float* U; bf16_t* QS; bf16_t* KS; bf16_t* VS; bf16_t* CQ; bf16_t* CKV; bf16_t* KR; rss_t* rss_cq; rss_t* rss_ckv; float qscale; bf16_t* UB;
    __device__ __forceinline__ void operator()(const f32x4 (&acc)[2][2][4][2], const Unit& u, int wr, int wc, int fr_, int fq_) const { const int ez = epi_vz(), fr = fr_ + ez, fq = fq_ + ez;
        const int row0 = u.pm * BM + wr * 64 + fr, pn = u.pn, i0 = 8 * fq;
        if (pn == 8 && wc != 0) return;
        float rs8[8]; row_scales8(rss, row0, 1.0f / D_MODEL, 1.0f, rs8);
        const bool rope = (pn == 2) || (pn == 3) || (pn == 4 && wc < 2) || (pn == 8);
#pragma unroll
        for (int aim = 0; aim < 4; ++aim) { const int ai = aim >> 1; RopeTb tb[4];
            if (rope) {
#pragma unroll
                for (int m = 2 * (aim & 1); m < 2 * (aim & 1) + 2; ++m) tb[m] = rope_load(cs, sn, row0 + ai * HALF + m * 16, i0); }
#pragma unroll
            for (int m = 2 * (aim & 1); m < 2 * (aim & 1) + 2; ++m) { const int row = row0 + ai * HALF + m * 16; const float rs = rs8[4 * ai + m];
                const f32x4 a00 = acc[ai][0][m][0] * rs, a01 = acc[ai][0][m][1] * rs, a10 = acc[ai][1][m][0] * rs, a11 = acc[ai][1][m][1] * rs;
                if (pn < 2) { float* p = U + (size_t)row * SSM_WIDTH + pn * BM + wc * 32 + 8 * fq;
                    *(f32x4*)p = a00; *(f32x4*)(p + 4) = a01; *(f32x4*)(p + HALF) = a10; *(f32x4*)(p + HALF + 4) = a11;
                    { const int c0 = pn * BM + wc * 32 + 8 * fq; bf16_t* ub = UB + ((size_t)((c0 >> 4) * 256 + (row >> 6)) * 1024 + (row & 63) * 16 + (c0 & 15));
                      store8_bf16(ub, a00, a01); store8_bf16(ub + (size_t)(HALF >> 4) * 256 * 1024, a10, a11); } }
                else if (pn < 4) { bf16_t* p = QS + (size_t)row * SWA_WIDTH + ((pn - 2) * 4 + wc) * SWA_HD + i0;
                    rope8v(a00, a01, a10, a11, tb[m], qscale, p, p + 32); }
                else if (pn == 4) {
                    if (wc < 2) { bf16_t* p = KS + (size_t)row * (SWA_KV * SWA_HD) + wc * SWA_HD + i0; rope8v(a00, a01, a10, a11, tb[m], 1.0f, p, p + 32); }
                    else { bf16_t* p = VS + (size_t)row * (SWA_KV * SWA_HD) + (wc - 2) * 32 + i0; store8_bf16(p, a00, a01); store8_bf16(p + 64, a10, a11); } }
                else if (pn < 7) { bf16_t* p = CQ + (size_t)row * MLA_QR + (pn - 5) * BM + wc * 32 + 8 * fq; store8_bf16(p, a00, a01); store8_bf16(p + HALF, a10, a11);
                    row_atomic(rss_cq + row, sumsq8(a00, a01) + sumsq8(a10, a11), fq); }
                else if (pn == 7) { bf16_t* p = CKV + (size_t)row * MLA_KVR + wc * 32 + 8 * fq; store8_bf16(p, a00, a01); store8_bf16(p + HALF, a10, a11);
                    row_atomic(rss_ckv + row, sumsq8(a00, a01) + sumsq8(a10, a11), fq); }
                else { bf16_t* p = KR + (size_t)row * MLA_ROPE + i0; rope8v(a00, a01, a10, a11, tb[m], 1.0f, p, p + 32); }
            } }
    }
};
struct EpiUq {
    static constexpr bool PERM = true, AFTER_DRAIN = false, INIT_ACC = false, KSEG = false;
    bf16_t* QM; const rss_t* rss; const float* cs; const float* sn; float qscale;
    __device__ __forceinline__ void operator()(const f32x4 (&acc)[2][2][4][2], const Unit& u, int wr, int wc, int fr_, int fq_) const { const int ez = epi_vz(), fr = fr_ + ez, fq = fq_ + ez;
        const int row0 = u.pm * BM + wr * 64 + fr, pn = u.pn, i0 = 8 * fq;
        float rs8[8]; row_scales8(rss, row0, 1.0f / MLA_QR, 1.0f, rs8);
#pragma unroll
        for (int aim = 0; aim < 4; ++aim) { const int ai = aim >> 1; RopeTb tb[4];
            if (pn >= 4) {
#pragma unroll
                for (int m = 2 * (aim & 1); m < 2 * (aim & 1) + 2; ++m) tb[m] = rope_load(cs, sn, row0 + ai * HALF + m * 16, i0); }
#pragma unroll
            for (int m = 2 * (aim & 1); m < 2 * (aim & 1) + 2; ++m) { const int row = row0 + ai * HALF + m * 16; const float rs = rs8[4 * ai + m];
                bf16_t* qrow = QM + (size_t)row * (MLA_HEADS * MLA_QK);
                if (pn < 4) { const float s = rs * qscale;
                    store8_bf16(qrow + (2 * pn) * MLA_QK + wc * 32 + 8 * fq, acc[ai][0][m][0] * s, acc[ai][0][m][1] * s);
                    store8_bf16(qrow + (2 * pn + 1) * MLA_QK + wc * 32 + 8 * fq, acc[ai][1][m][0] * s, acc[ai][1][m][1] * s); }
                else { bf16_t* p = qrow + ((pn - 4) * 4 + wc) * MLA_QK + MLA_NOPE + i0;
                    rope8v(acc[ai][0][m][0] * rs, acc[ai][0][m][1] * rs, acc[ai][1][m][0] * rs, acc[ai][1][m][1] * rs, tb[m], qscale, p, p + 32); }
            } }
    }
};
template <class Epi, class Sched, bool ALIGN_EPI = false, bool SP2 = false>
__device__ __forceinline__ void gemm_phase(PG8_LAS unsigned char* lds, const Gemm g, const Sched& S, const Epi& E) {
    int tid_z; asm volatile("v_mov_b32 %0, 0" : "=v"(tid_z));
    const int tid = threadIdx.x + tid_z, wid = __builtin_amdgcn_readfirstlane(tid >> 6), lane = tid & 63, wr = wid >> 2, wc = wid & 3, fr = lane & 15, fq = lane >> 4;
    const int K = g.K, nt = K / BK;
    unsigned voffA[2], voffB[2];
#pragma unroll
    for (int i = 0; i < 2; ++i) { int R, C; stage_rc(tid * 16 + i * 8192, R, C); const int Rb = Epi::PERM ? ((R & ~31) + perm32(R & 31)) : R;
        voffA[i] = (unsigned)(R * K + C) * 2u; voffB[i] = (unsigned)(Rb * K + C) * 2u; }
    const size_t kstep = (size_t)(BK * 2);
    const size_t hstep = (size_t)HALF * K * 2;
    const size_t tstep = 2 * hstep;
    const unsigned ldsw = (unsigned)wid * 1024u;
    const int aoff = lds_byte(wr * 64 + fr, fq * 8), boff = lds_byte(wc * 32 + fr, fq * 8);
#define PG8_SA(b, h) (((b) * 2 + (h)) * HTB)
#define PG8_SB(b, h) ((4 + (b) * 2 + (h)) * HTB)
#define PG8_STAGE(bufoff, gbase, voff) do { _Pragma("unroll") for (int _i = 0; _i < 2; ++_i) \
        __builtin_amdgcn_global_load_lds((const unsigned*)((const char*)(gbase) + (voff)[_i]), (PG8_LAS unsigned*)(lds + (bufoff) + ldsw + _i * 8192), 16, 0, 0); } while (0)
#define PG8_LDA(dst, b, h) do { _Pragma("unroll") for (int m = 0; m < 4; ++m) _Pragma("unroll") for (int k = 0; k < 2; ++k) dst[m][k] = *(const PG8_LAS bf16x8*)(lds + PG8_SA(b, h) + aoff + m * 2048 + k * 1024); } while (0)
#define PG8_LDB(dst, b, h) do { _Pragma("unroll") for (int n = 0; n < 2; ++n) _Pragma("unroll") for (int k = 0; k < 2; ++k) dst[n][k] = *(const PG8_LAS bf16x8*)(lds + PG8_SB(b, h) + boff + n * 2048 + k * 1024); } while (0)
#define PG8_MMA(ai, bj, At, Bt) do { __builtin_amdgcn_s_setprio(1); _Pragma("unroll") for (int m = 0; m < 4; ++m) _Pragma("unroll") for (int n = 0; n < 2; ++n) _Pragma("unroll") for (int k = 0; k < 2; ++k) \
        acc[ai][bj][m][n] = __builtin_amdgcn_mfma_f32_16x16x32_bf16(Bt[n][k], At[m][k], acc[ai][bj][m][n], 0, 0, 0); __builtin_amdgcn_s_setprio(0); } while (0)
#define PG8_WAIT_V(n) asm volatile("s_waitcnt vmcnt(" #n ")" ::: "memory")
#define PG8_WAIT_L(n) asm volatile("s_waitcnt lgkmcnt(" #n ")" ::: "memory")
#define PG8_BAR __builtin_amdgcn_s_barrier()
#define PG8_SCHED __builtin_amdgcn_sched_barrier(0)
    Unit cur, nxt; int ui = 0;
    if (!S.next(0, cur)) return;
    f32x4 acc[2][2][4][2];
    if constexpr (Epi::INIT_ACC) E.init(acc, cur, wr, wc, fr, fq);
    else {
#pragma unroll
    for (int a = 0; a < 2; ++a)
#pragma unroll
        for (int b = 0; b < 2; ++b)
#pragma unroll
            for (int m = 0; m < 4; ++m)
#pragma unroll
                for (int n = 0; n < 2; ++n) acc[a][b][m][n] = (f32x4){0.f, 0.f, 0.f, 0.f};
    }
    bf16x8 At[4][2], B0[2][2], B1[2][2];
    const char* cA = (const char*)g.A + (size_t)cur.pm * tstep; const char* cB = (const char*)g.Bt + (size_t)cur.pn * tstep;
    S.a_ready(cur);
    if constexpr (SP2) {
        PG8_STAGE(PG8_SB(0, 0), cB, voffB); PG8_STAGE(PG8_SB(0, 1), cB + hstep, voffB); PG8_STAGE(PG8_SA(0, 0), cA, voffA); PG8_STAGE(PG8_SA(0, 1), cA + hstep, voffA);
        if (wr == 1) PG8_BAR;
        PG8_WAIT_V(2); PG8_BAR;
        PG8_STAGE(PG8_SB(1, 0), cB + kstep, voffB); PG8_STAGE(PG8_SA(1, 0), cA + kstep, voffA); PG8_STAGE(PG8_SB(1, 1), cB + hstep + kstep, voffB);
        PG8_WAIT_V(6); PG8_BAR;
    } else {
        PG8_STAGE(PG8_SB(0, 0), cB, voffB); PG8_STAGE(PG8_SA(0, 0), cA, voffA); PG8_STAGE(PG8_SB(0, 1), cB + hstep, voffB); PG8_STAGE(PG8_SA(0, 1), cA + hstep, voffA);
        if (wr == 1) PG8_BAR;
        PG8_WAIT_V(4); PG8_BAR;
        PG8_STAGE(PG8_SB(1, 0), cB + kstep, voffB); PG8_STAGE(PG8_SA(1, 0), cA + kstep, voffA); PG8_STAGE(PG8_SB(1, 1), cB + hstep + kstep, voffB);
        PG8_WAIT_V(6); PG8_BAR;
    }
    for (;;) {
        const bool has_next = S.next(ui + 1, nxt);
        const char* nA = has_next ? (const char*)g.A + (size_t)nxt.pm * tstep : cA; const char* nB = has_next ? (const char*)g.Bt + (size_t)nxt.pn * tstep : cB;
        for (int t = 0; t < nt; t += 2) {
            if constexpr (Epi::KSEG) { if (E.seg_boundary(t)) E.rescale(acc, cur, t, wr, wc, fr, fq); }
            const bool last = (t == nt - 2);
            const char* a1 = cA + (size_t)(t + 1) * kstep;
            const char* a2 = last ? nA : cA + (size_t)(t + 2) * kstep; const char* b2 = last ? nB : cB + (size_t)(t + 2) * kstep;
            const char* a3 = a2 + kstep; const char* b3 = b2 + kstep;
            if (last && has_next) S.a_ready(nxt);
            if constexpr (SP2) {
            PG8_LDB(B0, 0, 0); PG8_LDB(B1, 0, 1); PG8_SCHED; PG8_LDA(At, 0, 0); PG8_STAGE(PG8_SA(1, 1), a1 + hstep, voffA);
            PG8_WAIT_V(8); PG8_WAIT_L(0); PG8_BAR; PG8_MMA(0, 0, At, B0); PG8_MMA(0, 1, At, B1); PG8_BAR; PG8_SCHED;
            PG8_LDA(At, 0, 1); PG8_STAGE(PG8_SB(0, 0), b2, voffB); PG8_STAGE(PG8_SB(0, 1), b2 + hstep, voffB); PG8_STAGE(PG8_SA(0, 0), a2, voffA);
            PG8_WAIT_V(8); PG8_WAIT_L(0); PG8_BAR; PG8_MMA(1, 0, At, B0); PG8_MMA(1, 1, At, B1); PG8_BAR; PG8_SCHED;
            PG8_LDB(B0, 1, 0); PG8_LDB(B1, 1, 1); PG8_SCHED; PG8_LDA(At, 1, 0); PG8_STAGE(PG8_SA(0, 1), a2 + hstep, voffA);
            PG8_WAIT_V(8); PG8_WAIT_L(0); PG8_BAR; PG8_MMA(0, 0, At, B0); PG8_MMA(0, 1, At, B1); PG8_BAR; PG8_SCHED;
            PG8_LDA(At, 1, 1); PG8_STAGE(PG8_SB(1, 0), b3, voffB); PG8_STAGE(PG8_SB(1, 1), b3 + hstep, voffB); PG8_STAGE(PG8_SA(1, 0), a3, voffA);
            PG8_WAIT_V(8); PG8_WAIT_L(0); PG8_BAR; PG8_MMA(1, 0, At, B0); PG8_MMA(1, 1, At, B1); PG8_BAR; PG8_SCHED;
            } else {
            PG8_LDB(B0, 0, 0); PG8_SCHED; PG8_LDA(At, 0, 0); PG8_STAGE(PG8_SA(1, 1), a1 + hstep, voffA);
            PG8_WAIT_L(8); PG8_BAR; PG8_WAIT_L(0); PG8_MMA(0, 0, At, B0); PG8_BAR; PG8_SCHED;
            PG8_LDB(B1, 0, 1); PG8_STAGE(PG8_SB(0, 0), b2, voffB);
            PG8_BAR; PG8_WAIT_L(0); PG8_MMA(0, 1, At, B1); PG8_BAR;
            PG8_LDA(At, 0, 1); PG8_STAGE(PG8_SA(0, 0), a2, voffA);
            PG8_BAR; PG8_WAIT_L(0); PG8_MMA(1, 0, At, B0); PG8_BAR; PG8_SCHED;
            PG8_STAGE(PG8_SB(0, 1), b2 + hstep, voffB);
            PG8_WAIT_V(6); PG8_BAR; PG8_MMA(1, 1, At, B1); PG8_BAR;
            PG8_LDB(B0, 1, 0); PG8_SCHED; PG8_LDA(At, 1, 0); PG8_STAGE(PG8_SA(0, 1), a2 + hstep, voffA);
            PG8_WAIT_L(8); PG8_BAR; PG8_WAIT_L(0); PG8_MMA(0, 0, At, B0); PG8_BAR; PG8_SCHED;
            PG8_LDB(B1, 1, 1); PG8_STAGE(PG8_SB(1, 0), b3, voffB);
            PG8_BAR; PG8_WAIT_L(0); PG8_MMA(0, 1, At, B1); PG8_BAR;
            PG8_LDA(At, 1, 1); PG8_STAGE(PG8_SA(1, 0), a3, voffA);
            PG8_BAR; PG8_WAIT_L(0); PG8_MMA(1, 0, At, B0); PG8_BAR; PG8_SCHED;
            PG8_STAGE(PG8_SB(1, 1), b3 + hstep, voffB);
            PG8_WAIT_V(6); PG8_BAR; PG8_MMA(1, 1, At, B1); PG8_BAR;
            }
        }
        if constexpr (ALIGN_EPI) { if (wr == 0) PG8_BAR; }
        if constexpr (!Epi::AFTER_DRAIN) { E(acc, cur, wr, wc, fr, fq); S.done(cur); }
        if (!has_next) break;
        if constexpr (Epi::INIT_ACC) E.init(acc, nxt, wr, wc, fr, fq);
        else {
#pragma unroll
        for (int a = 0; a < 2; ++a)
#pragma unroll
            for (int b = 0; b < 2; ++b)
#pragma unroll
                for (int m = 0; m < 4; ++m)
#pragma unroll
                    for (int n = 0; n < 2; ++n) acc[a][b][m][n] = (f32x4){0.f, 0.f, 0.f, 0.f};
        }
        cur = nxt; cA = nA; cB = nB; ++ui;
        if constexpr (ALIGN_EPI) { if (wr == 1) PG8_BAR; }
    }
    PG8_WAIT_V(0);
    if constexpr (!ALIGN_EPI) { if (wr == 0) PG8_BAR; }
    PG8_BAR;
    if constexpr (Epi::AFTER_DRAIN) { E.fused(acc, cur, wr, wc, fr, fq, lds, wid, lane); S.done(cur); }
#undef PG8_SA
#undef PG8_SB
#undef PG8_STAGE
#undef PG8_LDA
#undef PG8_LDB
#undef PG8_MMA
#undef PG8_WAIT_V
#undef PG8_WAIT_L
#undef PG8_BAR
#undef PG8_SCHED
}
}
#define GAS __attribute__((address_space(1)))
#define LAS __attribute__((address_space(3)))
typedef unsigned short bf16;
typedef unsigned v4u __attribute__((ext_vector_type(4)));
typedef float f32x4 __attribute__((ext_vector_type(4)));
typedef short bf16x8 __attribute__((ext_vector_type(8)));
typedef GAS unsigned gu32;
typedef GAS unsigned long long gu64;
#define RLX_AGENT __ATOMIC_RELAXED, __HIP_MEMORY_SCOPE_AGENT
#define LDS_WAIT() asm volatile("s_waitcnt lgkmcnt(0)" ::: "memory")
#define VM_WAIT() asm volatile("s_waitcnt vmcnt(0)" ::: "memory")
__device__ __forceinline__ unsigned long long rt() { return __builtin_amdgcn_s_memrealtime(); }
__device__ __forceinline__ unsigned f2bf(float f) { unsigned u = __builtin_bit_cast(unsigned, f); return (u + 0x7fffu + ((u >> 16) & 1u)) >> 16; }
__device__ __forceinline__ unsigned pk2(float lo, float hi) { return f2bf(lo) | (f2bf(hi) << 16); }

#define XB_TMO      128
#define XB_XCNT(j)  (256  + 64 * (j))
#define XB_XSUB(j)  (1280 + 64 * (j))
#define XB_XGEN(j)  (2304 + 64 * (j))
#define XB_TOP      3328
#define XB_TOPGEN   3392
#define XCD_BAR_WORDS 3456
#define XB_SPIN_CAP (1u << 18)

__device__ __forceinline__ unsigned xb_ld(unsigned* p)              { return __hip_atomic_load(p, __ATOMIC_RELAXED, __HIP_MEMORY_SCOPE_AGENT); }
__device__ __forceinline__ unsigned xb_add(unsigned* p, unsigned v) { return __hip_atomic_fetch_add(p, v, __ATOMIC_RELAXED, __HIP_MEMORY_SCOPE_AGENT); }
__device__ __forceinline__ unsigned xb_xcc_id() { return (unsigned)__builtin_amdgcn_s_getreg((3 << 11) | 20) & 0xFu; }
#define XB_SPIN(cond, bar) do { unsigned _sp = 0; while (cond) { __builtin_amdgcn_s_sleep(1); \
    if ((++_sp & 255u) == 0u) { if (xb_ld(&(bar)[XB_TMO])) break; if (_sp > XB_SPIN_CAP) { atomicAdd(&(bar)[XB_TMO], 1u); break; } } } } while (0)

struct XcdBarrier {
    unsigned* bar; unsigned x;
    volatile LAS unsigned* st;
};

__device__ __forceinline__ XcdBarrier xcd_barrier_post(unsigned* bar, volatile LAS unsigned* st) {
    XcdBarrier b; b.bar = bar; b.x = xb_xcc_id(); b.st = st;
    if (threadIdx.x == 0) (void)xb_add(&bar[XB_XCNT(b.x)], 1u);
    return b;
}
__device__ __forceinline__ void xcd_barrier_complete(unsigned* bar, unsigned x, unsigned& nloc, unsigned& nx) {
    const unsigned G = gridDim.x * gridDim.y * gridDim.z;
    unsigned sum, cnt, mine, sp = 0u;
    for (;;) {
        sum = 0u; cnt = 0u; mine = 0u;
#pragma unroll
        for (unsigned j = 0; j < 16; ++j) { const unsigned c = xb_ld(&bar[XB_XCNT(j)]); sum += c; cnt += (c > 0u) ? 1u : 0u; mine = (j == x) ? c : mine; }
        if (sum == G) break;
        __builtin_amdgcn_s_sleep(1);
        if ((++sp & 255u) == 0u) { if (xb_ld(&bar[XB_TMO])) break; if (sp > XB_SPIN_CAP) { atomicAdd(&bar[XB_TMO], 1u); break; } }
    }
    nloc = mine > 0u ? mine : 1u; nx = cnt > 0u ? cnt : 1u;
}

__device__ __forceinline__ void xcd_barrier(const XcdBarrier& b) {
    asm volatile("s_waitcnt vmcnt(0)" ::: "memory");
    __syncthreads();
    if (threadIdx.x == 0) {
        unsigned* bar = b.bar;
        __builtin_amdgcn_s_waitcnt(0);
        unsigned nloc = b.st[0], nx = b.st[1];
        if (nloc == 0u) { xcd_barrier_complete(bar, b.x, nloc, nx); b.st[0] = nloc; b.st[1] = nx; }
        const unsigned old = xb_add(&bar[XB_XSUB(b.x)], 1u);
        const unsigned gen = old / nloc;
        if (old + 1u == (gen + 1u) * nloc) {
            __builtin_amdgcn_fence(__ATOMIC_RELEASE, "agent");
            asm volatile("s_waitcnt vmcnt(0)" ::: "memory");
            const unsigned og = xb_add(&bar[XB_TOP], 1u);
            const unsigned tg = og / nx;
            if (og + 1u == (tg + 1u) * nx) xb_add(&bar[XB_TOPGEN], 1u);
            else XB_SPIN(xb_ld(&bar[XB_TOPGEN]) == tg, bar);
            __builtin_amdgcn_fence(__ATOMIC_ACQUIRE, "agent");
            xb_add(&bar[XB_XGEN(b.x)], 1u);
            asm volatile("s_waitcnt vmcnt(0)" ::: "memory");
        } else {
            XB_SPIN(xb_ld(&bar[XB_XGEN(b.x)]) == gen, bar);
            __builtin_amdgcn_fence(__ATOMIC_ACQUIRE, "agent");
            asm volatile("s_waitcnt vmcnt(0)" ::: "memory");
        }
    }
    __syncthreads();
}

constexpr int NWAVES = 8;
constexpr size_t MiB = 1u << 20;
constexpr size_t WS_CTL = 0, CTL_ZERO_BYTES = 8 * MiB;
constexpr int CW_BAR = 4096;
constexpr size_t RSS_OFF = 1 * MiB;
constexpr int RSS_PER_LAYER = 8, NRSS = DEPTH * RSS_PER_LAYER + 1;
static_assert(RSS_OFF + (size_t)(NRSS + 2) * MTOK * 8 <= CTL_ZERO_BYTES && (CW_BAR + 3456) * 4 <= (int)RSS_OFF, "control region");
constexpr size_t E_WGU = (size_t)2 * D_FF * D_MODEL, E_WD = (size_t)D_MODEL * D_FF, E_WIN = (size_t)N_IN_PAD * D_MODEL, E_WUQ = (size_t)MLA_HEADS * MLA_QK * MLA_QR,
                 E_WUKV = (size_t)MLA_HEADS * 256 * MLA_KVR, E_WGLU = (size_t)SSM_WIDTH * SSM_WIDTH, E_WOUT = (size_t)D_MODEL * D_MIX;
constexpr size_t O_WGU1 = 0, O_WD1 = O_WGU1 + E_WGU, O_WIN = O_WD1 + E_WD, O_WUQ = O_WIN + E_WIN, O_WUKV = O_WUQ + E_WUQ, O_WGLU = O_WUKV + E_WUKV, O_WOUT = O_WGLU + E_WGLU,
                 O_WGU2 = O_WOUT + E_WOUT, O_WD2 = O_WGU2 + E_WGU, E_LAYER = O_WD2 + E_WD;
constexpr size_t WS_W = CTL_ZERO_BYTES;
constexpr size_t WS_XB = WS_W + (size_t)DEPTH * E_LAYER * 2;
constexpr size_t WS_XL = WS_XB + (size_t)MTOK * D_MODEL * 2;
constexpr size_t WS_ROPE = WS_XL + (size_t)MTOK * D_MODEL * 2;
constexpr size_t WS_SSMC = WS_ROPE + (size_t)MTOK * 32 * 4 * 2;
constexpr size_t SSMC_A = 0, SSMC_AT = 32 * 64 * 2, SSMC_BB = 2 * 32 * 64 * 2, SSMC_LAYER = SSMC_BB + 32 * 64 * 32;
constexpr size_t WS_SST = WS_SSMC + (size_t)DEPTH * SSMC_LAYER * 4;
constexpr size_t WS_ACT = WS_SST + (size_t)BATCH * 64 * 32 * 64 * 2 * 4;
constexpr size_t WS_U = WS_ACT;
constexpr size_t WS_QS = WS_U + (size_t)MTOK * 512 * 4, WS_KS = WS_QS + (size_t)MTOK * 512 * 2, WS_VS = WS_KS + (size_t)MTOK * 128 * 2, WS_CQ = WS_VS + (size_t)MTOK * 128 * 2,
                 WS_CKV = WS_CQ + (size_t)MTOK * 512 * 2, WS_KR = WS_CKV + (size_t)MTOK * 256 * 2, WS_QM = WS_KR + (size_t)MTOK * 64 * 2, WS_KVM = WS_QM + (size_t)MTOK * 1536 * 2,
                 WS_YCAT = WS_KVM + (size_t)MTOK * 2048 * 2, WS_MIXEND = WS_YCAT + (size_t)MTOK * 2048 * 2;
constexpr size_t WS_ACTEND = WS_ACT + (size_t)MTOK * D_FF * 2;
constexpr size_t WS_END0 = (WS_MIXEND > WS_ACTEND ? WS_MIXEND : WS_ACTEND);
constexpr size_t WS_UB = WS_END0;
constexpr size_t WS_P1W = WS_UB + (size_t)32 * 256 * 1024 * 2;
constexpr size_t WS_OPH = WS_P1W + (size_t)DEPTH * 32 * 128 * 1024 * 2;
constexpr size_t WS_END = WS_OPH + (size_t)DEPTH * 32 * 12 * 64 * 16;
static_assert(WS_W % 256 == 0 && WS_XB % 256 == 0 && WS_ROPE % 256 == 0 && WS_SSMC % 256 == 0 && WS_SST % 256 == 0 && WS_ACT % 256 == 0, "alignment");

constexpr int RING_BYTES = 146432;
constexpr int MISC_OFF = RING_BYTES;
constexpr int LDS_BYTES = 147456;
static_assert(MISC_OFF + 128 <= LDS_BYTES, "LDS map");

typedef unsigned short bf16_t;
typedef float f32x16 __attribute__((ext_vector_type(16)));
typedef short s16x4 __attribute__((ext_vector_type(4)));
typedef unsigned u32x4 __attribute__((ext_vector_type(4)));
typedef unsigned u32x2 __attribute__((ext_vector_type(2)));
using pg8::cvt_pk_bf16; using pg8::rss_t; using pg8::rss_enc; using pg8::rss_dec;
__device__ __forceinline__ float bf2f(unsigned short b) { return __uint_as_float((unsigned)b << 16); }
__device__ __forceinline__ float wave_sum(float v) {
#pragma unroll
    for (int o = 1; o < 64; o <<= 1) v += __shfl_xor(v, o);
    return v;
}
__device__ __forceinline__ int vzero() { int z; asm volatile("v_mov_b32 %0, 0" : "=v"(z)); return z; }

struct Frame {
    LAS unsigned char* lds;
    int tid, lane, wave;
    int vcu, G;
};

__device__ __forceinline__ void conv_item(const float* W, int ldw, int K, int src_col0, const float* gain, bf16_t* WT, int dst_row0, int k0, LAS float* scr, int lane) {
#pragma unroll 8
    for (int i = 0; i < 32; ++i) { const int kk = 2 * i + (lane >> 5); float v = W[(size_t)(k0 + kk) * ldw + src_col0 + (lane & 31)]; if (gain) v *= gain[k0 + kk]; scr[kk * 33 + (lane & 31)] = v; }
    LDS_WAIT(); asm volatile("" ::: "memory");
    const int c = lane & 7;
#pragma unroll
    for (int j = 0; j < 4; ++j) { const int n = (lane >> 3) + 8 * j; const LAS float* s = scr + (8 * c) * 33 + n;
        u32x4 o; o.x = cvt_pk_bf16(s[0 * 33], s[1 * 33]); o.y = cvt_pk_bf16(s[2 * 33], s[3 * 33]); o.z = cvt_pk_bf16(s[4 * 33], s[5 * 33]); o.w = cvt_pk_bf16(s[6 * 33], s[7 * 33]);
        *(u32x4*)(WT + (size_t)(dst_row0 + n) * K + k0 + 8 * c) = o; }
    LDS_WAIT(); asm volatile("" ::: "memory");
}
__device__ __forceinline__ void zero_item(bf16_t* WT, int K, int dst_row0, int k0, int lane) {
    const int c = lane & 7;
#pragma unroll
    for (int j = 0; j < 4; ++j) { const int n = (lane >> 3) + 8 * j; *(u32x4*)(WT + (size_t)(dst_row0 + n) * K + k0 + 8 * c) = (u32x4){0u, 0u, 0u, 0u}; }
}
__device__ __forceinline__ int win_src_col(int db) {
    const int t = db >> 3, j = db & 7;
    if (t < 2) return db * 32;
    if (t < 4) return 512 + ((t - 2) * 4 + (j & 3)) * 64 + (j >> 2) * 32;
    if (t == 4) { if ((j & 3) < 2) return 1024 + (j & 3) * 64 + (j >> 2) * 32;
                  return 1152 + (j >> 2) * 64 + ((j & 3) - 2) * 32; }
    if (t < 8) return 1280 + (db - 40) * 32;
    if (j == 0) return 2048; if (j == 4) return 2080;
    return -1;
}
__device__ __forceinline__ int wuq_src_col(int db) {
    const int t = db >> 3, j = db & 7;
    if (t < 4) return (2 * t + (j >> 2)) * MLA_QK + (j & 3) * 32;
    return ((t - 4) * 4 + (j & 3)) * MLA_QK + MLA_NOPE + (j >> 2) * 32;
}

enum ArgIdx { A_X = 0, A_POS, A_FFN1_NORM, A_FFN1_WG, A_FFN1_WU, A_FFN1_WD, A_MIX_NORM, A_W_IN, A_SSM_LOG_DT, A_SSM_A_RE, A_SSM_A_IM, A_SSM_B_RE, A_SSM_B_IM, A_SSM_C_RE, A_SSM_C_IM, A_SSM_D,
              A_SSM_W_GLU, A_SSM_B_GLU, A_SWA_SINKS, A_MLA_Q_NORM, A_MLA_W_UQ, A_MLA_KV_NORM, A_MLA_W_UKV, A_OUT_NORM, A_W_OUT, A_FFN2_NORM, A_FFN2_WG, A_FFN2_WU, A_FFN2_WD, A_FINAL_NORM, A_OUT, A_WS };
__device__ __forceinline__ const void* karg(int i) {
    unsigned long long v; asm volatile("s_load_dwordx2 %0, %1, %2\n\ts_waitcnt lgkmcnt(0)" : "=s"(v) : "s"(__builtin_amdgcn_kernarg_segment_ptr()), "i"(i * 8) : "memory");
    return (const void*)(const GAS unsigned char*)v; }
#define KF(i) ((const float*)karg(i))
struct Ptrs { int dummy; };
__device__ __forceinline__ unsigned char* wsbase() { return (unsigned char*)karg(A_WS); }
__device__ __forceinline__ bf16_t* wptr(const Ptrs&, int l, size_t off) { return (bf16_t*)(wsbase() + WS_W) + (size_t)l * E_LAYER + off; }
__device__ __forceinline__ rss_t* rssptr(const Ptrs&, int idx) { return (rss_t*)(wsbase() + RSS_OFF) + (size_t)idx * MTOK; }

constexpr int CI_GU = (2 * D_FF / 32) * (D_MODEL / 64), CI_D = (D_MODEL / 32) * (D_FF / 64), CI_IN = (N_IN_PAD / 32) * (D_MODEL / 64), CI_UQ = (MLA_HEADS * MLA_QK / 32) * (MLA_QR / 64),
              CI_UKV = (2048 / 32) * (MLA_KVR / 64), CI_GLU = (SSM_WIDTH / 32) * (SSM_WIDTH / 64), CI_OUT = (D_MODEL / 32) * (D_MIX / 64);
constexpr int CI_LAYER = 2 * (CI_GU + CI_D) + CI_IN + CI_UQ + CI_UKV + CI_GLU + CI_OUT, CI_TOTAL = DEPTH * CI_LAYER;
struct ConvJob { const float* src; const float* gain; bf16_t* dst; int ldw, K; };
__device__ __forceinline__ void conv_decode(int I, ConvJob& J) {
    const int l = I / CI_LAYER; int r = I - l * CI_LAYER;
    const float* W; const float* gn = nullptr; int ldw, K, db, kb, sc; size_t off;
    if (r < 2 * (CI_GU + CI_D)) { const int f = r >= (CI_GU + CI_D); if (f) r -= CI_GU + CI_D;
        if (r < CI_GU) { K = D_MODEL; ldw = D_FF; db = r / (D_MODEL / 64); kb = r % (D_MODEL / 64); const int t = db >> 3, j = db & 7;
            W = ((j < 4) ? (f ? KF(A_FFN2_WG) : KF(A_FFN1_WG)) : (f ? KF(A_FFN2_WU) : KF(A_FFN1_WU))) + (size_t)l * D_MODEL * D_FF; gn = (f ? KF(A_FFN2_NORM) : KF(A_FFN1_NORM)) + (size_t)l * D_MODEL;
            sc = t * 128 + (j & 3) * 32; off = f ? O_WGU2 : O_WGU1; }
        else { r -= CI_GU; K = D_FF; ldw = D_MODEL; db = r / (D_FF / 64); kb = r % (D_FF / 64); W = (f ? KF(A_FFN2_WD) : KF(A_FFN1_WD)) + (size_t)l * D_FF * D_MODEL; sc = db * 32; off = f ? O_WD2 : O_WD1; } }
    else { r -= 2 * (CI_GU + CI_D);
        if (r < CI_IN) { K = D_MODEL; ldw = N_IN; db = r / (D_MODEL / 64); kb = r % (D_MODEL / 64); W = KF(A_W_IN) + (size_t)l * D_MODEL * N_IN; gn = KF(A_MIX_NORM) + (size_t)l * D_MODEL; sc = win_src_col(db); off = O_WIN; }
        else if ((r -= CI_IN) < CI_UQ) { K = MLA_QR; ldw = MLA_HEADS * MLA_QK; db = r / (MLA_QR / 64); kb = r % (MLA_QR / 64); W = KF(A_MLA_W_UQ) + (size_t)l * MLA_QR * (MLA_HEADS * MLA_QK); gn = KF(A_MLA_Q_NORM) + (size_t)l * MLA_QR; sc = wuq_src_col(db); off = O_WUQ; }
        else if ((r -= CI_UQ) < CI_UKV) { K = MLA_KVR; ldw = 2048; db = r / (MLA_KVR / 64); kb = r % (MLA_KVR / 64); W = KF(A_MLA_W_UKV) + (size_t)l * MLA_KVR * 2048; gn = KF(A_MLA_KV_NORM) + (size_t)l * MLA_KVR; sc = db * 32; off = O_WUKV; }
        else if ((r -= CI_UKV) < CI_GLU) { K = SSM_WIDTH; ldw = SSM_WIDTH; db = r / (SSM_WIDTH / 64); kb = r % (SSM_WIDTH / 64); W = KF(A_SSM_W_GLU) + (size_t)l * SSM_WIDTH * SSM_WIDTH; sc = db * 32; off = O_WGLU; }
        else { r -= CI_GLU; K = D_MIX; ldw = D_MODEL; db = r / (D_MIX / 64); kb = r % (D_MIX / 64); W = KF(A_W_OUT) + (size_t)l * D_MIX * D_MODEL; gn = KF(A_OUT_NORM) + (size_t)l * D_MIX; sc = db * 32; off = O_WOUT; } }
    J.src = sc >= 0 ? W + (size_t)(kb * 64) * ldw + sc : nullptr; J.gain = gn ? gn + kb * 64 : nullptr; J.ldw = ldw; J.K = K;
    J.dst = (bf16_t*)(wsbase() + WS_W) + (size_t)l * E_LAYER + off + (size_t)(db * 32) * K + kb * 64;
}
#define CONV_LOAD(J, v) do { if ((J).src) { const float* _s = (J).src + (size_t)(lane >> 5) * (J).ldw + (lane & 31); const size_t _st = (size_t)2 * (J).ldw; \
        _Pragma("unroll") for (int _i = 0; _i < 32; ++_i) v[_i] = _s[_i * _st]; } else { _Pragma("unroll") for (int _i = 0; _i < 32; ++_i) v[_i] = 0.f; } } while (0)
#define CONV_STORE(J, v) do { _Pragma("unroll") for (int _i = 0; _i < 32; ++_i) scr[(2 * _i + (lane >> 5)) * 33 + (lane & 31)] = v[_i]; \
        LDS_WAIT(); asm volatile("" ::: "memory"); \
        const int _c = lane & 7; f32x4 _g0 = {1.f, 1.f, 1.f, 1.f}, _g1 = {1.f, 1.f, 1.f, 1.f}; if ((J).gain) { _g0 = *(const f32x4*)((J).gain + 8 * _c); _g1 = *(const f32x4*)((J).gain + 8 * _c + 4); } \
        _Pragma("unroll") for (int _j = 0; _j < 4; ++_j) { const int _n = (lane >> 3) + 8 * _j; const LAS float* _s = scr + (8 * _c) * 33 + _n; \
            u32x4 _o; _o.x = cvt_pk_bf16(_s[0 * 33] * _g0[0], _s[1 * 33] * _g0[1]); _o.y = cvt_pk_bf16(_s[2 * 33] * _g0[2], _s[3 * 33] * _g0[3]); \
                      _o.z = cvt_pk_bf16(_s[4 * 33] * _g1[0], _s[5 * 33] * _g1[1]); _o.w = cvt_pk_bf16(_s[6 * 33] * _g1[2], _s[7 * 33] * _g1[3]); \
            *(u32x4*)((J).dst + (size_t)_n * (J).K + 8 * _c) = _o; } \
        LDS_WAIT(); asm volatile("" ::: "memory"); } while (0)

__device__ __forceinline__ void p0_prologue(const Frame& F, const Ptrs& P) {
    LAS float* scr = (LAS float*)(F.lds + F.wave * 16384);
    const int gw = F.vcu * NWAVES + F.wave, NGW = F.G * NWAVES, lane = F.lane + vzero();
    { ConvJob JA, JB; float va[32], vb[32];
      int I = gw;
      if (I < CI_TOTAL) { conv_decode(I, JA); CONV_LOAD(JA, va); }
      while (I < CI_TOTAL) {
          const bool hasB = I + NGW < CI_TOTAL; if (hasB) { conv_decode(I + NGW, JB); CONV_LOAD(JB, vb); }
          CONV_STORE(JA, va);
          if (!hasB) break;
          const bool hasA = I + 2 * NGW < CI_TOTAL; if (hasA) { conv_decode(I + 2 * NGW, JA); CONV_LOAD(JA, va); }
          CONV_STORE(JB, vb);
          I += 2 * NGW; if (!hasA) break;
      } }
    { rss_t* rss0 = rssptr(P, 0); bf16_t* XBp = (bf16_t*)(wsbase() + WS_XB); bf16_t* XLp = (bf16_t*)(wsbase() + WS_XL);
      for (int m = gw; m < MTOK; m += NGW) { const f32x4* xr = (const f32x4*)(KF(A_X) + (size_t)m * D_MODEL) + lane; float s = 0.f; u32x2* o8 = (u32x2*)(XBp + (size_t)m * D_MODEL) + lane; u32x2* l8 = (u32x2*)(XLp + (size_t)m * D_MODEL) + lane;
          f32x4 xv[8];
#pragma unroll
          for (int j = 0; j < 8; ++j) xv[j] = xr[64 * j];
#pragma unroll
          for (int j = 0; j < 8; ++j) { const f32x4 v = xv[j]; s += (v[0] * v[0] + v[1] * v[1]) + (v[2] * v[2] + v[3] * v[3]); u32x2 w; w.x = cvt_pk_bf16(v[0], v[1]); w.y = cvt_pk_bf16(v[2], v[3]); o8[64 * j] = w;
              if (RESID_LO) { const f32x4 rm = v - pg8::bf_lo4(w); u32x2 wl; wl.x = cvt_pk_bf16(rm[0], rm[1]); wl.y = cvt_pk_bf16(rm[2], rm[3]); l8[64 * j] = wl; } }
          s = wave_sum(s); if (lane == 0) rss0[m] = rss_enc(s); } }
    { float* cs = (float*)(wsbase() + WS_ROPE); float* sn = cs + (size_t)MTOK * 32; const int gt = gw * 64 + lane, NT = NGW * 64;
      for (int e = gt; e < MTOK * 32; e += NT) { const int row = e >> 5, i = e & 31; const float inv_freq = exp2f(-(float)i * (13.287712379549449f / 32.0f)); const float ang = (float)((const int*)karg(A_POS))[row] * inv_freq;
          float s, c; sincosf(ang, &s, &c); cs[e] = c; sn[e] = s; } }
    { const int gt = gw * 64 + lane, NT = NGW * 64;
      for (int e = gt; e < DEPTH * 32 * 64; e += NT) { const int l = e >> 11, gp = e & 2047, g = gp >> 6;
          float* C = (float*)(wsbase() + WS_SSMC) + (size_t)l * SSMC_LAYER;
          const double lr = (double)KF(A_SSM_A_RE)[e], li = (double)KF(A_SSM_A_IM)[e], dt = exp((double)KF(A_SSM_LOG_DT)[l * 32 + g]);
          const double mag = exp(lr * dt), ar = mag * cos(li * dt), ai = mag * sin(li * dt);
          const double magT = exp(lr * dt * 64.0), aTr = magT * cos(li * dt * 64.0), aTi = magT * sin(li * dt * 64.0);
          const double den = lr * lr + li * li, nr = ar - 1.0, qr = (nr * lr + ai * li) / den, qi = (ai * lr - nr * li) / den;
          C[SSMC_A + gp * 2] = (float)ar; C[SSMC_A + gp * 2 + 1] = (float)ai; C[SSMC_AT + gp * 2] = (float)aTr; C[SSMC_AT + gp * 2 + 1] = (float)aTi;
          const float* br = KF(A_SSM_B_RE) + (size_t)e * 16; const float* bi = KF(A_SSM_B_IM) + (size_t)e * 16; float* bb = C + SSMC_BB + (size_t)gp * 32;
          f32x4 brv[4], biv[4];
#pragma unroll
          for (int i = 0; i < 4; ++i) { brv[i] = *(const f32x4*)(br + 4 * i); biv[i] = *(const f32x4*)(bi + 4 * i); }
#pragma unroll
          for (int i = 0; i < 4; ++i) { f32x4 o_re, o_im;
#pragma unroll
              for (int k = 0; k < 4; ++k) { const double r = (double)brv[i][k], im = (double)biv[i][k]; o_re[k] = (float)(qr * r - qi * im); o_im[k] = (float)(qr * im + qi * r); }
              *(f32x4*)(bb + 4 * i) = o_re; *(f32x4*)(bb + 16 + 4 * i) = o_im; } } }
}

__device__ __forceinline__ int crow(int r, int hi) { return (r & 3) + 8 * (r >> 2) + 4 * hi; }
__device__ __forceinline__ s16x4 vtr(const LAS unsigned char* p) { typedef short v4i16_t __attribute__((ext_vector_type(4))); return __builtin_bit_cast(s16x4, __builtin_amdgcn_ds_read_tr16_b64_v4i16((LAS v4i16_t*)p)); }

template <int DK, int DK1, int DV, bool WIN, bool ALLST = false>
__device__ __forceinline__ void attn_unit(const Frame& F, const bf16_t* __restrict__ Q, int qld, const bf16_t* __restrict__ K1, int k1ld, const bf16_t* __restrict__ K2, int k2ld,
                                          const bf16_t* __restrict__ V, int vld, bf16_t* __restrict__ O, int old_, rss_t* __restrict__ rss, int rowbase, int q0, float m_init, float l_init) {
    constexpr int KROW = (DK + 8) * 2, VROW = (DV + 8) * 2, KBYTES = 64 * KROW, VBYTES = 64 * VROW, BUFB = KBYTES + VBYTES;
    constexpr int NKC = DK / 64, NVC = DV / 64, KCH = DK / 8, VCH = DV / 8;
    static_assert(2 * BUFB <= RING_BYTES, "attention tiles fit the phase scratch");
    const int zz = vzero();
    const int tid = F.tid + zz, lane = F.lane + zz, r = lane & 31, h = lane >> 5;
    const int wid = (F.wave < 4) ? F.wave : (F.wave ^ 2);
    LAS unsigned char* lds = F.lds;
    const int t_lo = WIN ? ((q0 >= SWA_WINDOW ? q0 - SWA_WINDOW : 0) >> 6) : 0, t_hi = (q0 + 256) >> 6;
    const bf16_t* ksrc[NKC]; int kdst[NKC]; int kld_[NKC]; const bf16_t* vsrc[NVC]; int vdst[NVC];
#pragma unroll
    for (int i = 0; i < NKC; ++i) { const int id = tid + i * 512, row = id / KCH, cc = id % KCH;
        ksrc[i] = (cc < DK1 / 8) ? K1 + (size_t)(rowbase + row) * k1ld + cc * 8 : K2 + (size_t)(rowbase + row) * k2ld + (cc - DK1 / 8) * 8; kdst[i] = row * KROW + cc * 16; kld_[i] = (cc < DK1 / 8) ? k1ld : k2ld; }
#pragma unroll
    for (int i = 0; i < NVC; ++i) { const int id = tid + i * 512, row = id / VCH, cc = id % VCH; vsrc[i] = V + (size_t)(rowbase + row) * vld + cc * 8; vdst[i] = KBYTES + row * VROW + cc * 16; }
    u32x4 kst[NKC], vst[NVC];
#define ATT_LOAD(t) do { _Pragma("unroll") for (int i = 0; i < NKC; ++i) kst[i] = *(const u32x4*)(ksrc[i] + (size_t)(t) * 64 * kld_[i]); \
                         _Pragma("unroll") for (int i = 0; i < NVC; ++i) vst[i] = *(const u32x4*)(vsrc[i] + (size_t)(t) * 64 * vld); } while (0)
#define ATT_STORE(buf) do { _Pragma("unroll") for (int i = 0; i < NKC; ++i) *(LAS u32x4*)(lds + (buf) * BUFB + kdst[i]) = kst[i]; \
                            _Pragma("unroll") for (int i = 0; i < NVC; ++i) *(LAS u32x4*)(lds + (buf) * BUFB + vdst[i]) = vst[i]; } while (0)
    constexpr float ATT_THR = 8.0f;
#define ATT_TILE(KT, VT) do { \
        if (active) { \
            const LAS unsigned char* kb = lds + (KT) + r * KROW + 16 * h; \
            f32x16 p0, p1; \
            _Pragma("unroll") \
            for (int e = 0; e < 16; ++e) { p0[e] = 0.f; p1[e] = 0.f; } \
              \
            bf16x8 kfa0 = *(const LAS bf16x8*)(kb), kfa1 = *(const LAS bf16x8*)(kb + 32 * KROW), kfb0 = *(const LAS bf16x8*)(kb + 32), kfb1 = *(const LAS bf16x8*)(kb + 32 * KROW + 32); \
            __builtin_amdgcn_s_setprio(1); \
            _Pragma("unroll") \
            for (int s = 0; s < DK / 16; s += 2) { \
                p0 = __builtin_amdgcn_mfma_f32_32x32x16_bf16(kfa0, qf[s], p0, 0, 0, 0); p1 = __builtin_amdgcn_mfma_f32_32x32x16_bf16(kfa1, qf[s], p1, 0, 0, 0); \
                if (s + 2 < DK / 16) { kfa0 = *(const LAS bf16x8*)(kb + 32 * (s + 2)); kfa1 = *(const LAS bf16x8*)(kb + 32 * KROW + 32 * (s + 2)); } \
                __builtin_amdgcn_sched_barrier(0); \
                p0 = __builtin_amdgcn_mfma_f32_32x32x16_bf16(kfb0, qf[s + 1], p0, 0, 0, 0); p1 = __builtin_amdgcn_mfma_f32_32x32x16_bf16(kfb1, qf[s + 1], p1, 0, 0, 0); \
                if (s + 3 < DK / 16) { kfb0 = *(const LAS bf16x8*)(kb + 32 * (s + 3)); kfb1 = *(const LAS bf16x8*)(kb + 32 * KROW + 32 * (s + 3)); } \
                __builtin_amdgcn_sched_barrier(0); } \
            __builtin_amdgcn_s_setprio(0); \
            const bool need_mask = (kb0 + 63 > wq0) || (WIN && kb0 + SWA_WINDOW <= wq0 + 31); \
            if (need_mask) { \
                const float NEG = -__builtin_inff(); \
            _Pragma("unroll") \
                for (int e = 0; e < 16; ++e) { const int d0 = qpos - (kb0 + crow(e, h)), d1 = d0 - 32; \
                    if (d0 < 0 || (WIN && d0 >= SWA_WINDOW)) p0[e] = NEG; \
                    if (d1 < 0 || (WIN && d1 >= SWA_WINDOW)) p1[e] = NEG; } \
            } \
            float mxa = __builtin_fmaxf(__builtin_fmaxf(p0[0], p0[1]), p1[0]), mxb = __builtin_fmaxf(__builtin_fmaxf(p0[2], p0[3]), p1[1]); mxa = __builtin_fmaxf(__builtin_fmaxf(mxa, p1[2]), p1[3]); \
            _Pragma("unroll") \
            for (int e = 4; e < 16; e += 4) { mxa = __builtin_fmaxf(__builtin_fmaxf(mxa, p0[e]), p0[e + 1]); mxb = __builtin_fmaxf(__builtin_fmaxf(mxb, p0[e + 2]), p0[e + 3]); mxa = __builtin_fmaxf(__builtin_fmaxf(mxa, p1[e]), p1[e + 1]); mxb = __builtin_fmaxf(__builtin_fmaxf(mxb, p1[e + 2]), p1[e + 3]); } \
            float mx = __builtin_fmaxf(mxa, mxb); mx = __builtin_fmaxf(mx, __shfl_xor(mx, 32)); \
            if (!__all(mx - m_run <= ATT_THR)) { const float mnew = fmaxf(m_run, mx), alpha = __builtin_amdgcn_exp2f(m_run - mnew); m_run = mnew; l_run *= alpha; \
            _Pragma("unroll") \
                for (int i = 0; i < DV / 32; ++i) \
            _Pragma("unroll") \
                    for (int e = 0; e < 16; ++e) o[i][e] *= alpha; } \
            const float mn = m_run; float ps = 0.f; \
            _Pragma("unroll") \
            for (int e = 0; e < 16; ++e) { p0[e] = __builtin_amdgcn_exp2f(p0[e] - mn); p1[e] = __builtin_amdgcn_exp2f(p1[e] - mn); ps += p0[e] + p1[e]; } \
            l_run += ps; \
            bf16x8 pb[4]; \
            _Pragma("unroll") \
            for (int ks = 0; ks < 4; ++ks) { const int b = (ks & 1) * 8; u32x4 w; \
                if (ks < 2) { w.x = cvt_pk_bf16(p0[b], p0[b + 1]); w.y = cvt_pk_bf16(p0[b + 2], p0[b + 3]); w.z = cvt_pk_bf16(p0[b + 4], p0[b + 5]); w.w = cvt_pk_bf16(p0[b + 6], p0[b + 7]); } \
                else        { w.x = cvt_pk_bf16(p1[b], p1[b + 1]); w.y = cvt_pk_bf16(p1[b + 2], p1[b + 3]); w.z = cvt_pk_bf16(p1[b + 4], p1[b + 5]); w.w = cvt_pk_bf16(p1[b + 6], p1[b + 7]); } \
                pb[ks] = __builtin_bit_cast(bf16x8, w); } \
            const LAS unsigned char* vb = lds + (VT) + (4 * h + ((lane & 15) >> 2)) * VROW + (16 * ((lane >> 4) & 1) + 4 * (lane & 3)) * 2; \
              \
            bf16x8 vfr[4]; \
              \
            _Pragma("unroll") \
            for (int j = 0; j < 4; ++j) { const int i_ = j % (DV / 32), ks_ = j / (DV / 32); const s16x4 lo = vtr(vb + (16 * ks_) * VROW + 64 * i_), hi = vtr(vb + (16 * ks_ + 8) * VROW + 64 * i_); vfr[j] = (bf16x8){lo[0], lo[1], lo[2], lo[3], hi[0], hi[1], hi[2], hi[3]}; } \
            __builtin_amdgcn_s_setprio(1); \
            _Pragma("unroll") \
            for (int j = 0; j < 4 * (DV / 32); ++j) { \
                o[j % (DV / 32)] = __builtin_amdgcn_mfma_f32_32x32x16_bf16(vfr[j & 3], pb[j / (DV / 32)], o[j % (DV / 32)], 0, 0, 0); \
                if (j + 4 < 4 * (DV / 32)) { const int jn = j + 4, i_ = jn % (DV / 32), ks_ = jn / (DV / 32); const s16x4 lo = vtr(vb + (16 * ks_) * VROW + 64 * i_), hi = vtr(vb + (16 * ks_ + 8) * VROW + 64 * i_); vfr[j & 3] = (bf16x8){lo[0], lo[1], lo[2], lo[3], hi[0], hi[1], hi[2], hi[3]}; } \
                __builtin_amdgcn_sched_barrier(0); } \
            __builtin_amdgcn_s_setprio(0); \
        } \
    } while (0)
    constexpr int NTMAX = ALLST ? 6 : 1;
    static_assert(!ALLST || NTMAX * (KBYTES + VBYTES) <= RING_BYTES, "whole-window staging fits the phase scratch");
    u32x4 ka[NTMAX][NKC], va[NTMAX][NVC];
    if constexpr (ALLST) {
#pragma unroll
        for (int jt = 0; jt < NTMAX; ++jt) if (t_lo + jt < t_hi) {
#pragma unroll
            for (int i = 0; i < NKC; ++i) ka[jt][i] = *(const u32x4*)(ksrc[i] + (size_t)(t_lo + jt) * 64 * kld_[i]);
#pragma unroll
            for (int i = 0; i < NVC; ++i) va[jt][i] = *(const u32x4*)(vsrc[i] + (size_t)(t_lo + jt) * 64 * vld); }
    } else { ATT_LOAD(t_lo); }
    bf16x8 qf[DK / 16];
    { const bf16_t* qrow = Q + (size_t)(rowbase + q0 + wid * 32 + r) * qld + 8 * h;
#pragma unroll
      for (int s = 0; s < DK / 16; ++s) qf[s] = *(const bf16x8*)(qrow + 16 * s);
#pragma unroll
      for (int s = 0; s < DK / 16; ++s) asm volatile("" : "+v"(qf[s])); }
    f32x16 o[DV / 32];
#pragma unroll
    for (int i = 0; i < DV / 32; ++i)
#pragma unroll
        for (int e = 0; e < 16; ++e) o[i][e] = 0.f;
    float m_run = m_init, l_run = (h == 0) ? l_init : 0.f;
    const int qpos = q0 + wid * 32 + r, wq0 = q0 + wid * 32;
    if constexpr (ALLST) {
#pragma unroll
        for (int jt = 0; jt < NTMAX; ++jt) if (t_lo + jt < t_hi) {
#pragma unroll
            for (int i = 0; i < NKC; ++i) *(LAS u32x4*)(lds + jt * KBYTES + kdst[i]) = ka[jt][i];
#pragma unroll
            for (int i = 0; i < NVC; ++i) *(LAS u32x4*)(lds + NTMAX * KBYTES + jt * VBYTES + (vdst[i] - KBYTES)) = va[jt][i]; }
        __syncthreads();
#pragma unroll 1
        for (int t = t_lo; t < t_hi; ++t) { const int jt = t - t_lo; const int kb0 = 64 * t;
            const bool active = (kb0 <= wq0 + 31) && (!WIN || kb0 + 63 + SWA_WINDOW > wq0);
            ATT_TILE(jt * KBYTES, NTMAX * KBYTES + jt * VBYTES); }
        __syncthreads();
    } else {
    ATT_STORE(0);
    __syncthreads();
    for (int t = t_lo; t < t_hi; ++t) {
        const int cur = (t - t_lo) & 1;
        if (t + 1 < t_hi) ATT_LOAD(t + 1);
        const int kb0 = 64 * t;
        const bool active = (kb0 <= wq0 + 31) && (!WIN || kb0 + 63 + SWA_WINDOW > wq0);
        ATT_TILE(cur * BUFB, cur * BUFB + KBYTES);
        if (t + 1 < t_hi) ATT_STORE(cur ^ 1);
        __syncthreads();
    }
    }
    const float lt = l_run + __shfl_xor(l_run, 32), inv = 1.0f / lt;
    float ss = 0.f;
    bf16_t* orow = O + (size_t)(rowbase + qpos) * old_;
#pragma unroll
    for (int i = 0; i < DV / 32; ++i)
#pragma unroll
        for (int pgi = 0; pgi < 2; ++pgi) { u32x2 w[2];
#pragma unroll
            for (int k = 0; k < 2; ++k) { const int g = 2 * pgi + k; const float a = o[i][4 * g] * inv, b = o[i][4 * g + 1] * inv, c = o[i][4 * g + 2] * inv, d = o[i][4 * g + 3] * inv;
                ss += (a * a + b * b) + (c * c + d * d); w[k].x = cvt_pk_bf16(a, b); w[k].y = cvt_pk_bf16(c, d); }
            const u32x2 snd = h ? w[0] : w[1]; u32x2 rcv; rcv.x = (unsigned)__shfl_xor((int)snd.x, 32); rcv.y = (unsigned)__shfl_xor((int)snd.y, 32);
            const u32x4 st = h ? (u32x4){rcv.x, rcv.y, w[1].x, w[1].y} : (u32x4){w[0].x, w[0].y, rcv.x, rcv.y};
            *(u32x4*)(orow + 32 * i + 16 * pgi + 8 * h) = st; }
    ss += __shfl_xor(ss, 32);
    if (h == 0) atomicAdd(rss + rowbase + qpos, rss_enc(ss));
#undef ATT_LOAD
#undef ATT_TILE
#undef ATT_STORE
}


constexpr int SSM_T = 64, SSM_NCH = SEQ / SSM_T;
__device__ __forceinline__ float gelu_tanh(float y) { const float z = 1.5957691216057308f * (y + 0.044715f * y * y * y); return y * __builtin_amdgcn_rcpf(1.0f + __builtin_amdgcn_exp2f(-z * LOG2E)); }

constexpr int SSM_YROW = 520;
constexpr int SSM_XBROW = 136;
constexpr int SSM_XROW = 132;
constexpr int SSM_LDS_Y = 0, SSM_LDS_X = SSM_T * SSM_YROW * 2, SSM_LDS_U = SSM_LDS_X + NWAVES * 16 * SSM_XROW * 4, SSM_LDS_END = SSM_LDS_U + NWAVES * 1024;
static_assert(SSM_LDS_END <= RING_BYTES && SSM_LDS_U - SSM_LDS_X >= SSM_T * SSM_YROW * 2, "SSM LDS map (the out tile reuses the state scratch)");
__device__ __forceinline__ void ssm_load_bb_raw(const float* C, int g, int lane, f32x4 (&raw)[16]) {
    const int q = lane >> 4, n = lane & 15;
#pragma unroll
    for (int blk = 0; blk < 8; ++blk) { const float* src = C + SSMC_BB + (size_t)(g * 64 + 16 * (blk & 3) + n) * 32 + (blk >> 2) * 16 + 8 * (q & 1); raw[2 * blk] = *(const f32x4*)src; raw[2 * blk + 1] = *(const f32x4*)(src + 4); }
}
__device__ __forceinline__ void ssm_cvt_bbh(const f32x4 (&raw)[16], int lane, bf16x8 (&bbh)[8]) {
    const int q = lane >> 4;
#pragma unroll
    for (int blk = 0; blk < 8; ++blk) { const f32x4 v0 = raw[2 * blk], v1 = raw[2 * blk + 1]; u32x4 w; w.x = cvt_pk_bf16(v0[0], v0[1]); w.y = cvt_pk_bf16(v0[2], v0[3]); w.z = cvt_pk_bf16(v1[0], v1[1]); w.w = cvt_pk_bf16(v1[2], v1[3]);
        if (q >= 2) w = (u32x4){0u, 0u, 0u, 0u}; bbh[blk] = __builtin_bit_cast(bf16x8, w); }
}
__device__ __forceinline__ void ssm_load_bbh(const float* C, int g, int lane, bf16x8 (&bbh)[8]) {
    f32x4 raw[16]; ssm_load_bb_raw(C, g, lane, raw);
#pragma unroll
    for (int i = 0; i < 16; ++i) asm volatile("" : "+v"(raw[i]));
    ssm_cvt_bbh(raw, lane, bbh);
}
__device__ __forceinline__ void ssm_bproj16(const LAS float* ubf, const bf16x8 (&bbh)[8], LAS float* bu, int lane) {
    const int q = lane >> 4, n = lane & 15;
    const f32x4 v0 = *(const LAS f32x4*)(ubf + n * 16 + 8 * (q & 1)), v1 = *(const LAS f32x4*)(ubf + n * 16 + 8 * (q & 1) + 4);
    u32x4 w; w.x = cvt_pk_bf16(v0[0], v0[1]); w.y = cvt_pk_bf16(v0[2], v0[3]); w.z = cvt_pk_bf16(v1[0], v1[1]); w.w = cvt_pk_bf16(v1[2], v1[3]);
    if (q >= 2) w = (u32x4){0u, 0u, 0u, 0u};
    const bf16x8 a = __builtin_bit_cast(bf16x8, w);
#pragma unroll
    for (int blk = 0; blk < 8; ++blk) { f32x4 d = {0.f, 0.f, 0.f, 0.f}; d = __builtin_amdgcn_mfma_f32_16x16x32_bf16(a, bbh[blk], d, 0, 0, 0);
#pragma unroll
        for (int i = 0; i < 4; ++i) bu[(4 * q + i) * SSM_XROW + 16 * blk + n] = d[i]; }
}

constexpr int SSM_BTROW = 20;
__device__ __forceinline__ bf16x8 ssm_bproj_a(const LAS float* ubf, int lane) {
    const int q = lane >> 4, n = lane & 15;
    const f32x4 v0 = *(const LAS f32x4*)(ubf + n * 16 + 8 * (q & 1)), v1 = *(const LAS f32x4*)(ubf + n * 16 + 8 * (q & 1) + 4);
    u32x4 w; w.x = cvt_pk_bf16(v0[0], v0[1]); w.y = cvt_pk_bf16(v0[2], v0[3]); w.z = cvt_pk_bf16(v1[0], v1[1]); w.w = cvt_pk_bf16(v1[2], v1[3]);
    if (q >= 2) w = (u32x4){0u, 0u, 0u, 0u};
    return __builtin_bit_cast(bf16x8, w);
}
__device__ __forceinline__ void ssm_bproj_half(const bf16x8 a, const bf16x8 (&bbh)[8], int half, LAS float* bt, int lane, float (&out)[16]) {
    const int q = lane >> 4, n = lane & 15;
#pragma unroll
    for (int b4 = 0; b4 < 4; ++b4) { f32x4 d = {0.f, 0.f, 0.f, 0.f}; d = __builtin_amdgcn_mfma_f32_16x16x32_bf16(a, bbh[half * 4 + b4], d, 0, 0, 0);
        *(LAS f32x4*)(bt + (16 * b4 + n) * SSM_BTROW + 4 * q) = d; }
#pragma unroll
    for (int i = 0; i < 4; ++i) { const f32x4 v = *(const LAS f32x4*)(bt + lane * SSM_BTROW + 4 * i); out[4 * i] = v[0]; out[4 * i + 1] = v[1]; out[4 * i + 2] = v[2]; out[4 * i + 3] = v[3]; }
}

typedef float sf2 __attribute__((ext_vector_type(2)));
#ifndef P1_LIGHT_T
#define P1_LIGHT_T 1
#endif
__device__ __forceinline__ void ssm_p1w_gen(const Frame& F) {
    const int gt = (F.vcu * NWAVES + F.wave) * 64 + F.lane + vzero(), NT = F.G * NWAVES * 64;
    for (int e = gt; e < DEPTH * 32 * 64 * 4; e += NT) { const int tq = e & 3, gp = (e >> 2) & 2047, l = e >> 13;
        const float* C = (const float*)(wsbase() + WS_SSMC) + (size_t)l * SSMC_LAYER;
        const float ar = C[SSMC_A + gp * 2], ai = C[SSMC_A + gp * 2 + 1];
        f32x4 bb[8];
#pragma unroll
        for (int i = 0; i < 8; ++i) bb[i] = *(const f32x4*)(C + SSMC_BB + (size_t)gp * 32 + 4 * i);
        float pr = 1.f, pi = 0.f;
        for (int m = 0; m < 48 - 16 * tq; ++m) { const float nr = pr * ar - pi * ai, ni = pr * ai + pi * ar; pr = nr; pi = ni; }
        bf16_t* wre = (bf16_t*)(wsbase() + WS_P1W) + ((size_t)(l * 32 + (gp >> 6)) * 128 + (gp & 63)) * 1024; bf16_t* wim = wre + (size_t)64 * 1024;
#pragma unroll 1
        for (int tt = 15; tt >= 0; --tt) { const int t = 16 * tq + tt;
#pragma unroll
            for (int h8 = 0; h8 < 2; ++h8) { f32x4 r0, r1, i0, i1;
#pragma unroll
                for (int k = 0; k < 4; ++k) { const float br0 = bb[2 * h8][k], bi0 = bb[4 + 2 * h8][k], br1 = bb[2 * h8 + 1][k], bi1 = bb[4 + 2 * h8 + 1][k];
                    r0[k] = pr * br0 - pi * bi0; i0[k] = pr * bi0 + pi * br0; r1[k] = pr * br1 - pi * bi1; i1[k] = pr * bi1 + pi * br1; }
                pg8::store8_bf16(wre + t * 16 + 8 * h8, r0, r1); pg8::store8_bf16(wim + t * 16 + 8 * h8, i0, i1); }
            const float nr = pr * ar - pi * ai, ni = pr * ai + pi * ar; pr = nr; pi = ni; }
    }
    for (int e = gt; e < DEPTH * 32 * 12 * 64; e += NT) { const int ln = e & 63, f = (e >> 6) % 12, lg = (e >> 6) / 12, g = lg & 31, l = lg >> 5, n = ln & 15, q = ln >> 4;
        const float* C = (const float*)(wsbase() + WS_SSMC) + (size_t)l * SSMC_LAYER; u32x4 w = {0u, 0u, 0u, 0u};
        if (f < 8) { if (q < 2) { const float* src = C + SSMC_BB + (size_t)(g * 64 + 16 * (f & 3) + n) * 32 + (f >> 2) * 16 + 8 * q; const f32x4 v0 = *(const f32x4*)src, v1 = *(const f32x4*)(src + 4);
                w.x = cvt_pk_bf16(v0[0], v0[1]); w.y = cvt_pk_bf16(v0[2], v0[3]); w.z = cvt_pk_bf16(v1[0], v1[1]); w.w = cvt_pk_bf16(v1[2], v1[3]); } }
        else { const size_t rowoff = ((size_t)(l * SSM_GROUPS + g) * 16 + n) * 64 + 4 * q + 16 * (f - 8); const f32x4 cr = *(const f32x4*)(KF(A_SSM_C_RE) + rowoff), ci = *(const f32x4*)(KF(A_SSM_C_IM) + rowoff);
            w.x = cvt_pk_bf16(cr[0], -ci[0]); w.y = cvt_pk_bf16(cr[1], -ci[1]); w.z = cvt_pk_bf16(cr[2], -ci[2]); w.w = cvt_pk_bf16(cr[3], -ci[3]); }
        *(u32x4*)(wsbase() + WS_OPH + (size_t)e * 16) = w; }
}
__device__ __forceinline__ void ssm_pass1(const Frame& F, const Ptrs& P, int l) {
    const int lane = F.lane + vzero(), wid = F.wave, n = lane & 15, q = lane >> 4;
    float* XIN = (float*)(wsbase() + WS_SST);
    const float* C = (const float*)(wsbase() + WS_SSMC) + (size_t)l * SSMC_LAYER;
    LAS float* Sl = (LAS float*)F.lds;
    for (int item = F.vcu; item < 256; item += F.G) { const int g = item >> 3, b = (item >> 1) & 3, h = item & 1;
        const int nblk = wid & 3, mb0 = 2 * (wid >> 2);
        const int j = 16 * nblk + n, prow = (j < 32) ? (32 * h + j) : (64 + 32 * h + (j - 32));
        const bf16_t* ap = (const bf16_t*)(wsbase() + WS_UB) + ((size_t)(g * 256 + b * 64 + mb0 * 16 + n)) * 1024 + 8 * q;
        const bf16_t* bp = (const bf16_t*)(wsbase() + WS_P1W) + ((size_t)((l * 32 + g) * 128 + prow)) * 1024 + 8 * q;
        f32x4 d0 = {0.f, 0.f, 0.f, 0.f}, d1 = d0;
#pragma unroll 1
        for (int kb = 0; kb < 4; ++kb) {
            u32x4 a0[8], a1[8], bf[8];
#pragma unroll
            for (int s = 0; s < 8; ++s) { const int ko = 32 * (8 * kb + s); a0[s] = *(const u32x4*)(ap + ko); a1[s] = *(const u32x4*)(ap + (size_t)16 * 1024 + ko); bf[s] = *(const u32x4*)(bp + ko); }
#pragma unroll
            for (int s = 0; s < 8; ++s) { asm volatile("" : "+v"(a0[s])); asm volatile("" : "+v"(a1[s])); asm volatile("" : "+v"(bf[s])); }
#pragma unroll
            for (int s = 0; s < 8; ++s) { const bf16x8 bv = __builtin_bit_cast(bf16x8, bf[s]);
                d0 = __builtin_amdgcn_mfma_f32_16x16x32_bf16(__builtin_bit_cast(bf16x8, a0[s]), bv, d0, 0, 0, 0);
                d1 = __builtin_amdgcn_mfma_f32_16x16x32_bf16(__builtin_bit_cast(bf16x8, a1[s]), bv, d1, 0, 0, 0); }
        }
#pragma unroll
        for (int r = 0; r < 4; ++r) { Sl[(mb0 * 16 + 4 * q + r) * 65 + j] = d0[r]; Sl[((mb0 + 1) * 16 + 4 * q + r) * 65 + j] = d1[r]; }
        __syncthreads();
        if (wid == 0 && lane < 32) {
            const int pst = 32 * h + lane; const float tr = C[SSMC_AT + (g * 64 + pst) * 2], ti = C[SSMC_AT + (g * 64 + pst) * 2 + 1];
            float xr = 0.f, xi = 0.f; float* xo = XIN + ((size_t)((b * SSM_NCH) * SSM_GROUPS + g) * 64 + pst) * 2;
#pragma unroll 4
            for (int c = 0; c < SSM_NCH; ++c) { *(sf2*)(xo + (size_t)c * SSM_GROUPS * 128) = (sf2){xr, xi};
                const float sr = Sl[c * 65 + lane], si = Sl[c * 65 + 32 + lane];
                const float nr = tr * xr - ti * xi + sr, ni = tr * xi + ti * xr + si; xr = nr; xi = ni; }
        }
        __syncthreads();
    }
}

__device__ __forceinline__ void ssm_pass2_unit(const Frame& F, const Ptrs& P, int l, int b, int c) {
    const int vz = vzero(); const int lane = F.lane + vz, wid = F.wave;
    const float* C = (const float*)(wsbase() + WS_SSMC) + (size_t)l * SSMC_LAYER; const float* U = (const float*)(wsbase() + WS_U); const float* SST = (const float*)(wsbase() + WS_SST);
    LAS unsigned short* ybuf = (LAS unsigned short*)(F.lds + SSM_LDS_Y); LAS float* bu = (LAS float*)(F.lds + SSM_LDS_X) + wid * 16 * SSM_XROW; LAS unsigned* xsw = (LAS unsigned*)bu;
    const int row0 = b * SEQ + c * SSM_T;
    float xin_r[4], xin_i[4];
    { const float* sp = SST + ((size_t)((b * SSM_NCH + c) * SSM_GROUPS + wid * 4) * 64 + lane) * 2;
#pragma unroll
      for (int gi = 0; gi < 4; ++gi) { const sf2 v = *(const sf2*)(sp + gi * 128); xin_r[gi] = v.x; xin_i[gi] = v.y; } }
#ifndef PROBE_REP_GRP
#define PROBE_REP_GRP 1
#endif
    struct GrpIn { u32x4 frag[12]; f32x4 uf[4]; float ar, ai, dsk; };
#define SSM_GRP_LOAD(G_, gidx) do { const int g_ = (gidx); const u32x4* fp_ = (const u32x4*)(wsbase() + WS_OPH) + ((size_t)(l * 32 + g_) * 12) * 64 + lane; \
        _Pragma("unroll") for (int f_ = 0; f_ < 12; ++f_) (G_).frag[f_] = fp_[f_ * 64]; \
        { const float* up_ = U + (size_t)(row0 + lane) * SSM_WIDTH + g_ * 16; _Pragma("unroll") for (int i_ = 0; i_ < 4; ++i_) (G_).uf[i_] = *(const f32x4*)(up_ + 4 * i_); } \
        (G_).ar = C[SSMC_A + (g_ * 64 + lane) * 2]; (G_).ai = C[SSMC_A + (g_ * 64 + lane) * 2 + 1]; (G_).dsk = KF(A_SSM_D)[l * SSM_WIDTH + g_ * 16 + (lane & 15)]; } while (0)
    GrpIn gnx; SSM_GRP_LOAD(gnx, wid * 4);
    for (int rep_g = 0; rep_g < PROBE_REP_GRP; ++rep_g)
#pragma unroll
    for (int gi = 0; gi < 4; ++gi) {
        const int g = wid * 4 + gi;
        GrpIn gc = gnx;
        if (gi + 1 < 4 || rep_g + 1 < PROBE_REP_GRP) SSM_GRP_LOAD(gnx, wid * 4 + ((gi + 1) & 3));
#pragma unroll
        for (int f = 0; f < 12; ++f) asm volatile("" : "+v"(gc.frag[f]));
#pragma unroll
        for (int i = 0; i < 4; ++i) asm volatile("" : "+v"(gc.uf[i]));
        asm volatile("" : "+v"(gc.ar), "+v"(gc.ai), "+v"(gc.dsk));
        const float ar = gc.ar, ai = gc.ai, dsk = gc.dsk;
        bf16x8 bbh[8], cmh[4]; f32x4 uf[4];
#pragma unroll
        for (int f = 0; f < 8; ++f) bbh[f] = __builtin_bit_cast(bf16x8, gc.frag[f]);
#pragma unroll
        for (int f = 0; f < 4; ++f) cmh[f] = __builtin_bit_cast(bf16x8, gc.frag[8 + f]);
#pragma unroll
        for (int i = 0; i < 4; ++i) uf[i] = gc.uf[i];
        float xr = xin_r[gi], xi = xin_i[gi];
        LAS f32x4* ub = (LAS f32x4*)(F.lds + SSM_LDS_U + wid * 1024);
#pragma unroll 1
        for (int tb = 0; tb < 4; ++tb) {
            if ((lane >> 4) == tb) {
#pragma unroll
                for (int i = 0; i < 4; ++i) ub[(lane & 15) * 4 + i] = uf[i]; }
            LDS_WAIT(); asm volatile("" ::: "memory");
            float uv[4];
#pragma unroll
            for (int i = 0; i < 4; ++i) uv[i] = ((const LAS float*)ub)[(4 * (lane >> 4) + i) * 16 + (lane & 15)];
            const bf16x8 ua = ssm_bproj_a((const LAS float*)ub, lane);
            float bre[16], bim[16];
            ssm_bproj_half(ua, bbh, 0, bu, lane, bre); ssm_bproj_half(ua, bbh, 1, bu, lane, bim);
            asm volatile("" ::: "memory");
#pragma unroll
            for (int tt = 0; tt < 16; ++tt) { const float nr = ar * xr - ai * xi + bre[tt], ni = ar * xi + ai * xr + bim[tt]; xr = nr; xi = ni;
                xsw[tt * 68 + lane] = cvt_pk_bf16(xr, xi); }
            asm volatile("" ::: "memory");
#ifndef PROBE_REP_CPROJ
#define PROBE_REP_CPROJ 1
#endif
            for (int rep_c = 0; rep_c < PROBE_REP_CPROJ; ++rep_c) {
            f32x4 ya = {0.f, 0.f, 0.f, 0.f};
            const LAS unsigned short* xa = (const LAS unsigned short*)(xsw + (lane & 15) * 68) + 8 * (lane >> 4);
#pragma unroll
            for (int s = 0; s < 4; ++s) ya = __builtin_amdgcn_mfma_f32_16x16x32_bf16(*(const LAS bf16x8*)(xa + 32 * s), cmh[s], ya, 0, 0, 0);
            const f32x4 yb = {0.f, 0.f, 0.f, 0.f};
#pragma unroll
            for (int i = 0; i < 4; ++i) { const int t = tb * 16 + 4 * (lane >> 4) + i;
                const float y = gelu_tanh(ya[i] + yb[i] + dsk * uv[i]); ybuf[t * SSM_YROW + g * 16 + (lane & 15)] = (unsigned short)(cvt_pk_bf16(y, 0.f) & 0xffffu); }
            }
            LDS_WAIT(); asm volatile("" ::: "memory");
        }
    }
#ifndef PROBE_REP_GLU
#define PROBE_REP_GLU 1
#endif
    for (int rep_ = 0; rep_ < PROBE_REP_GLU; ++rep_) {
    __syncthreads();
    const int lane2 = F.lane + vzero(); const int r = lane2 & 31, h = lane2 >> 5;
    f32x16 acc[2][2];
#pragma unroll
    for (int a = 0; a < 2; ++a)
#pragma unroll
        for (int q = 0; q < 2; ++q)
#pragma unroll
            for (int e = 0; e < 16; ++e) acc[a][q][e] = 0.f;
    const bf16_t* wg = wptr(P, l, O_WGLU) + (size_t)(wid * 64 + r) * SSM_WIDTH + 8 * h;
    const LAS unsigned short* ya_ = ybuf + r * SSM_YROW + 8 * h;
    bf16x8 wb[8][2];
#pragma unroll
    for (int i = 0; i < 8; ++i) { wb[i][0] = *(const bf16x8*)(wg + 16 * i); wb[i][1] = *(const bf16x8*)(wg + (size_t)32 * SSM_WIDTH + 16 * i); }
    bf16x8 an0 = *(const LAS bf16x8*)(ya_), an1 = *(const LAS bf16x8*)(ya_ + 32 * SSM_YROW);
#pragma unroll
    for (int s = 0; s < 32; ++s) {
        const bf16x8 a0 = an0, a1 = an1;
        if (s + 1 < 32) { an0 = *(const LAS bf16x8*)(ya_ + 16 * (s + 1)); an1 = *(const LAS bf16x8*)(ya_ + 32 * SSM_YROW + 16 * (s + 1)); }
        const bf16x8 b0 = wb[s & 7][0], b1 = wb[s & 7][1];
        acc[0][0] = __builtin_amdgcn_mfma_f32_32x32x16_bf16(a0, b0, acc[0][0], 0, 0, 0); acc[0][1] = __builtin_amdgcn_mfma_f32_32x32x16_bf16(a0, b1, acc[0][1], 0, 0, 0);
        acc[1][0] = __builtin_amdgcn_mfma_f32_32x32x16_bf16(a1, b0, acc[1][0], 0, 0, 0); acc[1][1] = __builtin_amdgcn_mfma_f32_32x32x16_bf16(a1, b1, acc[1][1], 0, 0, 0);
        if (s + 8 < 32) { wb[s & 7][0] = *(const bf16x8*)(wg + 16 * (s + 8)); wb[s & 7][1] = *(const bf16x8*)(wg + (size_t)32 * SSM_WIDTH + 16 * (s + 8)); }
        __builtin_amdgcn_sched_barrier(0);
    }
    LAS unsigned short* obuf = (LAS unsigned short*)(F.lds + SSM_LDS_X);
    { const int lane3 = F.lane + vzero(); const int r = lane3 & 31, h = lane3 >> 5;
#pragma unroll
    for (int q = 0; q < 2; ++q) { const int col = wid * 64 + q * 32 + r; const float bg = KF(A_SSM_B_GLU)[l * SSM_WIDTH + col];
#pragma unroll
        for (int a = 0; a < 2; ++a)
#pragma unroll
            for (int e = 0; e < 16; ++e) { const int row = 32 * a + crow(e, h); const float y = bf2f(ybuf[row * SSM_YROW + col]); const float z = acc[a][q][e] + bg;
                const float ov = y * __builtin_amdgcn_rcpf(1.0f + __builtin_amdgcn_exp2f(-z * LOG2E)); obuf[row * SSM_YROW + col] = (unsigned short)(cvt_pk_bf16(ov, 0.f) & 0xffffu); } } }
    __syncthreads();
    bf16_t* Y = (bf16_t*)(wsbase() + WS_YCAT); rss_t* rss = rssptr(P, l * RSS_PER_LAYER + 5);
#pragma unroll
    for (int i = 0; i < 8; ++i) { const int row = wid * 8 + i; const u32x4 v = *(const LAS u32x4*)(obuf + row * SSM_YROW + 8 * lane);
        float ss = 0.f;
#pragma unroll
        for (int k = 0; k < 4; ++k) { const float lo = __uint_as_float(v[k] << 16), hi = __uint_as_float(v[k] & 0xffff0000u); ss += lo * lo + hi * hi; }
        ss = wave_sum(ss); *(u32x4*)(Y + (size_t)(row0 + row) * D_MIX + 8 * lane) = v; if (lane == 0) rss[row0 + row] = rss_enc(ss); }
    }
    __syncthreads();
}

__device__ __forceinline__ void ycat_normalize(const Frame& F, const Ptrs& P, int l) {
    const int gw = F.vcu * NWAVES + F.wave, NGW = F.G * NWAVES, lane = F.lane + vzero();
    bf16_t* Y = (bf16_t*)(wsbase() + WS_YCAT); const rss_t* r0 = rssptr(P, l * RSS_PER_LAYER + 5) + vzero(); const rss_t* r1 = rssptr(P, l * RSS_PER_LAYER + 6) + vzero(); const rss_t* r2 = rssptr(P, l * RSS_PER_LAYER + 7) + vzero();
    for (int m = gw; m < MTOK; m += NGW) {
        const float s0 = __builtin_amdgcn_rsqf(rss_dec(r0[m]) * (1.0f / SSM_WIDTH) + EPS), s1 = __builtin_amdgcn_rsqf(rss_dec(r1[m]) * (1.0f / SWA_WIDTH) + EPS), s2 = __builtin_amdgcn_rsqf(rss_dec(r2[m]) * (1.0f / MLA_WIDTH) + EPS);
        u32x4* yr = (u32x4*)(Y + (size_t)m * D_MIX) + lane;
#pragma unroll
        for (int j = 0; j < 4; ++j) { const float sc = j == 0 ? s0 : (j == 1 ? s1 : s2); u32x4 v = yr[64 * j];
#pragma unroll
            for (int k = 0; k < 4; ++k) { const float lo = __uint_as_float(v[k] << 16) * sc, hi = __uint_as_float(v[k] & 0xffff0000u) * sc; v[k] = cvt_pk_bf16(lo, hi); }
            yr[64 * j] = v; }
    }
}
__device__ __forceinline__ void final_norm_phase(const Frame& F, const Ptrs& P) {
    const int gw = F.vcu * NWAVES + F.wave, NGW = F.G * NWAVES, lane = F.lane + vzero(); const rss_t* rs = rssptr(P, DEPTH * RSS_PER_LAYER) + vzero();
    const bf16_t* XBp = (const bf16_t*)(wsbase() + WS_XB); const bf16_t* XLp = (const bf16_t*)(wsbase() + WS_XL); float* outp = (float*)karg(A_OUT); const float* gnp = KF(A_FINAL_NORM);
    f32x4 gn[8];
#pragma unroll
    for (int j = 0; j < 4; ++j) { gn[2 * j] = *(const f32x4*)(gnp + 512 * j + 8 * lane); gn[2 * j + 1] = *(const f32x4*)(gnp + 512 * j + 8 * lane + 4); }
    for (int m = gw; m < MTOK; m += NGW) { const rss_t rv = rs[m]; u32x4 hv[4];
#pragma unroll
        for (int j = 0; j < 4; ++j) hv[j] = *(const u32x4*)(XBp + (size_t)m * D_MODEL + 512 * j + 8 * lane);
        const float sc = __builtin_amdgcn_rsqf(rss_dec(rv) * (1.0f / D_MODEL) + EPS);
#pragma unroll
        for (int j = 0; j < 4; ++j) { const size_t off = (size_t)m * D_MODEL + 512 * j + 8 * lane;
            const f32x4 a0 = pg8::bf_lo4((u32x2){hv[j].x, hv[j].y}), a1 = pg8::bf_lo4((u32x2){hv[j].z, hv[j].w});
            *(f32x4*)(outp + off) = a0 * sc * gn[2 * j]; *(f32x4*)(outp + off + 4) = a1 * sc * gn[2 * j + 1]; } }
}

#ifndef PROBE_REP_MLA
#define PROBE_REP_MLA 1
#endif
#ifndef PROBE_REP_SWA
#define PROBE_REP_SWA 1
#endif
#ifndef PROBE_REP_SSM
#define PROBE_REP_SSM 1
#endif
#ifndef PROBE_REP_GU
#define PROBE_REP_GU 1
#endif
#ifndef PROBE_REP_DOWN
#define PROBE_REP_DOWN 1
#endif
#ifndef PROBE_REP_SSM1
#define PROBE_REP_SSM1 1
#endif
#ifndef PG_ALIGN_GU
#define PG_ALIGN_GU true
#endif
#ifndef PG_ALIGN
#define PG_ALIGN true
#endif
#ifndef PG_SP2
#define PG_SP2 true
#endif
#ifndef PROBE_DOWN_NULLEPI
#define PROBE_DOWN_NULLEPI 0
#endif
#ifndef PROBE_REP_P0
#define PROBE_REP_P0 1
#endif
#ifndef MK_PER_PHASE
#define MK_PER_PHASE 0
#endif
constexpr int PH_PER_LAYER = 8, N_PHASES = 1 + DEPTH * PH_PER_LAYER + 1;
struct Args { const void* in[30]; float* out; unsigned char* ws; int ph_lo, ph_hi, pad0, pad1; };
__global__ void __launch_bounds__(NWAVES * 64, 2) mk_fwd(Args args) {
    extern __shared__ __attribute__((aligned(16))) unsigned char lds_raw[];
    Frame F;
    F.lds = (LAS unsigned char*)lds_raw;
    F.tid = threadIdx.x; F.lane = F.tid & 63; F.wave = __builtin_amdgcn_readfirstlane(F.tid >> 6);
    F.G = gridDim.x; { const int bx = blockIdx.x; F.vcu = (F.G % 8 == 0) ? (bx % 8) * (F.G / 8) + bx / 8 : bx; }
    Ptrs P; P.dummy = 0;
    volatile LAS unsigned* MISC = (volatile LAS unsigned*)(F.lds + MISC_OFF);
    for (int u = F.tid; u < (LDS_BYTES - MISC_OFF) / 4; u += NWAVES * 64) ((LAS unsigned*)(F.lds + MISC_OFF))[u] = 0u;
    __syncthreads();
    const int lo = args.ph_lo, hi = args.ph_hi;
    XcdBarrier bar; bar.bar = (unsigned*)(wsbase() + WS_CTL) + CW_BAR; bar.x = 0; bar.st = nullptr;
    if (hi - lo > 1) bar = xcd_barrier_post((unsigned*)(wsbase() + WS_CTL) + CW_BAR, MISC + 8);
    int ph = 0;
#ifndef ONLY_K
#define ONLY_K -1
#endif
    int kk = 0;
#define PHASE_BEGIN if ((ONLY_K < 0 || ONLY_K == kk) && ph >= lo && ph < hi) {
#define PHASE_END   if (ph + 1 < hi) xcd_barrier(bar); } ++ph; ++kk;

#define XB ((bf16_t*)(wsbase() + WS_XB))
#define ACT ((bf16_t*)(wsbase() + WS_ACT))
#define YCAT ((bf16_t*)(wsbase() + WS_YCAT))
#define RCS ((const float*)(wsbase() + WS_ROPE))
#define RSN (RCS + (size_t)MTOK * 32)
#define UU ((float*)(wsbase() + WS_U))
#define QS ((bf16_t*)(wsbase() + WS_QS))
#define KS ((bf16_t*)(wsbase() + WS_KS))
#define VS ((bf16_t*)(wsbase() + WS_VS))
#define CQ ((bf16_t*)(wsbase() + WS_CQ))
#define CKV ((bf16_t*)(wsbase() + WS_CKV))
#define KR ((bf16_t*)(wsbase() + WS_KR))
#define QM ((bf16_t*)(wsbase() + WS_QM))
#define KVM ((bf16_t*)(wsbase() + WS_KVM))
#define KL(k) ({ int _k = (k); asm volatile("" : "+s"(_k)); _k; })

    #ifndef NO_P0
    PHASE_BEGIN for (int rep = 0; rep < PROBE_REP_P0; ++rep) p0_prologue(F, P); PHASE_END
#endif

    for (int l = 0; l < DEPTH; ++l) { kk = 1;
#define rss_l rssptr(P, l * RSS_PER_LAYER)
        PHASE_BEGIN if (l == 0) ssm_p1w_gen(F);
            for (int rep = 0; rep < PROBE_REP_GU; ++rep) { pg8::Gemm g{XB, wptr(P, l, O_WGU1), MTOK, 2 * D_FF, KL(D_MODEL)}; pg8::StaticOrder S; S.init(MTOK, 2 * D_FF, F.G, (int)blockIdx.x);
            pg8::EpiSwiGLU E{ACT, D_FF, rss_l + 0 * MTOK, 1.0f / D_MODEL}; pg8::gemm_phase<pg8::EpiSwiGLU, pg8::StaticOrder, PG_ALIGN_GU, PG_SP2>(F.lds, g, S, E); } PHASE_END
        PHASE_BEGIN { pg8::Gemm g{ACT, wptr(P, l, O_WD1), MTOK, D_MODEL, KL(D_FF)}; pg8::StaticOrder S; S.init(MTOK, D_MODEL, F.G, (int)blockIdx.x);
            pg8::EpiResid E{XB, (bf16_t*)(wsbase() + WS_XL), rss_l + 1 * MTOK, 0.5f}; pg8::gemm_phase<pg8::EpiResid, pg8::StaticOrder, PG_ALIGN, PG_SP2>(F.lds, g, S, E); } PHASE_END
        PHASE_BEGIN { pg8::Gemm g{XB, wptr(P, l, O_WIN), MTOK, N_IN_PAD, KL(D_MODEL)}; pg8::StaticOrder S; S.init(MTOK, WIN_MAIN_N, F.G, (int)blockIdx.x);
            pg8::EpiWin E{rss_l + 1 * MTOK, RCS, RSN, UU, QS, KS, VS, CQ, CKV, KR, rss_l + 3 * MTOK, rss_l + 4 * MTOK, 0.125f * LOG2E, (bf16_t*)(wsbase() + WS_UB)};
            pg8::gemm_phase<pg8::EpiWin, pg8::StaticOrder, PG_ALIGN, PG_SP2>(F.lds, g, S, E); } PHASE_END
        PHASE_BEGIN {
            const int bx = (int)blockIdx.x, G = F.G; const bool deal = (G == 256); const int xcd = bx & 7, slot = bx >> 3; const bool light = deal && slot < 8;
#if WIN_MAIN_N < 2304
            { pg8::Gemm g{XB, wptr(P, l, O_WIN), MTOK, N_IN_PAD, KL(D_MODEL)}; pg8::DealOrder S;
              if (deal) S = pg8::DealOrder{slot, 0, light ? 1 : 0, 1, xcd * 8, 8}; else S = pg8::DealOrder{bx, G, bx < 64 ? (64 - bx + G - 1) / G : 0, 1, 0, 8};
              pg8::EpiWin E{rss_l + 1 * MTOK, RCS, RSN, UU, QS, KS, VS, CQ, CKV, KR, rss_l + 3 * MTOK, rss_l + 4 * MTOK, 0.125f * LOG2E, (bf16_t*)(wsbase() + WS_UB)};
              pg8::gemm_phase<pg8::EpiWin, pg8::DealOrder, PG_ALIGN, PG_SP2>(F.lds, g, S, E); }
#endif
#ifndef NO_UQ
            { pg8::Gemm g{CQ, wptr(P, l, O_WUQ), MTOK, MLA_HEADS * MLA_QK, KL(MLA_QR)}; pg8::DealOrder S;
              if (deal) S = pg8::DealOrder{slot - 8, 24, light ? 0 : 2, 6, xcd * 8, 0}; else S = pg8::DealOrder{bx, G, bx < 384 ? (384 - bx + G - 1) / G : 0, 6, 0, 0};
              pg8::EpiUq E{QM, rss_l + 3 * MTOK, RCS, RSN, 0.07216878364870322f * LOG2E}; pg8::gemm_phase<pg8::EpiUq, pg8::DealOrder, PG_ALIGN, PG_SP2>(F.lds, g, S, E); }
#endif
#ifndef NO_UKV
            { pg8::Gemm g{CKV, wptr(P, l, O_WUKV), MTOK, 2048, KL(MLA_KVR)}; pg8::DealOrder S;
              if (deal) S = light ? pg8::DealOrder{48 + slot, 8, 2, 8, xcd * 8, 0} : pg8::DealOrder{slot - 8, 24, 2, 8, xcd * 8, 0}; else S = pg8::DealOrder{bx, G, bx < 512 ? (512 - bx + G - 1) / G : 0, 8, 0, 0};
              pg8::EpiBf16Rs E{KVM, 2048, rss_l + 4 * MTOK, 1.0f / MLA_KVR, 1.0f}; pg8::gemm_phase<pg8::EpiBf16Rs, pg8::DealOrder, PG_ALIGN, PG_SP2>(F.lds, g, S, E); }
#endif
#ifndef NO_SSM1
            for (int rep = 0; rep < PROBE_REP_SSM * PROBE_REP_SSM1; ++rep) ssm_pass1(F, P, l);
#endif
        } PHASE_END
        PHASE_BEGIN {
#ifndef NO_MLA
            for (int rep = 0; rep < PROBE_REP_MLA; ++rep)
            for (int u = F.vcu; u < 512; u += F.G) { const int half = u >> 8, v = u & 255, bh = v >> 3, s = v & 7, qb = half ? 15 - s : s, b = bh >> 3, hh = bh & 7;
                attn_unit<MLA_QK, MLA_NOPE, MLA_V, false>(F, QM + hh * MLA_QK, MLA_HEADS * MLA_QK, KVM + hh * 256, 2048, KR, MLA_ROPE, KVM + hh * 256 + 128, 2048,
                                                         YCAT + 1024 + hh * MLA_V, D_MIX, rep ? rssptr(P, NRSS) : rss_l + 7 * MTOK, b * SEQ, qb * 256, -1e30f, 0.f); }
#endif
#ifndef NO_SWA
            for (int rep = 0; rep < PROBE_REP_SWA; ++rep)
            for (int u = F.vcu; u < 512; u += F.G) { const int hq = u & 7, qb = (u >> 3) & 15, b = u >> 7, kvh = hq >> 2;
                attn_unit<SWA_HD, SWA_HD, SWA_HD, true, true>(F, QS + hq * SWA_HD, SWA_WIDTH, KS + kvh * SWA_HD, SWA_KV * SWA_HD, nullptr, 0, VS + kvh * SWA_HD, SWA_KV * SWA_HD,
                                                       YCAT + 512 + hq * SWA_HD, D_MIX, rep ? rssptr(P, NRSS + 1) : rss_l + 6 * MTOK, b * SEQ, qb * 256, KF(A_SWA_SINKS)[l * SWA_HEADS + hq] * LOG2E, 1.0f); }
#endif
#ifndef NO_SSM2
            for (int rep = 0; rep < PROBE_REP_SSM; ++rep)
            for (int u = F.vcu; u < BATCH * SSM_NCH; u += F.G) ssm_pass2_unit(F, P, l, u >> 6, u & 63);
#endif
        } PHASE_END
        PHASE_BEGIN { pg8::Gemm g{YCAT, wptr(P, l, O_WOUT), MTOK, D_MODEL, KL(D_MIX)}; pg8::StaticOrder S; S.init(MTOK, D_MODEL, F.G, (int)blockIdx.x);
            pg8::EpiResidSeg E{XB, (bf16_t*)(wsbase() + WS_XL), rss_l + 2 * MTOK, rss_l + 5 * MTOK, rss_l + 6 * MTOK, rss_l + 7 * MTOK};
            pg8::gemm_phase<pg8::EpiResidSeg, pg8::StaticOrder, PG_ALIGN, PG_SP2>(F.lds, g, S, E); } PHASE_END
        PHASE_BEGIN for (int rep = 0; rep < PROBE_REP_GU; ++rep) { pg8::Gemm g{XB, wptr(P, l, O_WGU2), MTOK, 2 * D_FF, KL(D_MODEL)}; pg8::StaticOrder S; S.init(MTOK, 2 * D_FF, F.G, (int)blockIdx.x);
            pg8::EpiSwiGLU E{ACT, D_FF, rss_l + 2 * MTOK, 1.0f / D_MODEL}; pg8::gemm_phase<pg8::EpiSwiGLU, pg8::StaticOrder, PG_ALIGN_GU, PG_SP2>(F.lds, g, S, E); } PHASE_END
        PHASE_BEGIN { pg8::Gemm g{ACT, wptr(P, l, O_WD2), MTOK, D_MODEL, KL(D_FF)}; pg8::StaticOrder S; S.init(MTOK, D_MODEL, F.G, (int)blockIdx.x);
            pg8::EpiResid E{XB, (bf16_t*)(wsbase() + WS_XL), rss_l + RSS_PER_LAYER * MTOK, 0.5f}; pg8::gemm_phase<pg8::EpiResid, pg8::StaticOrder, PG_ALIGN, PG_SP2>(F.lds, g, S, E); } PHASE_END
    }
    kk = 10;
    PHASE_BEGIN final_norm_phase(F, P); PHASE_END
#undef PHASE_BEGIN
#undef PHASE_END
}

extern "C" void kernel_launch(void* const* d_in, const int* in_sizes, int n_in, void* d_out, int out_size, void* d_ws, size_t ws_size, hipStream_t stream) {
    static int grid = 0;
    if (grid == 0) {
        if (n_in != 30 || in_sizes[0] != MTOK * D_MODEL || out_size != MTOK * D_MODEL || ws_size < WS_END + (PROBE_REP_DOWN > 1 ? (size_t)MTOK * D_MODEL * 6 : 0)) {
            fprintf(stderr, "kernel_launch: built for 30 inputs, x/out of %d floats, >= %zu bytes of workspace; got n_in %d, in0 %d, out %d, ws %zu; nothing launched\n", MTOK * D_MODEL, (size_t)WS_END, n_in, n_in > 0 ? in_sizes[0] : -1, out_size, ws_size);
            grid = -1; return; }
        int dev = 0, cus = 0, per_cu = 0;
        if (hipGetDevice(&dev) != hipSuccess || hipDeviceGetAttribute(&cus, hipDeviceAttributeMultiprocessorCount, dev) != hipSuccess) { fprintf(stderr, "kernel_launch: device query failed\n"); grid = -1; return; }
        if (hipFuncSetAttribute((const void*)mk_fwd, hipFuncAttributeMaxDynamicSharedMemorySize, LDS_BYTES) != hipSuccess) { fprintf(stderr, "kernel_launch: hipFuncSetAttribute failed\n"); grid = -1; return; }
        if (hipOccupancyMaxActiveBlocksPerMultiprocessor(&per_cu, (const void*)mk_fwd, NWAVES * 64, LDS_BYTES) != hipSuccess || per_cu < 1)
            fprintf(stderr, "kernel_launch: note: occupancy query reports %d workgroups per CU\n", per_cu);
        (void)hipGetLastError();
        grid = cus;
    }
    if (grid < 0) return;
    if (hipMemsetAsync((char*)d_ws + WS_CTL, 0, CTL_ZERO_BYTES, stream) != hipSuccess) { fprintf(stderr, "kernel_launch: hipMemsetAsync failed\n"); return; }
    Args a{};
    for (int i = 0; i < 30; ++i) a.in[i] = d_in[i];
    a.out = (float*)d_out; a.ws = (unsigned char*)d_ws;
#if MK_PER_PHASE
    for (int p = 0; p < N_PHASES; ++p) { a.ph_lo = p; a.ph_hi = p + 1; hipLaunchKernelGGL(mk_fwd, dim3(grid), dim3(NWAVES * 64), LDS_BYTES, stream, a); }
#else
    a.ph_lo = 0; a.ph_hi = N_PHASES; hipLaunchKernelGGL(mk_fwd, dim3(grid), dim3(NWAVES * 64), LDS_BYTES, stream, a);
#endif
    const hipError_t le = hipPeekAtLastError();
    if (le != hipSuccess) fprintf(stderr, "kernel_launch: launch failed: %s\n", hipGetErrorName(le));
}
```
